# Optimizing an MI355X kernel written in HIP

```python
import jax, jax.numpy as jnp
from jax import lax
import numpy as np

D_MODEL = 1024
BATCH = 8
SEQ = 4096
DEPTH = 4

N_MIXERS = 2
ROPE_THETA = 10000.0
NORM_EPS = 1e-6

A_HEADS = 16
A_HEAD_DIM = 64
A_WIDTH = A_HEADS * A_HEAD_DIM
A_GROUPS = ((128, 1), (512, 4), (2048, 16))
A_N_GROUPS = len(A_GROUPS)
A_QKV_COLS = A_N_GROUPS * 3 * A_WIDTH
A_IN_COLS = A_QKV_COLS + A_WIDTH

B_HEADS = 16
B_KV_HEADS = 4
B_HEAD_DIM = 64
B_WIDTH = B_HEADS * B_HEAD_DIM
B_KV_WIDTH = B_KV_HEADS * B_HEAD_DIM
IDX_HEADS = 8
IDX_DIM = 64
TOPK_MAX = 256
Q_BLOCK = 128
B_SPLITS = (B_WIDTH, B_KV_WIDTH, B_KV_WIDTH, IDX_HEADS * IDX_DIM, IDX_DIM, IDX_HEADS, B_WIDTH)
B_IN_COLS = sum(B_SPLITS)

N_A_LAYERS = (DEPTH + 1) // 2
N_B_LAYERS = DEPTH // 2

kernel_name = 'hybrid_dilated_dsa_adaln_trunk'


def rms_norm(t, g):
    t32 = t.astype(jnp.float32)
    t32 = t32 * lax.rsqrt(jnp.mean(t32 * t32, axis=-1, keepdims=True) + NORM_EPS)
    return t32.astype(t.dtype) * g


def rope(t, pos):
    half = t.shape[-1] // 2
    inv_freq = ROPE_THETA ** (-jnp.arange(half, dtype=jnp.float32) / half)
    ang = pos.astype(jnp.float32)[..., None] * inv_freq
    cos = jnp.cos(ang)[:, :, None, :]
    sin = jnp.sin(ang)[:, :, None, :]
    t32 = t.astype(jnp.float32)
    t1, t2 = t32[..., :half], t32[..., half:]
    return jnp.concatenate([t1 * cos - t2 * sin, t2 * cos + t1 * sin], axis=-1).astype(t.dtype)


def banded_causal_attention(q, k, v, n_back):
    N, n, H, Dh = q.shape
    blk = n_back
    nb = -(-n // blk)
    pad = nb * blk - n
    qb = jnp.pad(q, ((0, 0), (0, pad), (0, 0), (0, 0))).reshape(N, nb, blk, H, Dh)
    kp = jnp.pad(k, ((0, 0), (blk, pad), (0, 0), (0, 0))).reshape(N, nb + 1, blk, H, Dh)
    vp = jnp.pad(v, ((0, 0), (blk, pad), (0, 0), (0, 0))).reshape(N, nb + 1, blk, H, Dh)
    kb = jnp.concatenate([kp[:, :-1], kp[:, 1:]], axis=2)
    vb = jnp.concatenate([vp[:, :-1], vp[:, 1:]], axis=2)
    s = jnp.einsum('nbqhd,nbkhd->nbhqk', qb, kb).astype(jnp.float32) * (Dh ** -0.5)
    qi = jnp.arange(blk)[:, None]
    kj = jnp.arange(2 * blk)[None, :]
    dist = blk + qi - kj
    key_pos = jnp.arange(nb)[:, None, None] * blk - blk + kj[None]
    mask = (dist >= 0) & (dist <= n_back) & (key_pos >= 0)
    s = jnp.where(mask[None, :, None], s, -jnp.inf)
    m = jnp.max(s, axis=-1, keepdims=True)
    e = jnp.exp(s - m)
    den = jnp.sum(e, axis=-1, keepdims=True)
    lse = (m + jnp.log(den))[..., 0]
    o = jnp.einsum('nbhqk,nbkhd->nbqhd', (e / den).astype(v.dtype), vb)
    o = o.reshape(N, nb * blk, H, Dh)[:, :n]
    lse = lse.transpose(0, 1, 3, 2).reshape(N, nb * blk, H)[:, :n]
    return o, lse


def dilated_group_attention(q, k, v, dilation, n_back):
    B, S, H, Dh = q.shape
    n = S // dilation

    def to_res(t):
        return t.reshape(B, n, dilation, H, Dh).transpose(0, 2, 1, 3, 4).reshape(B * dilation, n, H, Dh)

    o, lse = banded_causal_attention(to_res(q), to_res(k), to_res(v), n_back)
    o = o.reshape(B, dilation, n, H, Dh).transpose(0, 2, 1, 3, 4).reshape(B, S, H, Dh)
    lse = lse.reshape(B, dilation, n, H).transpose(0, 2, 1, 3).reshape(B, S, H)
    return o, lse


def dilated_mixer(h, pos, w_in, w_out):
    B, S, _ = h.shape
    proj = h @ w_in
    qkv = proj[..., :A_QKV_COLS].reshape(B, S, A_N_GROUPS, 3, A_HEADS, A_HEAD_DIM)
    gate = proj[..., A_QKV_COLS:]
    outs, lses = [], []
    for g, (window, dilation) in enumerate(A_GROUPS):
        q = rope(qkv[:, :, g, 0], pos)
        k = rope(qkv[:, :, g, 1], pos)
        v = qkv[:, :, g, 2]
        o, lse = dilated_group_attention(q, k, v, dilation, window // dilation)
        outs.append(o)
        lses.append(lse)
    o = jnp.stack(outs, axis=0)
    alpha = jax.nn.softmax(jnp.stack(lses, axis=0), axis=0)
    y = jnp.sum(alpha[..., None].astype(o.dtype) * o, axis=0).reshape(B, S, A_WIDTH)
    return (y * jax.nn.silu(gate)) @ w_out


def dsa_mixer(h, pos, w_in, w_out):
    B, S, _ = h.shape
    proj = h @ w_in
    cuts = list(np.cumsum(B_SPLITS)[:-1])
    q, k, v, qi, ki, wi, gate = jnp.split(proj, cuts, axis=-1)
    group = B_HEADS // B_KV_HEADS
    q = rope(q.reshape(B, S, B_HEADS, B_HEAD_DIM), pos).reshape(B, S, B_KV_HEADS, group, B_HEAD_DIM)
    k = rope(k.reshape(B, S, B_KV_HEADS, B_HEAD_DIM), pos)
    v = v.reshape(B, S, B_KV_HEADS, B_HEAD_DIM)
    qi = rope(qi.reshape(B, S, IDX_HEADS, IDX_DIM), pos)
    ki = rope(ki.reshape(B, S, 1, IDX_DIM), pos)[:, :, 0].astype(jnp.float32)
    wi = wi * (IDX_HEADS ** -0.5)
    k_sel = min(TOPK_MAX, S // 4)
    n_blk = S // Q_BLOCK
    key_idx = jnp.arange(S)

    def to_blocks(t):
        return t.reshape(B, n_blk, Q_BLOCK, *t.shape[2:]).swapaxes(0, 1)

    def block_fn(args):
        qb, qib, wib, start = args
        q_pos = start + jnp.arange(Q_BLOCK)
        sc = jnp.einsum('bqhd,bsd->bqhs', qib.astype(jnp.float32), ki) * (IDX_DIM ** -0.5)
        score = jnp.einsum('bqhs,bqh->bqs', jax.nn.relu(sc), wib.astype(jnp.float32))
        causal = key_idx[None, :] <= q_pos[:, None]
        score = jnp.where(causal[None], score, -jnp.inf)
        _, idx = lax.top_k(score, k_sel)
        valid = idx <= q_pos[None, :, None]
        ks = jax.vmap(lambda kb_, ib_: kb_[ib_])(k, idx)
        vs = jax.vmap(lambda vb_, ib_: vb_[ib_])(v, idx)
        s = jnp.einsum('bqgrd,bqkgd->bqgrk', qb, ks).astype(jnp.float32) * (B_HEAD_DIM ** -0.5)
        s = jnp.where(valid[:, :, None, None, :], s, -jnp.inf)
        p = jax.nn.softmax(s, axis=-1).astype(vs.dtype)
        o = jnp.einsum('bqgrk,bqkgd->bqgrd', p, vs)
        return o.reshape(B, Q_BLOCK, B_WIDTH)

    starts = jnp.arange(n_blk) * Q_BLOCK
    o = lax.map(block_fn, (to_blocks(q), to_blocks(qi), to_blocks(wi), starts))
    o = o.swapaxes(0, 1).reshape(B, S, B_WIDTH)
    return (o * jax.nn.silu(gate)) @ w_out


def setup_inputs(seed: int = 0) -> dict:
    key = jax.random.key(seed)
    ks = jax.random.split(key, 12)
    f32 = jnp.float32
    x = jax.random.normal(ks[0], (BATCH, SEQ, D_MODEL), f32)
    c = jax.random.normal(ks[1], (BATCH, D_MODEL), f32)
    offset = jax.random.randint(ks[2], (BATCH, 1), 0, 4096, dtype=jnp.int32)
    positions = (offset + jnp.arange(SEQ, dtype=jnp.int32)[None, :]).astype(jnp.int32)
    norm_g = 1.0 + 0.02 * jax.random.normal(ks[3], (DEPTH, D_MODEL), f32)
    ada_w = 0.02 * jax.random.normal(ks[4], (DEPTH, D_MODEL, 3 * D_MODEL), f32)
    ada_b = 0.02 * jax.random.normal(ks[5], (DEPTH, 3 * D_MODEL), f32)
    a_w_in = jax.random.normal(ks[6], (N_A_LAYERS, D_MODEL, A_IN_COLS), f32) * (D_MODEL ** -0.5)
    a_w_out = jax.random.normal(ks[7], (N_A_LAYERS, A_WIDTH, D_MODEL), f32) * (A_WIDTH ** -0.5)
    b_w_in = jax.random.normal(ks[8], (N_B_LAYERS, D_MODEL, B_IN_COLS), f32) * (D_MODEL ** -0.5)
    b_w_out = jax.random.normal(ks[9], (N_B_LAYERS, B_WIDTH, D_MODEL), f32) * (B_WIDTH ** -0.5)
    final_g = 1.0 + 0.02 * jax.random.normal(ks[10], (D_MODEL,), f32)
    return {'x': x, 'c': c, 'positions': positions, 'norm_g': norm_g, 'ada_w': ada_w,
            'ada_b': ada_b, 'a_w_in': a_w_in, 'a_w_out': a_w_out, 'b_w_in': b_w_in,
            'b_w_out': b_w_out, 'final_g': final_g}


def reference(x, c, positions, norm_g, ada_w, ada_b, a_w_in, a_w_out, b_w_in, b_w_out, final_g):
    h = x
    c_act = jax.nn.silu(c)
    for i in range(DEPTH):
        mod = c_act @ ada_w[i] + ada_b[i]
        shift, scale, gate = jnp.split(mod, 3, axis=-1)
        u = rms_norm(h, norm_g[i]) * (1.0 + scale[:, None, :]) + shift[:, None, :]
        if i % N_MIXERS == 0:
            y = dilated_mixer(u, positions, a_w_in[i // N_MIXERS], a_w_out[i // N_MIXERS])
        else:
            y = dsa_mixer(u, positions, b_w_in[i // N_MIXERS], b_w_out[i // N_MIXERS])
        h = h + gate[:, None, :] * y
    return rms_norm(h, final_g)
```

```cpp
#include <hip/hip_runtime.h>
#include <cstdio>
#include <cstdint>
#include <cmath>
namespace pg8 {
#define PG8_LAS __attribute__((address_space(3)))
typedef unsigned short bf16_t;
typedef short bf16x8 __attribute__((ext_vector_type(8)));
typedef float f32x4 __attribute__((ext_vector_type(4)));
typedef unsigned u32x4 __attribute__((ext_vector_type(4)));
constexpr int BM = 256, BK = 64, HALF = 128, HTB = HALF * BK * 2  , STAGE_BYTES = 8 * HTB, NXCD = 8, WGM = 8;

__host__ __device__ __forceinline__ int lds_byte(int r, int c) { const int st = (r >> 4) * 2 + (c >> 5), rr = r & 15, cc = c & 31, ob = rr * 64 + cc * 2; return st * 1024 + (ob ^ (((ob >> 9) & 1) << 5)); }
__host__ __device__ __forceinline__ void stage_rc(int b, int& R, int& C) { const int st = b / 1024, sb = b % 1024, swz = sb ^ (((sb >> 9) & 1) << 5); R = (st >> 1) * 16 + swz / 64; C = (st & 1) * 32 + (swz % 64) / 2; }
__host__ __device__ __forceinline__ int perm32(int rho) { const int n = rho >> 4, i = rho & 15; return 8 * (i >> 2) + 4 * n + (i & 3); }

struct Unit { int pm, pn; };
struct Gemm { const bf16_t* A; const bf16_t* Bt; int M, N, K; };

struct StaticOrder {
    int nM, nN, nwg, G, c;
    __host__ __device__ void init(int M, int N, int G_, int c_) { nM = M / BM; nN = N / BM; nwg = nM * nN; G = G_; c = c_; }
    __host__ __device__ bool next(int i, Unit& u) const {
        const long L = (long)i * G + c; if (L >= nwg) return false;
        int wgid = (int)L; { const int q = nwg / NXCD, r = nwg % NXCD, xcd = wgid % NXCD, off = wgid / NXCD; wgid = (xcd < r ? xcd * (q + 1) : r * (q + 1) + (xcd - r) * q) + off; }
        const int nig = WGM * nN, gid = wgid / nig, fm = gid * WGM, gsz = (nM - fm) < WGM ? (nM - fm) : WGM;
        u.pm = fm + ((wgid % nig) % gsz); u.pn = (wgid % nig) / gsz; return true;
    }
    __device__ __forceinline__ void a_ready(const Unit&) const {}
    __device__ __forceinline__ void done(const Unit&) const {}
};

__device__ __forceinline__ unsigned cvt_pk_bf16(float lo, float hi) { unsigned r; asm volatile("v_cvt_pk_bf16_f32 %0, %1, %2" : "=v"(r) : "v"(lo), "v"(hi)); return r; }
typedef float f32x2 __attribute__((ext_vector_type(2)));
constexpr float C2F = 0.125f * 1.4426950408889634f;
constexpr float WSC = 0.35355339059327373f * 0.125f;
__device__ __forceinline__ float silu_f(float x) { return x * __builtin_amdgcn_rcpf(1.0f + __builtin_amdgcn_exp2f(-1.4426950408889634f * x)); }
__device__ __forceinline__ f32x4 silu4(f32x4 v) { return (f32x4){silu_f(v[0]), silu_f(v[1]), silu_f(v[2]), silu_f(v[3])}; }
__device__ __forceinline__ u32x4 pack8(f32x4 a, f32x4 b) { u32x4 w; w.x = cvt_pk_bf16(a[0], a[1]); w.y = cvt_pk_bf16(a[2], a[3]); w.z = cvt_pk_bf16(b[0], b[1]); w.w = cvt_pk_bf16(b[2], b[3]); return w; }

__device__ __forceinline__ void epi_store_rows(const f32x4 (&acc)[2][2][4][2], int kind, bf16_t* ob, int pitch, int row0, int col0, int j0, const float* cs, const float* sn) {
#pragma unroll
    for (int ai = 0; ai < 2; ++ai)
#pragma unroll
        for (int m = 0; m < 4; ++m) {
            const int row = row0 + ai * HALF + m * 16;
            f32x4 c4 = (f32x4){1.f, 1.f, 1.f, 1.f}, s4 = (f32x4){0.f, 0.f, 0.f, 0.f};
            if (kind < 2) { c4 = *(const f32x4*)(cs + (size_t)row * 32 + j0); s4 = *(const f32x4*)(sn + (size_t)row * 32 + j0); }
            bf16_t* rowp = ob + (size_t)row * pitch + col0;
#pragma unroll
            for (int bj = 0; bj < 2; ++bj) {
                f32x4 v0 = acc[ai][bj][m][0], v1 = acc[ai][bj][m][1];
                if (kind < 2) { const f32x4 o0 = v0 * c4 - v1 * s4, o1 = v1 * c4 + v0 * s4; v0 = o0; v1 = o1; if (kind == 0) { v0 = v0 * C2F; v1 = v1 * C2F; } }
                else if (kind == 3) { v0 = silu4(v0); v1 = silu4(v1); }
                *(u32x4*)(rowp + bj * HALF) = pack8(v0, v1);
            }
        }
}
struct EpiA {
    static constexpr bool PERM = true, AFTER_DRAIN = false;
    bf16_t* base; size_t sub_stride; const float* cs; const float* sn;
    __device__ __forceinline__ void operator()(const f32x4 (&acc)[2][2][4][2], const Unit& u, int wr, int wc, int fr, int fq) const {
        const int t = u.pn >> 2, kind = (t == 9) ? 3 : (t % 3);
        epi_store_rows(acc, kind, base + (size_t)t * sub_stride, 1024, u.pm * BM + wr * 64 + fr, (u.pn & 3) * BM + wc * 32 + 8 * fq, 16 * (wc & 1) + 4 * fq, cs, sn);
    }
};
struct EpiB {
    static constexpr bool PERM = true, AFTER_DRAIN = false;
    bf16_t *Q, *K, *V, *QI, *KI, *G; float* WI; const float* cs; const float* sn;
    __device__ __forceinline__ void operator()(const f32x4 (&acc)[2][2][4][2], const Unit& u, int wr, int wc, int fr, int fq) const {
        const int pn = u.pn, row0 = u.pm * BM + wr * 64 + fr, cw = wc * 32 + 8 * fq, j0 = 16 * (wc & 1) + 4 * fq;
        if (pn < 4)       epi_store_rows(acc, 0, Q, 1024, row0, pn * BM + cw, j0, cs, sn);
        else if (pn == 4) epi_store_rows(acc, 1, K, 256, row0, cw, j0, cs, sn);
        else if (pn == 5) epi_store_rows(acc, 2, V, 256, row0, cw, j0, cs, sn);
        else if (pn < 8)  epi_store_rows(acc, 1, QI, 512, row0, (pn - 6) * BM + cw, j0, cs, sn);
        else if (pn > 8)  epi_store_rows(acc, 3, G, 1024, row0, (pn - 9) * BM + cw, j0, cs, sn);
        else {
#pragma unroll
            for (int ai = 0; ai < 2; ++ai)
#pragma unroll
                for (int m = 0; m < 4; ++m) {
                    const int row = row0 + ai * HALF + m * 16;
                    const f32x4 v0 = acc[ai][0][m][0], v1 = acc[ai][0][m][1];
                    if (wc < 2) {
                        const f32x4 c4 = *(const f32x4*)(cs + (size_t)row * 32 + j0), s4 = *(const f32x4*)(sn + (size_t)row * 32 + j0);
                        *(u32x4*)(KI + (size_t)row * 64 + cw) = pack8(v0 * c4 - v1 * s4, v1 * c4 + v0 * s4);
                    } else if (wc == 2 && fq == 0) {
                        *(f32x4*)(WI + (size_t)row * 8) = v0 * WSC; *(f32x4*)(WI + (size_t)row * 8 + 4) = v1 * WSC;
                    }
                }
        }
    }
};
struct EpiOut {
    static constexpr bool PERM = false, AFTER_DRAIN = false;
    const float* hin; float* hout; const float* gate;
    __device__ __forceinline__ void operator()(const f32x4 (&acc)[2][2][4][2], const Unit& u, int wr, int wc, int fr, int fq) const {
        const int col0 = u.pn * BM + wc * 32 + 4 * fq;
#pragma unroll
        for (int ai = 0; ai < 2; ++ai)
#pragma unroll
            for (int m = 0; m < 4; ++m) {
                const int row = u.pm * BM + ai * HALF + wr * 64 + m * 16 + fr; const int b = row >> 12;
#pragma unroll
                for (int bj = 0; bj < 2; ++bj)
#pragma unroll
                    for (int n = 0; n < 2; ++n) {
                        const int c = col0 + bj * HALF + n * 16;
                        const f32x4 g4 = *(const f32x4*)(gate + (size_t)b * 3072 + c), h4 = *(const f32x4*)(hin + (size_t)row * 1024 + c);
                        *(f32x4*)(hout + (size_t)row * 1024 + c) = h4 + g4 * acc[ai][bj][m][n];
                    }
            }
    }
};

template <class Epi, class Sched, bool ALIGN_EPI = false, bool SP2 = false>
__device__ __forceinline__ void gemm_phase(PG8_LAS unsigned char* lds, const Gemm g, const Sched& S, const Epi& E) {
    int tid_ = threadIdx.x; asm volatile("" : "+v"(tid_));
    const int tid = tid_, wid = __builtin_amdgcn_readfirstlane(tid >> 6), lane = tid & 63, wr = wid >> 2, wc = wid & 3, fr = lane & 15, fq = lane >> 4;
    const int K = g.K, nt = K / BK;
    unsigned voffA[2], voffB[2];
#pragma unroll
    for (int i = 0; i < 2; ++i) { int R, C; stage_rc(tid * 16 + i * 8192, R, C); const int Rb = Epi::PERM ? ((R & ~31) + perm32(R & 31)) : R;
        voffA[i] = (unsigned)(R * K + C) * 2u; voffB[i] = (unsigned)(Rb * K + C) * 2u; }
    const size_t kstep = (size_t)(BK * 2);
    const size_t hstep = (size_t)HALF * K * 2;
    const size_t tstep = 2 * hstep;
    const unsigned ldsw = (unsigned)wid * 1024u;
    const int aoff = lds_byte(wr * 64 + fr, fq * 8), boff = lds_byte(wc * 32 + fr, fq * 8);
#define PG8_SA(b, h) (((b) * 2 + (h)) * HTB)
#define PG8_SB(b, h) ((4 + (b) * 2 + (h)) * HTB)
#define PG8_STAGE(bufoff, gbase, voff) do { _Pragma("unroll") for (int _i = 0; _i < 2; ++_i) \
        __builtin_amdgcn_global_load_lds((const unsigned*)((const char*)(gbase) + (voff)[_i]), (PG8_LAS unsigned*)(lds + (bufoff) + ldsw + _i * 8192), 16, 0, 0); } while (0)
#define PG8_LDA(dst, b, h) do { _Pragma("unroll") for (int m = 0; m < 4; ++m) _Pragma("unroll") for (int k = 0; k < 2; ++k) dst[m][k] = *(const PG8_LAS bf16x8*)(lds + PG8_SA(b, h) + aoff + m * 2048 + k * 1024); } while (0)
#define PG8_LDB(dst, b, h) do { _Pragma("unroll") for (int n = 0; n < 2; ++n) _Pragma("unroll") for (int k = 0; k < 2; ++k) dst[n][k] = *(const PG8_LAS bf16x8*)(lds + PG8_SB(b, h) + boff + n * 2048 + k * 1024); } while (0)
#define PG8_MMA(ai, bj, At, Bt) do { __builtin_amdgcn_s_setprio(1); _Pragma("unroll") for (int m = 0; m < 4; ++m) _Pragma("unroll") for (int n = 0; n < 2; ++n) _Pragma("unroll") for (int k = 0; k < 2; ++k) \
        acc[ai][bj][m][n] = __builtin_amdgcn_mfma_f32_16x16x32_bf16(Bt[n][k], At[m][k], acc[ai][bj][m][n], 0, 0, 0); __builtin_amdgcn_s_setprio(0); } while (0)
#define PG8_WAIT_V(n) asm volatile("s_waitcnt vmcnt(" #n ")" ::: "memory")
#define PG8_WAIT_L(n) asm volatile("s_waitcnt lgkmcnt(" #n ")" ::: "memory")
#define PG8_BAR __builtin_amdgcn_s_barrier()
#define PG8_SCHED __builtin_amdgcn_sched_barrier(0)
    Unit cur, nxt; int ui = 0;
    if (!S.next(0, cur)) return;
    f32x4 acc[2][2][4][2];
#pragma unroll
    for (int a = 0; a < 2; ++a)
#pragma unroll
        for (int b = 0; b < 2; ++b)
#pragma unroll
            for (int m = 0; m < 4; ++m)
#pragma unroll
                for (int n = 0; n < 2; ++n) acc[a][b][m][n] = (f32x4){0.f, 0.f, 0.f, 0.f};
    bf16x8 At[4][2], B0[2][2], B1[2][2];
    const char* cA = (const char*)g.A + (size_t)cur.pm * tstep; const char* cB = (const char*)g.Bt + (size_t)cur.pn * tstep;
    S.a_ready(cur);
    if constexpr (SP2) {
        PG8_STAGE(PG8_SB(0, 0), cB, voffB); PG8_STAGE(PG8_SB(0, 1), cB + hstep, voffB); PG8_STAGE(PG8_SA(0, 0), cA, voffA); PG8_STAGE(PG8_SA(0, 1), cA + hstep, voffA);
        if (wr == 1) PG8_BAR;
        PG8_WAIT_V(2); PG8_BAR;
        PG8_STAGE(PG8_SB(1, 0), cB + kstep, voffB); PG8_STAGE(PG8_SA(1, 0), cA + kstep, voffA); PG8_STAGE(PG8_SB(1, 1), cB + hstep + kstep, voffB);
        PG8_WAIT_V(6); PG8_BAR;
    } else {
        PG8_STAGE(PG8_SB(0, 0), cB, voffB); PG8_STAGE(PG8_SA(0, 0), cA, voffA); PG8_STAGE(PG8_SB(0, 1), cB + hstep, voffB); PG8_STAGE(PG8_SA(0, 1), cA + hstep, voffA);
        if (wr == 1) PG8_BAR;
        PG8_WAIT_V(4); PG8_BAR;
        PG8_STAGE(PG8_SB(1, 0), cB + kstep, voffB); PG8_STAGE(PG8_SA(1, 0), cA + kstep, voffA); PG8_STAGE(PG8_SB(1, 1), cB + hstep + kstep, voffB);
        PG8_WAIT_V(6); PG8_BAR;
    }
    for (;;) {
        const bool has_next = S.next(ui + 1, nxt);
        const char* nA = has_next ? (const char*)g.A + (size_t)nxt.pm * tstep : cA; const char* nB = has_next ? (const char*)g.Bt + (size_t)nxt.pn * tstep : cB;
        for (int t = 0; t < nt; t += 2) {
            const bool last = (t == nt - 2);
            const char* a1 = cA + (size_t)(t + 1) * kstep;
            const char* a2 = last ? nA : cA + (size_t)(t + 2) * kstep; const char* b2 = last ? nB : cB + (size_t)(t + 2) * kstep;
            const char* a3 = a2 + kstep; const char* b3 = b2 + kstep;
            if (last && has_next) S.a_ready(nxt);
            if constexpr (SP2) {
            PG8_LDB(B0, 0, 0); PG8_LDB(B1, 0, 1); PG8_SCHED; PG8_LDA(At, 0, 0); PG8_STAGE(PG8_SA(1, 1), a1 + hstep, voffA);
            PG8_WAIT_V(8); PG8_WAIT_L(0); PG8_BAR; PG8_MMA(0, 0, At, B0); PG8_MMA(0, 1, At, B1); PG8_BAR; PG8_SCHED;
            PG8_LDA(At, 0, 1); PG8_STAGE(PG8_SB(0, 0), b2, voffB); PG8_STAGE(PG8_SB(0, 1), b2 + hstep, voffB); PG8_STAGE(PG8_SA(0, 0), a2, voffA);
            PG8_WAIT_V(8); PG8_WAIT_L(0); PG8_BAR; PG8_MMA(1, 0, At, B0); PG8_MMA(1, 1, At, B1); PG8_BAR; PG8_SCHED;
            PG8_LDB(B0, 1, 0); PG8_LDB(B1, 1, 1); PG8_SCHED; PG8_LDA(At, 1, 0); PG8_STAGE(PG8_SA(0, 1), a2 + hstep, voffA);
            PG8_WAIT_V(8); PG8_WAIT_L(0); PG8_BAR; PG8_MMA(0, 0, At, B0); PG8_MMA(0, 1, At, B1); PG8_BAR; PG8_SCHED;
            PG8_LDA(At, 1, 1); PG8_STAGE(PG8_SB(1, 0), b3, voffB); PG8_STAGE(PG8_SB(1, 1), b3 + hstep, voffB); PG8_STAGE(PG8_SA(1, 0), a3, voffA);
            PG8_WAIT_V(8); PG8_WAIT_L(0); PG8_BAR; PG8_MMA(1, 0, At, B0); PG8_MMA(1, 1, At, B1); PG8_BAR; PG8_SCHED;
            } else {
            PG8_LDB(B0, 0, 0); PG8_SCHED; PG8_LDA(At, 0, 0); PG8_STAGE(PG8_SA(1, 1), a1 + hstep, voffA);
            PG8_WAIT_L(8); PG8_BAR; PG8_WAIT_L(0); PG8_MMA(0, 0, At, B0); PG8_BAR; PG8_SCHED;
            PG8_LDB(B1, 0, 1); PG8_STAGE(PG8_SB(0, 0), b2, voffB);
            PG8_BAR; PG8_WAIT_L(0); PG8_MMA(0, 1, At, B1); PG8_BAR;
            PG8_LDA(At, 0, 1); PG8_STAGE(PG8_SA(0, 0), a2, voffA);
            PG8_BAR; PG8_WAIT_L(0); PG8_MMA(1, 0, At, B0); PG8_BAR; PG8_SCHED;
            PG8_STAGE(PG8_SB(0, 1), b2 + hstep, voffB);
            PG8_WAIT_V(6); PG8_BAR; PG8_MMA(1, 1, At, B1); PG8_BAR;
            PG8_LDB(B0, 1, 0); PG8_SCHED; PG8_LDA(At, 1, 0); PG8_STAGE(PG8_SA(0, 1), a2 + hstep, voffA);
            PG8_WAIT_L(8); PG8_BAR; PG8_WAIT_L(0); PG8_MMA(0, 0, At, B0); PG8_BAR; PG8_SCHED;
            PG8_LDB(B1, 1, 1); PG8_STAGE(PG8_SB(1, 0), b3, voffB);
            PG8_BAR; PG8_WAIT_L(0); PG8_MMA(0, 1, At, B1); PG8_BAR;
            PG8_LDA(At, 1, 1); PG8_STAGE(PG8_SA(1, 0), a3, voffA);
            PG8_BAR; PG8_WAIT_L(0); PG8_MMA(1, 0, At, B0); PG8_BAR; PG8_SCHED;
            PG8_STAGE(PG8_SB(1, 1), b3 + hstep, voffB);
            PG8_WAIT_V(6); PG8_BAR; PG8_MMA(1, 1, At, B1); PG8_BAR;
            }
        }
        if constexpr (ALIGN_EPI) { if (wr == 0) PG8_BAR; }
        if constexpr (!Epi::AFTER_DRAIN) { E(acc, cur, wr, wc, fr, fq); S.done(cur); }
        if (!has_next) break;
#pragma unroll
        for (int a = 0; a < 2; ++a)
#pragma unroll
            for (int b = 0; b < 2; ++b)
#pragma unroll
                for (int m = 0; m < 4; ++m)
#pragma unroll
                    for (int n = 0; n < 2; ++n) acc[a][b][m][n] = (f32x4){0.f, 0.f, 0.f, 0.f};
        cur = nxt; cA = nA; cB = nB; ++ui;
        if constexpr (ALIGN_EPI) { if (wr == 1) PG8_BAR; }
    }
    PG8_WAIT_V(0);
    if constexpr (!ALIGN_EPI) { if (wr == 0) PG8_BAR; }
    PG8_BAR;
    if constexpr (Epi::AFTER_DRAIN) { E.fused(acc, cur, wr, wc, fr, fq, lds, wid, lane); S.done(cur); }
#undef PG8_SA
#undef PG8_SB
#undef PG8_STAGE
#undef PG8_LDA
#undef PG8_LDB
#undef PG8_MMA
#undef PG8_WAIT_V
#undef PG8_WAIT_L
#undef PG8_BAR
#undef PG8_SCHED
}
}
#define GAS __attribute__((address_space(1)))
#define LAS __attribute__((address_space(3)))
typedef unsigned short bf16;
typedef unsigned v4u __attribute__((ext_vector_type(4)));
typedef float f32x4 __attribute__((ext_vector_type(4)));
typedef short bf16x8 __attribute__((ext_vector_type(8)));
typedef GAS unsigned gu32;
typedef GAS unsigned long long gu64;
#define RLX_AGENT __ATOMIC_RELAXED, __HIP_MEMORY_SCOPE_AGENT
#define LDS_WAIT() asm volatile("s_waitcnt lgkmcnt(0)" ::: "memory")
#define VM_WAIT() asm volatile("s_waitcnt vmcnt(0)" ::: "memory")
__device__ __forceinline__ unsigned long long rt() { return __builtin_amdgcn_s_memrealtime(); }
__device__ __forceinline__ unsigned f2bf(float f) { unsigned u = __builtin_bit_cast(unsigned, f); return (u + 0x7fffu + ((u >> 16) & 1u)) >> 16; }
__device__ __forceinline__ unsigned pk2(float lo, float hi) { return f2bf(lo) | (f2bf(hi) << 16); }

#define XB_TMO      128
#define XB_XCNT(j)  (256  + 64 * (j))
#define XB_XSUB(j)  (1280 + 64 * (j))
#define XB_XGEN(j)  (2304 + 64 * (j))
#define XB_TOP      3328
#define XB_TOPGEN   3392
#define XCD_BAR_WORDS 3456
#define XB_SPIN_CAP (1u << 18)

__device__ __forceinline__ unsigned xb_ld(unsigned* p)              { return __hip_atomic_load(p, __ATOMIC_RELAXED, __HIP_MEMORY_SCOPE_AGENT); }
__device__ __forceinline__ unsigned xb_add(unsigned* p, unsigned v) { return __hip_atomic_fetch_add(p, v, __ATOMIC_RELAXED, __HIP_MEMORY_SCOPE_AGENT); }
__device__ __forceinline__ unsigned xb_xcc_id() { return (unsigned)__builtin_amdgcn_s_getreg((3 << 11) | 20) & 0xFu; }
#define XB_SPIN(cond, bar) do { unsigned _sp = 0; while (cond) { __builtin_amdgcn_s_sleep(1); \
    if ((++_sp & 255u) == 0u) { if (xb_ld(&(bar)[XB_TMO])) break; if (_sp > XB_SPIN_CAP) { atomicAdd(&(bar)[XB_TMO], 1u); break; } } } } while (0)

struct XcdBarrier {
    unsigned* bar; unsigned x;
    volatile LAS unsigned* st;
};

__device__ __forceinline__ XcdBarrier xcd_barrier_post(unsigned* bar, volatile LAS unsigned* st) {
    XcdBarrier b; b.bar = bar; b.x = xb_xcc_id(); b.st = st;
    if (threadIdx.x == 0) (void)xb_add(&bar[XB_XCNT(b.x)], 1u);
    return b;
}
__device__ __forceinline__ void xcd_barrier_complete(unsigned* bar, unsigned x, unsigned& nloc, unsigned& nx) {
    const unsigned G = gridDim.x * gridDim.y * gridDim.z;
    unsigned sum, cnt, mine, sp = 0u;
    for (;;) {
        sum = 0u; cnt = 0u; mine = 0u;
#pragma unroll
        for (unsigned j = 0; j < 16; ++j) { const unsigned c = xb_ld(&bar[XB_XCNT(j)]); sum += c; cnt += (c > 0u) ? 1u : 0u; mine = (j == x) ? c : mine; }
        if (sum == G) break;
        __builtin_amdgcn_s_sleep(1);
        if ((++sp & 255u) == 0u) { if (xb_ld(&bar[XB_TMO])) break; if (sp > XB_SPIN_CAP) { atomicAdd(&bar[XB_TMO], 1u); break; } }
    }
    nloc = mine > 0u ? mine : 1u; nx = cnt > 0u ? cnt : 1u;
}

__device__ __forceinline__ void xcd_barrier(const XcdBarrier& b) {
    asm volatile("s_waitcnt vmcnt(0)" ::: "memory");
    __syncthreads();
    if (threadIdx.x == 0) {
        unsigned* bar = b.bar;
        __builtin_amdgcn_s_waitcnt(0);
        unsigned nloc = b.st[0], nx = b.st[1];
        if (nloc == 0u) { xcd_barrier_complete(bar, b.x, nloc, nx); b.st[0] = nloc; b.st[1] = nx; }
        const unsigned old = xb_add(&bar[XB_XSUB(b.x)], 1u);
        const unsigned gen = old / nloc;
        if (old + 1u == (gen + 1u) * nloc) {
            __builtin_amdgcn_fence(__ATOMIC_RELEASE, "agent");
            asm volatile("s_waitcnt vmcnt(0)" ::: "memory");
            const unsigned og = xb_add(&bar[XB_TOP], 1u);
            const unsigned tg = og / nx;
            if (og + 1u == (tg + 1u) * nx) xb_add(&bar[XB_TOPGEN], 1u);
            else XB_SPIN(xb_ld(&bar[XB_TOPGEN]) == tg, bar);
            __builtin_amdgcn_fence(__ATOMIC_ACQUIRE, "agent");
            xb_add(&bar[XB_XGEN(b.x)], 1u);
            asm volatile("s_waitcnt vmcnt(0)" ::: "memory");
        } else {
            XB_SPIN(xb_ld(&bar[XB_XGEN(b.x)]) == gen, bar);
            __builtin_amdgcn_fence(__ATOMIC_ACQUIRE, "agent");
            asm volatile("s_waitcnt vmcnt(0)" ::: "memory");
        }
    }
    __syncthreads();
}

constexpr int NWAVES = 8;
constexpr int NB = 8, SEQ = 4096, DM = 1024, MTOK = NB * SEQ;
constexpr int A_N = 10240, B_NL = 3144, B_NP = 3328;
constexpr int MC = 16384, NCHUNK = MTOK / MC;
constexpr float NORM_EPS = 1e-6f;
#ifndef PMASK
#define PMASK 0xffff
#endif
#define P_ON(k) ((PMASK >> (k)) & 1)
#ifndef MK_ONE_LAUNCH
#define MK_ONE_LAUNCH 1
#endif
constexpr int N_SEAMS = 1 + 2 * ((1 + 3 * NCHUNK + 1) + 5);

constexpr size_t MiB = 1u << 20;
constexpr size_t WS_CTL = 0, CTL_ZERO_BYTES = 1 * MiB;
constexpr size_t WS_MOD = 1 * MiB;
constexpr size_t WS_COS = 2 * MiB, WS_SIN = 6 * MiB;
constexpr size_t WS_WA = 10 * MiB;
constexpr size_t WS_WB = 50 * MiB;
constexpr size_t WS_WO = 63 * MiB;
constexpr size_t WS_U = 72 * MiB;
constexpr size_t WS_ACT = 136 * MiB;
constexpr size_t A_SUB = (size_t)MC * 1024 * 2;
constexpr size_t WS_LSE = WS_ACT + 10 * A_SUB;
constexpr size_t WS_END_A = WS_LSE + (size_t)3 * MC * 16 * 4;
constexpr size_t WS_BQ = WS_ACT, WS_BK = WS_BQ + 64 * MiB, WS_BV = WS_BK + 16 * MiB, WS_BQI = WS_BV + 16 * MiB, WS_BKI = WS_BQI + 32 * MiB,
                 WS_BWI = WS_BKI + 4 * MiB, WS_BG = WS_BWI + 2 * MiB, WS_BMASK = WS_BG + 64 * MiB, WS_END_B = WS_BMASK + 16 * MiB;
constexpr size_t WS_NEED = (WS_END_A > WS_END_B ? WS_END_A : WS_END_B);
static_assert(WS_WA + (size_t)2 * A_N * 1024 * 2 <= WS_WB && WS_WB + (size_t)2 * B_NP * 1024 * 2 <= WS_WO && WS_WO + (size_t)4 * 1024 * 1024 * 2 <= WS_U && WS_U + (size_t)MTOK * 1024 * 2 <= WS_ACT, "ws map");
constexpr int CW_BAR = 4096;

constexpr int RING_BYTES = 131072;
constexpr int SEL_HIST_OFF = 131072, SEL_STAGE_OFF = 131072 + 8192, MISC_OFF = 131072 + 8192 + 4096, LDS_BYTES = 147456;
static_assert(MISC_OFF + 256 <= LDS_BYTES, "LDS map");

typedef short s16x4 __attribute__((ext_vector_type(4)));
typedef short v4i16_t __attribute__((ext_vector_type(4)));
typedef float f32x16 __attribute__((ext_vector_type(16)));
typedef unsigned u32x2 __attribute__((ext_vector_type(2)));
__device__ __forceinline__ float wave_sum(float v) {
#pragma unroll
    for (int o = 1; o < 64; o <<= 1) v += __shfl_xor(v, o);
    return v;
}
__device__ __forceinline__ unsigned cvtpk(float lo, float hi) { unsigned r; asm volatile("v_cvt_pk_bf16_f32 %0, %1, %2" : "=v"(r) : "v"(lo), "v"(hi)); return r; }
__device__ __forceinline__ float bf_lo(unsigned w) { return __uint_as_float(w << 16); }
__device__ __forceinline__ float bf_hi(unsigned w) { return __uint_as_float(w & 0xffff0000u); }
__device__ __forceinline__ float swap_max(float m) { auto rr = __builtin_amdgcn_permlane32_swap(__float_as_uint(m), __float_as_uint(m), false, false); return fmaxf(__uint_as_float(rr[0]), __uint_as_float(rr[1])); }
__device__ __forceinline__ float swap_sum(float m) { auto rr = __builtin_amdgcn_permlane32_swap(__float_as_uint(m), __float_as_uint(m), false, false); return __uint_as_float(rr[0]) + __uint_as_float(rr[1]); }
__device__ __forceinline__ int crow(int r, int hi) { return (r & 3) + 8 * (r >> 2) + 4 * hi; }
__device__ __forceinline__ unsigned vimg(unsigned row, unsigned ch) { return row * 128u + 16u * (ch ^ ((row & 3u) | (((row >> 1) & 1u) << 2))); }
__device__ __forceinline__ unsigned kimg(unsigned row, unsigned ch) { return row * 128u + 16u * (ch ^ ((row >> 1) & 7u)); }
__device__ __forceinline__ s16x4 vtr(const LAS unsigned char* p) { return __builtin_bit_cast(s16x4, __builtin_amdgcn_ds_read_tr16_b64_v4i16((LAS v4i16_t*)p)); }
#define MFMA32(a, b, c) __builtin_amdgcn_mfma_f32_32x32x16_bf16((a), (b), (c), 0, 0, 0)

struct Frame {
    LAS unsigned char* lds; volatile LAS unsigned* MISC; gu32* ctl;
    int tid, lane, wave, vcu, G;
};
struct Args { const float* in[11]; const int* pos; float* out; unsigned char* ws; int seg; int pad; };
typedef const Args __attribute__((address_space(4)))* cargs_t;

__device__ __forceinline__ int rope_perm64(int c) { return ((c & 31) >> 2) * 8 + (c & 3) + ((c >> 5) << 2); }
template <int KIND> __device__ __forceinline__ int phys_row(int n) {
    if (KIND == 0) { if (n < 9216 && ((n >> 10) % 3) < 2) return (n & ~63) + rope_perm64(n & 63); return n; }
    if (KIND == 1) { if (n < 1280 || (n >= 1536 && n < 2112)) return (n & ~63) + rope_perm64(n & 63); if (n >= 2120) return n + 184; return n; }
    return n;
}
template <int KIND> __device__ __forceinline__ void transpose_item(const float* W, int K, int N, bf16* WT, LAS float* scr, int item, int lane) {
    const int nblk = (N + 31) / 32, kb = item / nblk, nb = item % nblk, k0 = 64 * kb, n0 = 32 * nb;
    const bool nok = n0 + (lane & 31) < N;
#pragma unroll 8
    for (int i = 0; i < 32; ++i) { const int kk = 2 * i + (lane >> 5); scr[kk * 33 + (lane & 31)] = nok ? W[(size_t)(k0 + kk) * N + n0 + (lane & 31)] : 0.f; }
    LDS_WAIT(); asm volatile("" ::: "memory");
    const int c = lane & 7;
#pragma unroll
    for (int j = 0; j < 4; ++j) { const int n = (lane >> 3) + 8 * j; const LAS float* s = scr + (8 * c) * 33 + n;
        v4u o; o.x = pk2(s[0 * 33], s[1 * 33]); o.y = pk2(s[2 * 33], s[3 * 33]); o.z = pk2(s[4 * 33], s[5 * 33]); o.w = pk2(s[6 * 33], s[7 * 33]);
        if (n0 + n < N) *(GAS v4u*)(WT + (size_t)phys_row<KIND>(n0 + n) * K + k0 + 8 * c) = o; }
    LDS_WAIT(); asm volatile("" ::: "memory");
}
__constant__ float INVF[32] = {1.000000000e+00f, 7.498942614e-01f, 5.623413324e-01f, 4.216965139e-01f, 3.162277639e-01f, 2.371373773e-01f, 1.778279394e-01f, 1.333521307e-01f, 1.000000015e-01f, 7.498941571e-02f,
    5.623413250e-02f, 4.216965288e-02f, 3.162277490e-02f, 2.371373773e-02f, 1.778279431e-02f, 1.333521493e-02f, 9.999999776e-03f, 7.498941850e-03f, 5.623413250e-03f, 4.216964822e-03f, 3.162277630e-03f, 2.371373586e-03f,
    1.778279431e-03f, 1.333521446e-03f, 1.000000047e-03f, 7.498942432e-04f, 5.623413017e-04f, 4.216965172e-04f, 3.162277571e-04f, 2.371373703e-04f, 1.778279402e-04f, 1.333521504e-04f};

__device__ __forceinline__ void p_prologue(Frame& F, cargs_t ap) {
    const float* const* in_ = nullptr; (void)in_;
    struct { const float* in[11]; const int* pos; unsigned char* ws; } a;
#pragma unroll
    for (int i = 0; i < 11; ++i) a.in[i] = ap->in[i];
    a.pos = ap->pos; a.ws = ap->ws;
    unsigned char* ws = a.ws;
    LAS float* scr = (LAS float*)(F.lds + F.wave * 12288);
    const int gw = F.vcu * NWAVES + F.wave, NGW = F.G * NWAVES;
    constexpr int I_A = 16 * (A_N / 32), I_B = 16 * ((B_NL + 31) / 32), I_O = 16 * 32;
    constexpr int NITEMS = 2 * I_A + 2 * I_B + 4 * I_O;
    for (int it = gw; it < NITEMS; it += NGW) {
        int r = it;
        if (r < 2 * I_A) { const int l = r / I_A; transpose_item<0>(a.in[6] + (size_t)l * 1024 * A_N, 1024, A_N, (bf16*)(ws + WS_WA) + (size_t)l * A_N * 1024, scr, r % I_A, F.lane); continue; } r -= 2 * I_A;
        if (r < 2 * I_B) { const int l = r / I_B; transpose_item<1>(a.in[8] + (size_t)l * 1024 * B_NL, 1024, B_NL, (bf16*)(ws + WS_WB) + (size_t)l * B_NP * 1024, scr, r % I_B, F.lane); continue; } r -= 2 * I_B;
        { const int l = r / I_O;
          const float* W = ((l & 1) ? a.in[9] : a.in[7]) + (size_t)(l >> 1) * 1024 * 1024;
          transpose_item<2>(W, 1024, 1024, (bf16*)(ws + WS_WO) + (size_t)l * 1024 * 1024, scr, r % I_O, F.lane); }
    }
    { const int gt = (F.vcu * NWAVES + F.wave) * 64 + F.lane, NGT = NGW * 64;
      for (int i = gt; i < 2 * 184 * 128; i += NGT) { const int l = i / (184 * 128), rr = (i / 128) % 184, c = i % 128;
          *(GAS v4u*)((bf16*)(ws + WS_WB) + (size_t)l * B_NP * 1024 + (size_t)(2120 + rr) * 1024 + c * 8) = (v4u){0u, 0u, 0u, 0u}; }
      float* cs = (float*)(ws + WS_COS); float* sn = (float*)(ws + WS_SIN);
      for (int i = gt; i < MTOK * 32; i += NGT) { const int tok = i >> 5, j = i & 31;
          const float angf = (float)a.pos[tok] * INVF[j]; const double x = (double)angf;
          const double k = __builtin_rint(x * 0.15915494309189535); double r = __builtin_fma(-k, 6.283185307179586, x); r = __builtin_fma(-k, 2.4492935982947064e-16, r);
          const float rf = (float)r; cs[i] = __cosf(rf); sn[i] = __sinf(rf); }
    }
    { LAS float* cact = (LAS float*)(F.lds + 98304);
      for (int i = F.tid; i < 8 * 1024; i += NWAVES * 64) { const float v = a.in[1][i]; cact[i] = v / (1.f + __expf(-v)); }
      __syncthreads();
      const float* adaw = a.in[4]; const float* adab = a.in[5]; float* mod = (float*)(ws + WS_MOD);
      const int col = F.lane & 15, kq = F.lane >> 4;
      for (int it = gw; it < 4 * 192; it += NGW) { const int l = it / 192, n0 = (it % 192) * 16;
          float acc[8];
#pragma unroll
          for (int b = 0; b < 8; ++b) acc[b] = 0.f;
          const float* wp = adaw + (size_t)l * 1024 * 3072 + (size_t)(kq * 256) * 3072 + n0 + col;
#pragma unroll 32
          for (int k = 0; k < 256; ++k) { const float w = wp[(size_t)k * 3072];
#pragma unroll
              for (int b = 0; b < 8; ++b) acc[b] += cact[b * 1024 + kq * 256 + k] * w; }
#pragma unroll
          for (int b = 0; b < 8; ++b) { float v = acc[b]; v += __shfl_xor(v, 16); v += __shfl_xor(v, 32); acc[b] = v; }
          if (kq == 0) {
#pragma unroll
              for (int b = 0; b < 8; ++b) mod[((size_t)l * 8 + b) * 3072 + n0 + col] = acc[b] + adab[(size_t)l * 3072 + n0 + col]; }
      }
    }
}

__device__ __forceinline__ void p_norm_mod(Frame& F, const float* hin, const float* g, const float* mod_l, bf16* U) {
    const int gw = F.vcu * NWAVES + F.wave, NGW = F.G * NWAVES;
    for (int r0 = gw * 16; r0 < MTOK; r0 += NGW * 16) {
        const int b = r0 >> 12;
        f32x4 A[4], Bv[4];
#pragma unroll
        for (int j = 0; j < 4; ++j) { const int c = 4 * F.lane + 256 * j; const f32x4 gg = *(const f32x4*)(g + c), sc = *(const f32x4*)(mod_l + (size_t)b * 3072 + 1024 + c);
            A[j] = gg * (sc + 1.0f); Bv[j] = *(const f32x4*)(mod_l + (size_t)b * 3072 + c); }
        for (int rr = 0; rr < 16; ++rr) {
            const int row = r0 + rr; const GAS f32x4* xr = (const GAS f32x4*)(hin + (size_t)row * DM) + F.lane;
            f32x4 v[4]; float s = 0.f;
#pragma unroll
            for (int j = 0; j < 4; ++j) { v[j] = xr[64 * j]; s += (v[j].x * v[j].x + v[j].y * v[j].y) + (v[j].z * v[j].z + v[j].w * v[j].w); }
            const float rstd = 1.0f / sqrtf(wave_sum(s) * (1.f / DM) + NORM_EPS);
            GAS u32x2* o8 = (GAS u32x2*)(U + (size_t)row * DM) + F.lane;
#pragma unroll
            for (int j = 0; j < 4; ++j) { const f32x4 y = (v[j] * rstd) * A[j] + Bv[j]; o8[64 * j] = (u32x2){cvtpk(y.x, y.y), cvtpk(y.z, y.w)}; }
        }
    }
}
__device__ __forceinline__ void p_final_norm(Frame& F, const float* hin, const float* g, float* out) {
    const int gw = F.vcu * NWAVES + F.wave, NGW = F.G * NWAVES;
    f32x4 A[4];
#pragma unroll
    for (int j = 0; j < 4; ++j) A[j] = *(const f32x4*)(g + 4 * F.lane + 256 * j);
    for (int row = gw; row < MTOK; row += NGW) {
        const GAS f32x4* xr = (const GAS f32x4*)(hin + (size_t)row * DM) + F.lane;
        f32x4 v[4]; float s = 0.f;
#pragma unroll
        for (int j = 0; j < 4; ++j) { v[j] = xr[64 * j]; s += (v[j].x * v[j].x + v[j].y * v[j].y) + (v[j].z * v[j].z + v[j].w * v[j].w); }
        const float rstd = 1.0f / sqrtf(wave_sum(s) * (1.f / DM) + NORM_EPS);
        GAS f32x4* o = (GAS f32x4*)(out + (size_t)row * DM) + F.lane;
#pragma unroll
        for (int j = 0; j < 4; ++j) o[64 * j] = (v[j] * rstd) * A[j];
    }
}

__device__ __forceinline__ void attnA_tile(bf16* Qp, const bf16* Kp, const bf16* Vp, float* lsep, int lse_stride, int rstride, int i0, LAS unsigned char* vst, int lane) {
    const int q32 = lane & 31, hi = lane >> 5;
    bf16x8 qf[4];
    { const bf16* qrow = Qp + (size_t)(i0 + q32) * rstride + 8 * hi;
#pragma unroll
      for (int ks = 0; ks < 4; ++ks) qf[ks] = *(const bf16x8*)(qrow + 16 * ks); }
    f32x16 o0 = {}, o1 = {};
    float m_run = -INFINITY, l_run = 0.f;
    const int kt0 = (i0 >= 128) ? 0 : (128 - i0) / 32;
    bf16x8 kf[4]; v4u vr[4];
    const int vc = lane & 7, vrow = lane >> 3;
#define ATT_LOADKV(kb_) do { const bf16* kr_ = Kp + (size_t)((kb_) + q32) * rstride + 8 * hi; \
        _Pragma("unroll") for (int ks = 0; ks < 4; ++ks) kf[ks] = *(const bf16x8*)(kr_ + 16 * ks); \
        _Pragma("unroll") for (int i = 0; i < 4; ++i) vr[i] = *(const v4u*)(Vp + (size_t)((kb_) + vrow + 8 * i) * rstride + 8 * vc); } while (0)
    ATT_LOADKV(i0 - 128 + 32 * kt0);
    const int q4 = (lane & 15) >> 2, blk = (lane >> 4) & 1, p4 = lane & 3;
    for (int kt = kt0; kt < 5; ++kt) {
#pragma unroll
        for (int i = 0; i < 4; ++i) *(LAS v4u*)(vst + vimg(vrow + 8 * i, vc)) = vr[i];
        bf16x8 kc[4];
#pragma unroll
        for (int ks = 0; ks < 4; ++ks) kc[ks] = kf[ks];
        if (kt + 1 < 5) ATT_LOADKV(i0 - 128 + 32 * (kt + 1));
        f32x16 p = {};
#pragma unroll
        for (int ks = 0; ks < 4; ++ks) p = MFMA32(kc[ks], qf[ks], p);
        if (kt == 0) {
#pragma unroll
            for (int r = 0; r < 16; ++r) if (crow(r, hi) < q32) p[r] = -INFINITY;
        }
        if (kt == 4) {
#pragma unroll
            for (int r = 0; r < 16; ++r) if (crow(r, hi) > q32) p[r] = -INFINITY;
        }
        float mt = p[0];
#pragma unroll
        for (int r = 1; r < 16; ++r) mt = fmaxf(mt, p[r]);
        mt = swap_max(mt);
        const float m_new = fmaxf(m_run, mt);
        const float alpha = __builtin_amdgcn_exp2f(m_run - m_new);
        float s = 0.f;
#pragma unroll
        for (int r = 0; r < 16; ++r) { p[r] = __builtin_amdgcn_exp2f(p[r] - m_new); s += p[r]; }
        l_run = l_run * alpha + s; m_run = m_new;
#pragma unroll
        for (int r = 0; r < 16; ++r) { o0[r] *= alpha; o1[r] *= alpha; }
        bf16x8 pf[2];
#pragma unroll
        for (int ks = 0; ks < 2; ++ks) { v4u w; w.x = cvtpk(p[8 * ks + 0], p[8 * ks + 1]); w.y = cvtpk(p[8 * ks + 2], p[8 * ks + 3]); w.z = cvtpk(p[8 * ks + 4], p[8 * ks + 5]); w.w = cvtpk(p[8 * ks + 6], p[8 * ks + 7]); pf[ks] = __builtin_bit_cast(bf16x8, w); }
        LDS_WAIT(); asm volatile("" ::: "memory");
#pragma unroll
        for (int ks = 0; ks < 2; ++ks)
#pragma unroll
            for (int d0 = 0; d0 < 2; ++d0) {
                const s16x4 lo = vtr(vst + vimg(16 * ks + 4 * hi + q4, 4 * d0 + 2 * blk + (p4 >> 1)) + 8 * (p4 & 1));
                const s16x4 up = vtr(vst + vimg(16 * ks + 8 + 4 * hi + q4, 4 * d0 + 2 * blk + (p4 >> 1)) + 8 * (p4 & 1));
                const bf16x8 vf = (bf16x8){lo[0], lo[1], lo[2], lo[3], up[0], up[1], up[2], up[3]};
                if (d0 == 0) o0 = MFMA32(vf, pf[ks], o0); else o1 = MFMA32(vf, pf[ks], o1);
            }
        LDS_WAIT(); asm volatile("" ::: "memory");
    }
#undef ATT_LOADKV
    const float l_tot = swap_sum(l_run), inv = 1.0f / l_tot;
    bf16* orow = Qp + (size_t)(i0 + q32) * rstride;
#pragma unroll
    for (int g4 = 0; g4 < 4; ++g4) {
        *(u32x2*)(orow + 8 * g4 + 4 * hi) = (u32x2){cvtpk(o0[4 * g4] * inv, o0[4 * g4 + 1] * inv), cvtpk(o0[4 * g4 + 2] * inv, o0[4 * g4 + 3] * inv)};
        *(u32x2*)(orow + 32 + 8 * g4 + 4 * hi) = (u32x2){cvtpk(o1[4 * g4] * inv, o1[4 * g4 + 1] * inv), cvtpk(o1[4 * g4 + 2] * inv, o1[4 * g4 + 3] * inv)};
    }
    if (hi == 0) lsep[(size_t)(i0 + q32) * lse_stride] = m_run + __builtin_amdgcn_logf(l_tot);
}
__device__ __forceinline__ void p_attnA(Frame& F, bf16* act, float* lse) {
    LAS unsigned char* vst = F.lds + F.wave * 4096;
    constexpr int NBL = MC / SEQ, NUNITS = NBL * 3 * 16 * 16;
    for (int u = blockIdx.x; u < NUNITS; u += F.G) {
        const int cb = u & 15, h = (u >> 4) & 15, g = (u >> 8) % 3, bl = u / 768;
        const int dl = (g == 0) ? 1 : (g == 1 ? 4 : 16), nbk = 16 / dl;
        const int r = cb / nbk, bk = cb % nbk;
        const size_t row_base = (size_t)bl * SEQ + r;
        bf16* Qp = act + (size_t)(3 * g + 0) * (A_SUB / 2) + row_base * 1024 + h * 64;
        const bf16* Kp = act + (size_t)(3 * g + 1) * (A_SUB / 2) + row_base * 1024 + h * 64;
        const bf16* Vp = act + (size_t)(3 * g + 2) * (A_SUB / 2) + row_base * 1024 + h * 64;
        float* lsep = lse + ((size_t)g * MC + row_base) * 16 + h;
        attnA_tile(Qp, Kp, Vp, lsep, 16 * dl, dl * 1024, bk * 256 + 32 * F.wave, vst, F.lane);
    }
}
__device__ __forceinline__ void p_mergeA(Frame& F, const bf16* act, const float* lse, bf16* Z  ) {
    const int gw = F.vcu * NWAVES + F.wave, NGW = F.G * NWAVES;
    const int head = F.lane >> 2;
    for (int row = gw; row < MC; row += NGW) {
        float l0 = lse[((size_t)0 * MC + row) * 16 + head], l1 = lse[((size_t)1 * MC + row) * 16 + head], l2 = lse[((size_t)2 * MC + row) * 16 + head];
        const float mx = fmaxf(l0, fmaxf(l1, l2));
        float e0 = __builtin_amdgcn_exp2f(l0 - mx), e1 = __builtin_amdgcn_exp2f(l1 - mx), e2 = __builtin_amdgcn_exp2f(l2 - mx);
        const float inv = 1.0f / (e0 + e1 + e2); e0 *= inv; e1 *= inv; e2 *= inv;
#pragma unroll
        for (int hf = 0; hf < 2; ++hf) {
            const size_t off = (size_t)row * 1024 + 16 * F.lane + 8 * hf;
            const v4u a0 = *(const v4u*)(act + (size_t)0 * (A_SUB / 2) + off), a1 = *(const v4u*)(act + (size_t)3 * (A_SUB / 2) + off), a2 = *(const v4u*)(act + (size_t)6 * (A_SUB / 2) + off),
                      gg = *(const v4u*)(act + (size_t)9 * (A_SUB / 2) + off);
            v4u o;
#pragma unroll
            for (int k = 0; k < 4; ++k) {
                const float ylo = (e0 * bf_lo(a0[k]) + e1 * bf_lo(a1[k]) + e2 * bf_lo(a2[k])) * bf_lo(gg[k]);
                const float yhi = (e0 * bf_hi(a0[k]) + e1 * bf_hi(a1[k]) + e2 * bf_hi(a2[k])) * bf_hi(gg[k]);
                o[k] = cvtpk(ylo, yhi);
            }
            *(v4u*)(Z + off) = o;
        }
    }
}

__device__ __forceinline__ unsigned ordkey(float f) { unsigned u = __float_as_uint(f); if ((u << 1) == 0u) u = 0u; return (u & 0x80000000u) ? ~u : (u | 0x80000000u); }
__device__ __forceinline__ void index_tile(Frame& F, int b, int t0, const bf16* QI, const bf16* KI, const float* WI, unsigned long long* maskw) {
    LAS float* sc = (LAS float*)F.lds;
    LAS unsigned* hist = (LAS unsigned*)(F.lds + SEL_HIST_OFF) + F.wave * 256;
    LAS unsigned long long* stage = (LAS unsigned long long*)(F.lds + SEL_STAGE_OFF);
    const int lane = F.lane, c32 = lane & 31, hi = lane >> 5;
    const size_t tok0 = (size_t)b * SEQ + t0;
    {
        bf16x8 qf[2][4]; f32x4 wv[2][2][2];
        const int tl = 2 * ((c32 >> 2) & 1) + (c32 >> 4), hd = ((c32 >> 3) & 1) * 4 + (c32 & 3);
#pragma unroll
        for (int R = 0; R < 2; ++R) {
            const bf16* qp = QI + (tok0 + 4 * R + tl) * 512 + hd * 64 + 8 * hi;
#pragma unroll
            for (int ks = 0; ks < 4; ++ks) qf[R][ks] = *(const bf16x8*)(qp + 16 * ks);
#pragma unroll
            for (int tt = 0; tt < 2; ++tt) { const float* wp = WI + (tok0 + 4 * R + 2 * hi + tt) * 8; wv[R][tt][0] = *(const f32x4*)wp; wv[R][tt][1] = *(const f32x4*)(wp + 4); }
        }
        const int nkt = (t0 + 8 + 31) >> 5;
        bf16x8 kf[4];
        const bf16* kbase = KI + ((size_t)b * SEQ + c32) * 64 + 8 * hi;
        int kt = F.wave;
        if (kt < nkt) {
#pragma unroll
            for (int ks = 0; ks < 4; ++ks) kf[ks] = *(const bf16x8*)(kbase + (size_t)kt * 32 * 64 + 16 * ks);
        }
        for (; kt < nkt; kt += NWAVES) {
            bf16x8 kc[4];
#pragma unroll
            for (int ks = 0; ks < 4; ++ks) kc[ks] = kf[ks];
            if (kt + NWAVES < nkt) {
#pragma unroll
                for (int ks = 0; ks < 4; ++ks) kf[ks] = *(const bf16x8*)(kbase + (size_t)(kt + NWAVES) * 32 * 64 + 16 * ks);
            }
#pragma unroll
            for (int R = 0; R < 2; ++R) {
                f32x16 acc = {};
#pragma unroll
                for (int ks = 0; ks < 4; ++ks) acc = MFMA32(qf[R][ks], kc[ks], acc);
#pragma unroll
                for (int tt = 0; tt < 2; ++tt) {
                    float s = 0.f;
#pragma unroll
                    for (int i = 0; i < 8; ++i) s += wv[R][tt][i >> 2][i & 3] * fmaxf(acc[8 * tt + i], 0.f);
                    sc[(4 * R + 2 * hi + tt) * 4096 + kt * 32 + c32] = s;
                }
            }
        }
    }
    __syncthreads();
    {
        const int t = t0 + F.wave, n = t + 1;
        const LAS float* scq = sc + F.wave * 4096;
        unsigned T = 0u; int kk = 0; const bool all = n <= 256;
        if (!all) {
            unsigned prefix = 0u; kk = 256;
#pragma unroll
            for (int pass = 0; pass < 4; ++pass) {
                const int shift = 24 - 8 * pass;
                *(LAS v4u*)(hist + 4 * lane) = (v4u){0u, 0u, 0u, 0u};
                LDS_WAIT(); asm volatile("" ::: "memory");
                for (int s = lane; s < n; s += 64) {
                    const unsigned key = ordkey(scq[s]);
                    const bool in = (pass == 0) ? true : ((key >> ((shift + 8) & 31)) == prefix);
                    if (in) __hip_atomic_fetch_add(hist + ((key >> shift) & 255u), 1u, __ATOMIC_RELAXED, __HIP_MEMORY_SCOPE_WORKGROUP);
                }
                LDS_WAIT(); asm volatile("" ::: "memory");
                const v4u c = *(const LAS v4u*)(hist + 4 * lane);
                const unsigned ls = c.x + c.y + c.z + c.w;
                unsigned inc = ls;
#pragma unroll
                for (int o = 1; o < 64; o <<= 1) { const unsigned v = __shfl_up(inc, o); if (lane >= o) inc += v; }
                const unsigned total = __shfl(inc, 63);
                const unsigned S = total - inc;
                const bool found = (S < (unsigned)kk) && ((unsigned)kk <= S + ls);
                unsigned acc = S; int bin; unsigned above;
                if (acc + c.w >= (unsigned)kk) { bin = 3; above = acc; }
                else { acc += c.w; if (acc + c.z >= (unsigned)kk) { bin = 2; above = acc; }
                else { acc += c.z; if (acc + c.y >= (unsigned)kk) { bin = 1; above = acc; }
                else { acc += c.y; bin = 0; above = acc; } } }
                const unsigned long long fm = __ballot(found);
                const int src = fm ? (__ffsll((long long)fm) - 1) : 0;
                const int binb = __shfl(4 * lane + bin, src); const unsigned aboveb = __shfl(above, src);
                prefix = (prefix << 8) | (unsigned)binb; kk -= (int)aboveb;
            }
            T = prefix;
        }
        unsigned taken = 0u; unsigned long long myword = 0ull;
        for (int j = 0; j < 64; ++j) {
            bool sel = false;
            if (64 * j < n) {
                const int s = 64 * j + lane; const bool v = s < n;
                if (all) sel = v;
                else {
                    const unsigned key = v ? ordkey(scq[s]) : 0u;
                    const bool gt = v && key > T, eq = v && key == T;
                    const unsigned long long em = __ballot(eq);
                    const unsigned rank = taken + (unsigned)__popcll(em & ((1ull << lane) - 1ull));
                    sel = gt || (eq && rank < (unsigned)kk);
                    taken += (unsigned)__popcll(em);
                }
            }
            const unsigned long long w = __ballot(sel);
            if (lane == j) myword = w;
        }
        stage[F.wave * 64 + lane] = myword;
    }
    __syncthreads();
    { const int j = F.tid >> 3, tq = F.tid & 7; maskw[((size_t)b * 64 + j) * 4096 + t0 + tq] = stage[tq * 64 + j]; }
}
__device__ __forceinline__ void p_index(Frame& F, const bf16* QI, const bf16* KI, const float* WI, unsigned long long* maskw) {
    for (int L = F.vcu; L < 4096; L += F.G) {
        const int i = L >> 8, v = L & 255, b = i >> 1, tt = (i & 1) ? 511 - v : v;
        index_tile(F, b, tt * 8, QI, KI, WI, maskw);
    }
}

__device__ __forceinline__ void attnB_unit(Frame& F, int b, int kvh, int blkq, const bf16* Q, const bf16* K, const bf16* V, const bf16* G, const unsigned long long* maskw, bf16* Z) {
    const int lane = F.lane, q32 = lane & 31, hi = lane >> 5, w = F.wave;
    const int head = 4 * kvh + (w >> 1), tok = blkq * 64 + 32 * (w & 1) + q32;
    const size_t grow = (size_t)b * SEQ + tok;
    const int NT = blkq + 1;
    bf16x8 qf[4];
    { const bf16* qrow = Q + grow * 1024 + head * 64 + 8 * hi;
#pragma unroll
      for (int ks = 0; ks < 4; ++ks) qf[ks] = *(const bf16x8*)(qrow + 16 * ks); }
    LAS unsigned char* Kb = F.lds; LAS unsigned char* Vb = F.lds + 16384;
    const int srow = F.tid >> 3, sch = F.tid & 7;
    const bf16* ksrc = K + ((size_t)b * SEQ + srow) * 256 + kvh * 64 + 8 * sch;
    const bf16* vsrc = V + ((size_t)b * SEQ + srow) * 256 + kvh * 64 + 8 * sch;
    const unsigned long long* mp = maskw + (size_t)b * 64 * 4096 + tok;
    v4u kreg = *(const v4u*)ksrc, vreg = *(const v4u*)vsrc;
    unsigned long long mw_next = mp[0];
    *(LAS v4u*)(Kb + kimg(srow, sch)) = kreg; *(LAS v4u*)(Vb + vimg(srow, sch)) = vreg;
    __syncthreads();
    f32x16 o0 = {}, o1 = {};
    float m_run = -INFINITY, l_run = 0.f;
    const int q4 = (lane & 15) >> 2, blk = (lane >> 4) & 1, p4 = lane & 3;
    for (int j = 0; j < NT; ++j) {
        const unsigned long long mw = mw_next;
        if (j + 1 < NT) { kreg = *(const v4u*)(ksrc + (size_t)(j + 1) * 64 * 256); vreg = *(const v4u*)(vsrc + (size_t)(j + 1) * 64 * 256); mw_next = mp[(size_t)(j + 1) * 4096]; }
        const LAS unsigned char* Kc = Kb + (j & 1) * 8192; const LAS unsigned char* Vc = Vb + (j & 1) * 8192;
#pragma unroll
        for (int sub = 0; sub < 2; ++sub) {
            f32x16 p = {};
#pragma unroll
            for (int ks = 0; ks < 4; ++ks) { const bf16x8 kfr = *(const LAS bf16x8*)(Kc + kimg(32 * sub + q32, 2 * ks + hi)); p = MFMA32(kfr, qf[ks], p); }
            const unsigned bits = (unsigned)(mw >> (32 * sub)) >> (4 * hi);
#pragma unroll
            for (int r = 0; r < 16; ++r) { if (!((bits >> ((r & 3) + 8 * (r >> 2))) & 1u)) p[r] = -INFINITY; }
            float mt = p[0];
#pragma unroll
            for (int r = 1; r < 16; ++r) mt = fmaxf(mt, p[r]);
            mt = swap_max(mt);
            const float m_new = fmaxf(m_run, mt);
            const float m_use = (m_new == -INFINITY) ? 0.f : m_new;
            const float alpha = __builtin_amdgcn_exp2f(m_run - m_use);
            float s = 0.f;
#pragma unroll
            for (int r = 0; r < 16; ++r) { p[r] = __builtin_amdgcn_exp2f(p[r] - m_use); s += p[r]; }
            l_run = l_run * alpha + s; m_run = m_new;
#pragma unroll
            for (int r = 0; r < 16; ++r) { o0[r] *= alpha; o1[r] *= alpha; }
            bf16x8 pf[2];
#pragma unroll
            for (int ks = 0; ks < 2; ++ks) { v4u ww; ww.x = cvtpk(p[8 * ks + 0], p[8 * ks + 1]); ww.y = cvtpk(p[8 * ks + 2], p[8 * ks + 3]); ww.z = cvtpk(p[8 * ks + 4], p[8 * ks + 5]); ww.w = cvtpk(p[8 * ks + 6], p[8 * ks + 7]); pf[ks] = __builtin_bit_cast(bf16x8, ww); }
#pragma unroll
            for (int ks = 0; ks < 2; ++ks)
#pragma unroll
                for (int d0 = 0; d0 < 2; ++d0) {
                    const s16x4 lo = vtr(Vc + vimg(32 * sub + 16 * ks + 4 * hi + q4, 4 * d0 + 2 * blk + (p4 >> 1)) + 8 * (p4 & 1));
                    const s16x4 up = vtr(Vc + vimg(32 * sub + 16 * ks + 8 + 4 * hi + q4, 4 * d0 + 2 * blk + (p4 >> 1)) + 8 * (p4 & 1));
                    const bf16x8 vf = (bf16x8){lo[0], lo[1], lo[2], lo[3], up[0], up[1], up[2], up[3]};
                    if (d0 == 0) o0 = MFMA32(vf, pf[ks], o0); else o1 = MFMA32(vf, pf[ks], o1);
                }
        }
        if (j + 1 < NT) { *(LAS v4u*)(Kb + ((j + 1) & 1) * 8192 + kimg(srow, sch)) = kreg; *(LAS v4u*)(Vb + ((j + 1) & 1) * 8192 + vimg(srow, sch)) = vreg; }
        __syncthreads();
    }
    const float l_tot = swap_sum(l_run), inv = 1.0f / l_tot;
    const bf16* grow_p = G + grow * 1024 + head * 64;
    bf16* zrow = Z + grow * 1024 + head * 64;
#pragma unroll
    for (int g4 = 0; g4 < 4; ++g4) {
        const u32x2 ga = *(const u32x2*)(grow_p + 8 * g4 + 4 * hi), gb = *(const u32x2*)(grow_p + 32 + 8 * g4 + 4 * hi);
        *(u32x2*)(zrow + 8 * g4 + 4 * hi) = (u32x2){cvtpk(o0[4 * g4] * inv * bf_lo(ga.x), o0[4 * g4 + 1] * inv * bf_hi(ga.x)), cvtpk(o0[4 * g4 + 2] * inv * bf_lo(ga.y), o0[4 * g4 + 3] * inv * bf_hi(ga.y))};
        *(u32x2*)(zrow + 32 + 8 * g4 + 4 * hi) = (u32x2){cvtpk(o1[4 * g4] * inv * bf_lo(gb.x), o1[4 * g4 + 1] * inv * bf_hi(gb.x)), cvtpk(o1[4 * g4 + 2] * inv * bf_lo(gb.y), o1[4 * g4 + 3] * inv * bf_hi(gb.y))};
    }
}
__device__ __forceinline__ void p_attnB(Frame& F, const bf16* Q, const bf16* K, const bf16* V, const bf16* G, const unsigned long long* maskw, bf16* Z) {
    for (int L = F.vcu; L < 2048; L += F.G) {
        const int i = L >> 8, v = L & 255, bh = v >> 3, s = v & 7;
        const int blkq = 16 * (i >> 1) + ((i & 1) ? 15 - s : s);
        attnB_unit(F, bh >> 2, bh & 3, blkq, Q, K, V, G, maskw, Z);
    }
}

__device__ __forceinline__ cargs_t fresh_args() { cargs_t p = (cargs_t)__builtin_amdgcn_kernarg_segment_ptr(); asm volatile("" : "+s"(p)); return p; }
__global__ void __launch_bounds__(NWAVES * 64, 2) trunk_fwd(Args args_unused) {
    extern __shared__ __attribute__((aligned(16))) unsigned char lds[];
    Frame F;
    F.lds = (LAS unsigned char*)lds;
    F.MISC = (volatile LAS unsigned*)(F.lds + MISC_OFF);
    F.tid = threadIdx.x; F.lane = F.tid & 63; F.wave = __builtin_amdgcn_readfirstlane(F.tid >> 6);
    F.G = gridDim.x; { const int bx = blockIdx.x; F.vcu = (F.G % 8 == 0) ? (bx % 8) * (F.G / 8) + bx / 8 : bx; }
    F.ctl = (gu32*)(fresh_args()->ws + WS_CTL);
    if (F.tid < 64) ((LAS unsigned*)(F.lds + MISC_OFF))[F.tid] = 0u;
    __syncthreads();
#if MK_ONE_LAUNCH
    XcdBarrier bar = xcd_barrier_post((unsigned*)(F.ctl + CW_BAR), F.MISC + 8);
#define SEAM() xcd_barrier(bar)
#define RUN 1
#else
    int seam = 0; const int seg = fresh_args()->seg;
#define SEAM() (++seam)
#define RUN (seam == seg)
#endif
#define WSP(off) (A_->ws + (off))
#define FRESH_F() Frame Fp = F; { int t_ = threadIdx.x; asm volatile("" : "+v"(t_)); Fp.tid = t_; Fp.lane = t_ & 63; Fp.wave = __builtin_amdgcn_readfirstlane(t_ >> 6); }
    if (P_ON(0) && RUN) { cargs_t A_ = fresh_args(); FRESH_F(); p_prologue(Fp, A_); }
    SEAM();
    for (int lp = 0; lp < 2; ++lp) {
        {
            const int layer = 2 * lp;
            if (P_ON(1) && RUN) { cargs_t A_ = fresh_args(); FRESH_F(); const float* hin = (layer == 0) ? A_->in[0] : A_->out;
                p_norm_mod(Fp, hin, A_->in[3] + (size_t)layer * 1024, (const float*)WSP(WS_MOD) + (size_t)layer * 8 * 3072, (bf16*)WSP(WS_U)); }
            SEAM();
            for (int ch = 0; ch < NCHUNK; ++ch) {
                if (P_ON(2) && RUN) { cargs_t A_ = fresh_args();
                    pg8::Gemm g{(bf16*)WSP(WS_U) + (size_t)ch * MC * 1024, (bf16*)WSP(WS_WA) + (size_t)lp * A_N * 1024, MC, A_N, 1024};
                    pg8::StaticOrder S; S.init(MC, A_N, F.G, (int)blockIdx.x);
                    pg8::EpiA E{(bf16*)WSP(WS_ACT), A_SUB / 2, (const float*)WSP(WS_COS) + (size_t)ch * MC * 32, (const float*)WSP(WS_SIN) + (size_t)ch * MC * 32};
                    pg8::gemm_phase<pg8::EpiA, pg8::StaticOrder, true, true>(F.lds, g, S, E);
                }
                SEAM();
                if (P_ON(3) && RUN) { cargs_t A_ = fresh_args(); FRESH_F(); p_attnA(Fp, (bf16*)WSP(WS_ACT), (float*)WSP(WS_LSE)); }
                SEAM();
                if (P_ON(4) && RUN) { cargs_t A_ = fresh_args(); FRESH_F(); p_mergeA(Fp, (const bf16*)WSP(WS_ACT), (const float*)WSP(WS_LSE), (bf16*)WSP(WS_U) + (size_t)ch * MC * 1024); }
                SEAM();
            }
            if (P_ON(5) && RUN) { cargs_t A_ = fresh_args(); const float* hin = (layer == 0) ? A_->in[0] : A_->out;
                pg8::Gemm g{(bf16*)WSP(WS_U), (bf16*)WSP(WS_WO) + (size_t)layer * 1024 * 1024, MTOK, 1024, 1024};
                pg8::StaticOrder S; S.init(MTOK, 1024, F.G, (int)blockIdx.x);
                pg8::EpiOut E{hin, A_->out, (const float*)WSP(WS_MOD) + (size_t)layer * 8 * 3072 + 2048};
                pg8::gemm_phase<pg8::EpiOut, pg8::StaticOrder, true, true>(F.lds, g, S, E);
            }
            SEAM();
        }
        {
            const int layer = 2 * lp + 1;
            if (P_ON(6) && RUN) { cargs_t A_ = fresh_args(); FRESH_F();
                p_norm_mod(Fp, A_->out, A_->in[3] + (size_t)layer * 1024, (const float*)WSP(WS_MOD) + (size_t)layer * 8 * 3072, (bf16*)WSP(WS_U)); }
            SEAM();
            if (P_ON(7) && RUN) { cargs_t A_ = fresh_args();
                pg8::Gemm g{(bf16*)WSP(WS_U), (bf16*)WSP(WS_WB) + (size_t)lp * B_NP * 1024, MTOK, B_NP, 1024};
                pg8::StaticOrder S; S.init(MTOK, B_NP, F.G, (int)blockIdx.x);
                pg8::EpiB E{(bf16*)WSP(WS_BQ), (bf16*)WSP(WS_BK), (bf16*)WSP(WS_BV), (bf16*)WSP(WS_BQI), (bf16*)WSP(WS_BKI), (bf16*)WSP(WS_BG), (float*)WSP(WS_BWI), (const float*)WSP(WS_COS), (const float*)WSP(WS_SIN)};
                pg8::gemm_phase<pg8::EpiB, pg8::StaticOrder, true, true>(F.lds, g, S, E);
            }
            SEAM();
            if (P_ON(8) && RUN) { cargs_t A_ = fresh_args(); FRESH_F(); p_index(Fp, (const bf16*)WSP(WS_BQI), (const bf16*)WSP(WS_BKI), (const float*)WSP(WS_BWI), (unsigned long long*)WSP(WS_BMASK)); }
            SEAM();
            if (P_ON(9) && RUN) { cargs_t A_ = fresh_args(); FRESH_F(); p_attnB(Fp, (const bf16*)WSP(WS_BQ), (const bf16*)WSP(WS_BK), (const bf16*)WSP(WS_BV), (const bf16*)WSP(WS_BG), (const unsigned long long*)WSP(WS_BMASK), (bf16*)WSP(WS_U)); }
            SEAM();
            if (P_ON(10) && RUN) { cargs_t A_ = fresh_args();
                pg8::Gemm g{(bf16*)WSP(WS_U), (bf16*)WSP(WS_WO) + (size_t)layer * 1024 * 1024, MTOK, 1024, 1024};
                pg8::StaticOrder S; S.init(MTOK, 1024, F.G, (int)blockIdx.x);
                pg8::EpiOut E{A_->out, A_->out, (const float*)WSP(WS_MOD) + (size_t)layer * 8 * 3072 + 2048};
                pg8::gemm_phase<pg8::EpiOut, pg8::StaticOrder, true, true>(F.lds, g, S, E);
            }
            SEAM();
        }
    }
    if (P_ON(11) && RUN) { cargs_t A_ = fresh_args(); FRESH_F(); p_final_norm(Fp, A_->out, A_->in[10], A_->out); }
}

extern "C" void kernel_launch(void* const* d_in, const int* in_sizes, int n_in, void* d_out, int out_size, void* d_ws, size_t ws_size, hipStream_t stream) {
    static int grid = 0;
    if (grid == 0) {
        if (n_in != 11 || in_sizes[0] != MTOK * DM || out_size != MTOK * DM || ws_size < WS_NEED) {
            fprintf(stderr, "kernel_launch: unexpected shapes / workspace (n_in %d, in0 %d, out %d, ws %zu, need %zu); nothing launched\n", n_in, n_in > 0 ? in_sizes[0] : -1, out_size, ws_size, (size_t)WS_NEED); grid = -1; return; }
        int dev = 0, cus = 0, per_cu = 0;
        if (hipGetDevice(&dev) != hipSuccess || hipDeviceGetAttribute(&cus, hipDeviceAttributeMultiprocessorCount, dev) != hipSuccess) { fprintf(stderr, "kernel_launch: device query failed\n"); grid = -1; return; }
        if (hipFuncSetAttribute((const void*)trunk_fwd, hipFuncAttributeMaxDynamicSharedMemorySize, LDS_BYTES) != hipSuccess) { fprintf(stderr, "kernel_launch: hipFuncSetAttribute failed\n"); grid = -1; return; }
        if (hipOccupancyMaxActiveBlocksPerMultiprocessor(&per_cu, (const void*)trunk_fwd, NWAVES * 64, LDS_BYTES) != hipSuccess || per_cu < 1)
            fprintf(stderr, "kernel_launch: note: occupancy query reports %d workgroups per CU\n", per_cu);
        (void)hipGetLastError();
        grid = cus;
    }
    if (grid < 0) return;
    if (hipMemsetAsync((char*)d_ws + WS_CTL, 0, CTL_ZERO_BYTES, stream) != hipSuccess) { fprintf(stderr, "kernel_launch: memset failed\n"); return; }
    Args a{};
    for (int i = 0; i < 11; ++i) a.in[i] = (const float*)d_in[i];
    a.pos = (const int*)d_in[2]; a.out = (float*)d_out; a.ws = (unsigned char*)d_ws; a.seg = 0; a.pad = 0;
#if MK_ONE_LAUNCH
    hipLaunchKernelGGL(trunk_fwd, dim3(grid), dim3(NWAVES * 64), LDS_BYTES, stream, a);
#else
    for (int s = 0; s <= N_SEAMS; ++s) { a.seg = s; hipLaunchKernelGGL(trunk_fwd, dim3(grid), dim3(NWAVES * 64), LDS_BYTES, stream, a); }
#endif
    const hipError_t le = hipPeekAtLastError();
    if (le != hipSuccess) fprintf(stderr, "kernel_launch: launch failed: %s\n", hipGetErrorName(le));
}
```

```cpp
#include <hip/hip_runtime.h>
#include <cstdio>
#include <cstdint>
#include <cmath>
constexpr int NWAVES = 8;
constexpr int NB = 8, SEQ = 4096, DM = 1024, MTOK = NB * SEQ;
constexpr int A_N = 10240, B_NL = 3144, B_NP = 3328;
constexpr int MC = 16384, NCHUNK = MTOK / MC;
constexpr float NORM_EPS = 1e-6f;
#ifndef PMASK
#define PMASK 0xffff
#endif
#define P_ON(k) ((PMASK >> (k)) & 1)
#ifndef DUPMASK
#define DUPMASK 0
#endif
#define DUP(k) ((DUPMASK >> (k)) & 1)
#ifndef MK_ONE_LAUNCH
#define MK_ONE_LAUNCH 1
#endif
constexpr int N_SEAMS = 1 + 2 * ((1 + 3 * NCHUNK + 1) + 5);

constexpr size_t MiB = 1u << 20;
constexpr size_t WS_CTL = 0, CTL_ZERO_BYTES = 1 * MiB;
constexpr size_t WS_MOD = 1 * MiB;
constexpr size_t WS_COS = 2 * MiB, WS_SIN = 6 * MiB;
constexpr size_t WS_WA = 10 * MiB;
constexpr size_t WS_WB = 50 * MiB;
constexpr size_t WS_WO = 63 * MiB;
constexpr size_t WS_U = 72 * MiB;
constexpr size_t WS_ACT = 136 * MiB;
constexpr size_t A_SUB = (size_t)MC * 1024 * 2;
constexpr size_t WS_LSE = WS_ACT + 10 * A_SUB;
constexpr size_t WS_END_A = WS_LSE + (size_t)3 * MC * 16 * 4;
constexpr size_t WS_BQ = WS_ACT, WS_BK = WS_BQ + 64 * MiB, WS_BV = WS_BK + 16 * MiB, WS_BQI = WS_BV + 16 * MiB, WS_BKI = WS_BQI + 32 * MiB,
                 WS_BWI = WS_BKI + 4 * MiB, WS_BG = WS_BWI + 2 * MiB, WS_BMASK = WS_BG + 64 * MiB, WS_END_B = WS_BMASK + 16 * MiB;
constexpr size_t WS_NEED = (WS_END_A > WS_END_B ? WS_END_A : WS_END_B);
static_assert(WS_WA + (size_t)2 * A_N * 1024 * 2 <= WS_WB && WS_WB + (size_t)2 * B_NP * 1024 * 2 <= WS_WO && WS_WO + (size_t)4 * 1024 * 1024 * 2 <= WS_U && WS_U + (size_t)MTOK * 1024 * 2 <= WS_ACT, "ws map");
constexpr int CW_BAR = 4096;

namespace pg8 {
#define PG8_LAS __attribute__((address_space(3)))
typedef unsigned short bf16_t;
typedef short bf16x8 __attribute__((ext_vector_type(8)));
typedef float f32x4 __attribute__((ext_vector_type(4)));
typedef unsigned u32x4 __attribute__((ext_vector_type(4)));
constexpr int BM = 256, BK = 64, HALF = 128, HTB = HALF * BK * 2  , STAGE_BYTES = 8 * HTB, NXCD = 8, WGM = 8;

__host__ __device__ __forceinline__ int lds_byte(int r, int c) { const int st = (r >> 4) * 2 + (c >> 5), rr = r & 15, cc = c & 31, ob = rr * 64 + cc * 2; return st * 1024 + (ob ^ (((ob >> 9) & 1) << 5)); }
__host__ __device__ __forceinline__ void stage_rc(int b, int& R, int& C) { const int st = b / 1024, sb = b % 1024, swz = sb ^ (((sb >> 9) & 1) << 5); R = (st >> 1) * 16 + swz / 64; C = (st & 1) * 32 + (swz % 64) / 2; }
__host__ __device__ __forceinline__ int perm32(int rho) { const int n = rho >> 4, i = rho & 15; return 8 * (i >> 2) + 4 * n + (i & 3); }

struct Unit { int pm, pn; };
struct Gemm { const bf16_t* A; const bf16_t* Bt; int M, N, K; };

struct StaticOrder {
    int nM, nN, nwg, G, c;
    __host__ __device__ void init(int M, int N, int G_, int c_) { nM = M / BM; nN = N / BM; nwg = nM * nN; G = G_; c = c_; }
    __host__ __device__ bool next(int i, Unit& u) const {
        const long L = (long)i * G + c; if (L >= nwg) return false;
        int wgid = (int)L; { const int q = nwg / NXCD, r = nwg % NXCD, xcd = wgid % NXCD, off = wgid / NXCD; wgid = (xcd < r ? xcd * (q + 1) : r * (q + 1) + (xcd - r) * q) + off; }
        const int nig = WGM * nN, gid = wgid / nig, fm = gid * WGM, gsz = (nM - fm) < WGM ? (nM - fm) : WGM;
        u.pm = fm + ((wgid % nig) % gsz); u.pn = (wgid % nig) / gsz; return true;
    }
    __device__ __forceinline__ void a_ready(const Unit&) const {}
    __device__ __forceinline__ void done(const Unit&) const {}
};

__device__ __forceinline__ unsigned cvt_pk_bf16(float lo, float hi) { unsigned r; asm volatile("v_cvt_pk_bf16_f32 %0, %1, %2" : "=v"(r) : "v"(lo), "v"(hi)); return r; }
typedef float f32x2 __attribute__((ext_vector_type(2)));
constexpr float C2F = 0.125f * 1.4426950408889634f;
constexpr float WSC = 0.35355339059327373f * 0.125f;
__device__ __forceinline__ float silu_f(float x) { return x * __builtin_amdgcn_rcpf(1.0f + __builtin_amdgcn_exp2f(-1.4426950408889634f * x)); }
__device__ __forceinline__ f32x4 silu4(f32x4 v) { return (f32x4){silu_f(v[0]), silu_f(v[1]), silu_f(v[2]), silu_f(v[3])}; }
__device__ __forceinline__ u32x4 pack8(f32x4 a, f32x4 b) { u32x4 w; w.x = cvt_pk_bf16(a[0], a[1]); w.y = cvt_pk_bf16(a[2], a[3]); w.z = cvt_pk_bf16(b[0], b[1]); w.w = cvt_pk_bf16(b[2], b[3]); return w; }

__device__ __forceinline__ void epi_store_rows(const f32x4 (&acc)[2][2][4][2], int kind, bf16_t* ob, int pitch, int row0, int col0, int j0, const float* cs, const float* sn) {
#pragma unroll
    for (int ai = 0; ai < 2; ++ai)
#pragma unroll
        for (int m = 0; m < 4; ++m) {
            const int row = row0 + ai * HALF + m * 16;
            f32x4 c4 = (f32x4){1.f, 1.f, 1.f, 1.f}, s4 = (f32x4){0.f, 0.f, 0.f, 0.f};
            if (kind < 2) { c4 = *(const f32x4*)(cs + (size_t)row * 32 + j0); s4 = *(const f32x4*)(sn + (size_t)row * 32 + j0); }
            bf16_t* rowp = ob + (size_t)row * pitch + col0;
#pragma unroll
            for (int bj = 0; bj < 2; ++bj) {
                f32x4 v0 = acc[ai][bj][m][0], v1 = acc[ai][bj][m][1];
                if (kind < 2) { const f32x4 o0 = v0 * c4 - v1 * s4, o1 = v1 * c4 + v0 * s4; v0 = o0; v1 = o1; if (kind == 0) { v0 = v0 * C2F; v1 = v1 * C2F; } }
                else if (kind == 3) { v0 = silu4(v0); v1 = silu4(v1); }
                *(u32x4*)(rowp + bj * HALF) = pack8(v0, v1);
            }
        }
}
struct EpiA {
    static constexpr bool PERM = true, AFTER_DRAIN = false;
    unsigned char* ws; int row_off;
    __device__ __forceinline__ void operator()(const f32x4 (&acc)[2][2][4][2], const Unit& u, int wr, int wc, int fr, int fq) const {
        asm volatile("" : "+v"(fr), "+v"(fq));
        const int t = u.pn >> 2, kind = (t == 9) ? 3 : (t % 3);
        const float* cs = (const float*)(ws + WS_COS) + (size_t)row_off * 32; const float* sn = (const float*)(ws + WS_SIN) + (size_t)row_off * 32;
        epi_store_rows(acc, kind, (bf16_t*)(ws + WS_ACT) + (size_t)t * (A_SUB / 2), 1024, u.pm * BM + wr * 64 + fr, (u.pn & 3) * BM + wc * 32 + 8 * fq, 16 * (wc & 1) + 4 * fq, cs, sn);
    }
};
struct EpiB {
    static constexpr bool PERM = true, AFTER_DRAIN = false;
    unsigned char* ws;
    __device__ __forceinline__ void operator()(const f32x4 (&acc)[2][2][4][2], const Unit& u, int wr, int wc, int fr, int fq) const {
        asm volatile("" : "+v"(fr), "+v"(fq));
        bf16_t* Q = (bf16_t*)(ws + WS_BQ); bf16_t* K = (bf16_t*)(ws + WS_BK); bf16_t* V = (bf16_t*)(ws + WS_BV); bf16_t* QI = (bf16_t*)(ws + WS_BQI); bf16_t* KI = (bf16_t*)(ws + WS_BKI); bf16_t* G = (bf16_t*)(ws + WS_BG);
        float* WI = (float*)(ws + WS_BWI); const float* cs = (const float*)(ws + WS_COS); const float* sn = (const float*)(ws + WS_SIN);
        const int pn = u.pn, row0 = u.pm * BM + wr * 64 + fr, cw = wc * 32 + 8 * fq, j0 = 16 * (wc & 1) + 4 * fq;
        if (pn < 4)       epi_store_rows(acc, 0, Q, 1024, row0, pn * BM + cw, j0, cs, sn);
        else if (pn == 4) epi_store_rows(acc, 1, K, 256, row0, cw, j0, cs, sn);
        else if (pn == 5) epi_store_rows(acc, 2, V, 256, row0, cw, j0, cs, sn);
        else if (pn < 8)  epi_store_rows(acc, 1, QI, 512, row0, (pn - 6) * BM + cw, j0, cs, sn);
        else if (pn > 8)  epi_store_rows(acc, 3, G, 1024, row0, (pn - 9) * BM + cw, j0, cs, sn);
        else {
#pragma unroll
            for (int ai = 0; ai < 2; ++ai)
#pragma unroll
                for (int m = 0; m < 4; ++m) {
                    const int row = row0 + ai * HALF + m * 16;
                    const f32x4 v0 = acc[ai][0][m][0], v1 = acc[ai][0][m][1];
                    if (wc < 2) {
                        const f32x4 c4 = *(const f32x4*)(cs + (size_t)row * 32 + j0), s4 = *(const f32x4*)(sn + (size_t)row * 32 + j0);
                        *(u32x4*)(KI + (size_t)row * 64 + cw) = pack8(v0 * c4 - v1 * s4, v1 * c4 + v0 * s4);
                    } else if (wc == 2 && fq == 0) {
                        *(f32x4*)(WI + (size_t)row * 8) = v0 * WSC; *(f32x4*)(WI + (size_t)row * 8 + 4) = v1 * WSC;
                    }
                }
        }
    }
};
struct EpiOut {
    static constexpr bool PERM = false, AFTER_DRAIN = false;
    const float* hin; float* hout; const float* gate;
    __device__ __forceinline__ void operator()(const f32x4 (&acc)[2][2][4][2], const Unit& u, int wr, int wc, int fr, int fq) const {
        asm volatile("" : "+v"(fr), "+v"(fq));
        const int col0 = u.pn * BM + wc * 32 + 4 * fq;
#pragma unroll
        for (int ai = 0; ai < 2; ++ai)
#pragma unroll
            for (int m = 0; m < 4; ++m) {
                const int row = u.pm * BM + ai * HALF + wr * 64 + m * 16 + fr; const int b = row >> 12;
#pragma unroll
                for (int bj = 0; bj < 2; ++bj)
#pragma unroll
                    for (int n = 0; n < 2; ++n) {
                        const int c = col0 + bj * HALF + n * 16;
                        const f32x4 g4 = *(const f32x4*)(gate + (size_t)b * 3072 + c), h4 = *(const f32x4*)(hin + (size_t)row * 1024 + c);
                        *(f32x4*)(hout + (size_t)row * 1024 + c) = h4 + g4 * acc[ai][bj][m][n];
                    }
            }
    }
};

template <class Epi, class Sched, bool ALIGN_EPI = false, bool SP2 = false>
__device__ __forceinline__ void gemm_phase(PG8_LAS unsigned char* lds, const Gemm g, const Sched& S, const Epi& E) {
    int tid_ = threadIdx.x; asm volatile("" : "+v"(tid_));
    const int tid = tid_, wid = __builtin_amdgcn_readfirstlane(tid >> 6), lane = tid & 63, wr = wid >> 2, wc = wid & 3, fr = lane & 15, fq = lane >> 4;
    const int K = g.K, nt = K / BK;
    unsigned voffA[2], voffB[2];
#pragma unroll
    for (int i = 0; i < 2; ++i) { int R, C; stage_rc(tid * 16 + i * 8192, R, C); const int Rb = Epi::PERM ? ((R & ~31) + perm32(R & 31)) : R;
        voffA[i] = (unsigned)(R * K + C) * 2u; voffB[i] = (unsigned)(Rb * K + C) * 2u; }
    const size_t kstep = (size_t)(BK * 2);
    const size_t hstep = (size_t)HALF * K * 2;
    const size_t tstep = 2 * hstep;
    const unsigned ldsw = (unsigned)wid * 1024u;
    const int aoff = lds_byte(wr * 64 + fr, fq * 8), boff = lds_byte(wc * 32 + fr, fq * 8);
#define PG8_SA(b, h) (((b) * 2 + (h)) * HTB)
#define PG8_SB(b, h) ((4 + (b) * 2 + (h)) * HTB)
#define PG8_STAGE(bufoff, gbase, voff) do { _Pragma("unroll") for (int _i = 0; _i < 2; ++_i) \
        __builtin_amdgcn_global_load_lds((const unsigned*)((const char*)(gbase) + (voff)[_i]), (PG8_LAS unsigned*)(lds + (bufoff) + ldsw + _i * 8192), 16, 0, 0); } while (0)
#define PG8_LDA(dst, b, h) do { _Pragma("unroll") for (int m = 0; m < 4; ++m) _Pragma("unroll") for (int k = 0; k < 2; ++k) dst[m][k] = *(const PG8_LAS bf16x8*)(lds + PG8_SA(b, h) + aoff + m * 2048 + k * 1024); } while (0)
#define PG8_LDB(dst, b, h) do { _Pragma("unroll") for (int n = 0; n < 2; ++n) _Pragma("unroll") for (int k = 0; k < 2; ++k) dst[n][k] = *(const PG8_LAS bf16x8*)(lds + PG8_SB(b, h) + boff + n * 2048 + k * 1024); } while (0)
#define PG8_MMA(ai, bj, At, Bt) do { __builtin_amdgcn_s_setprio(1); _Pragma("unroll") for (int m = 0; m < 4; ++m) _Pragma("unroll") for (int n = 0; n < 2; ++n) _Pragma("unroll") for (int k = 0; k < 2; ++k) \
        acc[ai][bj][m][n] = __builtin_amdgcn_mfma_f32_16x16x32_bf16(Bt[n][k], At[m][k], acc[ai][bj][m][n], 0, 0, 0); __builtin_amdgcn_s_setprio(0); } while (0)
#define PG8_WAIT_V(n) asm volatile("s_waitcnt vmcnt(" #n ")" ::: "memory")
#define PG8_WAIT_L(n) asm volatile("s_waitcnt lgkmcnt(" #n ")" ::: "memory")
#define PG8_BAR __builtin_amdgcn_s_barrier()
#define PG8_SCHED __builtin_amdgcn_sched_barrier(0)
    Unit cur, nxt; int ui = 0;
    if (!S.next(0, cur)) return;
    f32x4 acc[2][2][4][2];
#pragma unroll
    for (int a = 0; a < 2; ++a)
#pragma unroll
        for (int b = 0; b < 2; ++b)
#pragma unroll
            for (int m = 0; m < 4; ++m)
#pragma unroll
                for (int n = 0; n < 2; ++n) acc[a][b][m][n] = (f32x4){0.f, 0.f, 0.f, 0.f};
    bf16x8 At[4][2], B0[2][2], B1[2][2];
    const char* cA = (const char*)g.A + (size_t)cur.pm * tstep; const char* cB = (const char*)g.Bt + (size_t)cur.pn * tstep;
    S.a_ready(cur);
    if constexpr (SP2) {
        PG8_STAGE(PG8_SB(0, 0), cB, voffB); PG8_STAGE(PG8_SB(0, 1), cB + hstep, voffB); PG8_STAGE(PG8_SA(0, 0), cA, voffA); PG8_STAGE(PG8_SA(0, 1), cA + hstep, voffA);
        if (wr == 1) PG8_BAR;
        PG8_WAIT_V(2); PG8_BAR;
        PG8_STAGE(PG8_SB(1, 0), cB + kstep, voffB); PG8_STAGE(PG8_SA(1, 0), cA + kstep, voffA); PG8_STAGE(PG8_SB(1, 1), cB + hstep + kstep, voffB);
        PG8_WAIT_V(6); PG8_BAR;
    } else {
        PG8_STAGE(PG8_SB(0, 0), cB, voffB); PG8_STAGE(PG8_SA(0, 0), cA, voffA); PG8_STAGE(PG8_SB(0, 1), cB + hstep, voffB); PG8_STAGE(PG8_SA(0, 1), cA + hstep, voffA);
        if (wr == 1) PG8_BAR;
        PG8_WAIT_V(4); PG8_BAR;
        PG8_STAGE(PG8_SB(1, 0), cB + kstep, voffB); PG8_STAGE(PG8_SA(1, 0), cA + kstep, voffA); PG8_STAGE(PG8_SB(1, 1), cB + hstep + kstep, voffB);
        PG8_WAIT_V(6); PG8_BAR;
    }
    for (;;) {
        const bool has_next = S.next(ui + 1, nxt);
        const char* nA = has_next ? (const char*)g.A + (size_t)nxt.pm * tstep : cA; const char* nB = has_next ? (const char*)g.Bt + (size_t)nxt.pn * tstep : cB;
        for (int t = 0; t < nt; t += 2) {
            const bool last = (t == nt - 2);
            const char* a1 = cA + (size_t)(t + 1) * kstep;
            const char* a2 = last ? nA : cA + (size_t)(t + 2) * kstep; const char* b2 = last ? nB : cB + (size_t)(t + 2) * kstep;
            const char* a3 = a2 + kstep; const char* b3 = b2 + kstep;
            if (last && has_next) S.a_ready(nxt);
            if constexpr (SP2) {
            PG8_LDB(B0, 0, 0); PG8_LDB(B1, 0, 1); PG8_SCHED; PG8_LDA(At, 0, 0); PG8_STAGE(PG8_SA(1, 1), a1 + hstep, voffA);
            PG8_WAIT_V(8); PG8_WAIT_L(0); PG8_BAR; PG8_MMA(0, 0, At, B0); PG8_MMA(0, 1, At, B1); PG8_BAR; PG8_SCHED;
            PG8_LDA(At, 0, 1); PG8_STAGE(PG8_SB(0, 0), b2, voffB); PG8_STAGE(PG8_SB(0, 1), b2 + hstep, voffB); PG8_STAGE(PG8_SA(0, 0), a2, voffA);
            PG8_WAIT_V(8); PG8_WAIT_L(0); PG8_BAR; PG8_MMA(1, 0, At, B0); PG8_MMA(1, 1, At, B1); PG8_BAR; PG8_SCHED;
            PG8_LDB(B0, 1, 0); PG8_LDB(B1, 1, 1); PG8_SCHED; PG8_LDA(At, 1, 0); PG8_STAGE(PG8_SA(0, 1), a2 + hstep, voffA);
            PG8_WAIT_V(8); PG8_WAIT_L(0); PG8_BAR; PG8_MMA(0, 0, At, B0); PG8_MMA(0, 1, At, B1); PG8_BAR; PG8_SCHED;
            PG8_LDA(At, 1, 1); PG8_STAGE(PG8_SB(1, 0), b3, voffB); PG8_STAGE(PG8_SB(1, 1), b3 + hstep, voffB); PG8_STAGE(PG8_SA(1, 0), a3, voffA);
            PG8_WAIT_V(8); PG8_WAIT_L(0); PG8_BAR; PG8_MMA(1, 0, At, B0); PG8_MMA(1, 1, At, B1); PG8_BAR; PG8_SCHED;
            } else {
            PG8_LDB(B0, 0, 0); PG8_SCHED; PG8_LDA(At, 0, 0); PG8_STAGE(PG8_SA(1, 1), a1 + hstep, voffA);
            PG8_WAIT_L(8); PG8_BAR; PG8_WAIT_L(0); PG8_MMA(0, 0, At, B0); PG8_BAR; PG8_SCHED;
            PG8_LDB(B1, 0, 1); PG8_STAGE(PG8_SB(0, 0), b2, voffB);
            PG8_BAR; PG8_WAIT_L(0); PG8_MMA(0, 1, At, B1); PG8_BAR;
            PG8_LDA(At, 0, 1); PG8_STAGE(PG8_SA(0, 0), a2, voffA);
            PG8_BAR; PG8_WAIT_L(0); PG8_MMA(1, 0, At, B0); PG8_BAR; PG8_SCHED;
            PG8_STAGE(PG8_SB(0, 1), b2 + hstep, voffB);
            PG8_WAIT_V(6); PG8_BAR; PG8_MMA(1, 1, At, B1); PG8_BAR;
            PG8_LDB(B0, 1, 0); PG8_SCHED; PG8_LDA(At, 1, 0); PG8_STAGE(PG8_SA(0, 1), a2 + hstep, voffA);
            PG8_WAIT_L(8); PG8_BAR; PG8_WAIT_L(0); PG8_MMA(0, 0, At, B0); PG8_BAR; PG8_SCHED;
            PG8_LDB(B1, 1, 1); PG8_STAGE(PG8_SB(1, 0), b3, voffB);
            PG8_BAR; PG8_WAIT_L(0); PG8_MMA(0, 1, At, B1); PG8_BAR;
            PG8_LDA(At, 1, 1); PG8_STAGE(PG8_SA(1, 0), a3, voffA);
            PG8_BAR; PG8_WAIT_L(0); PG8_MMA(1, 0, At, B0); PG8_BAR; PG8_SCHED;
            PG8_STAGE(PG8_SB(1, 1), b3 + hstep, voffB);
            PG8_WAIT_V(6); PG8_BAR; PG8_MMA(1, 1, At, B1); PG8_BAR;
            }
        }
        if constexpr (ALIGN_EPI) { if (wr == 0) PG8_BAR; }
        if constexpr (!Epi::AFTER_DRAIN) { E(acc, cur, wr, wc, fr, fq); S.done(cur); }
        if (!has_next) break;
#pragma unroll
        for (int a = 0; a < 2; ++a)
#pragma unroll
            for (int b = 0; b < 2; ++b)
#pragma unroll
                for (int m = 0; m < 4; ++m)
#pragma unroll
                    for (int n = 0; n < 2; ++n) acc[a][b][m][n] = (f32x4){0.f, 0.f, 0.f, 0.f};
        cur = nxt; cA = nA; cB = nB; ++ui;
        if constexpr (ALIGN_EPI) { if (wr == 1) PG8_BAR; }
    }
    PG8_WAIT_V(0);
    if constexpr (!ALIGN_EPI) { if (wr == 0) PG8_BAR; }
    PG8_BAR;
    if constexpr (Epi::AFTER_DRAIN) { E.fused(acc, cur, wr, wc, fr, fq, lds, wid, lane); S.done(cur); }
#undef PG8_SA
#undef PG8_SB
#undef PG8_STAGE
#undef PG8_LDA
#undef PG8_LDB
#undef PG8_MMA
#undef PG8_WAIT_V
#undef PG8_WAIT_L
#undef PG8_BAR
#undef PG8_SCHED
}
}
#define GAS __attribute__((address_space(1)))
#define LAS __attribute__((address_space(3)))
typedef unsigned short bf16;
typedef unsigned v4u __attribute__((ext_vector_type(4)));
typedef float f32x4 __attribute__((ext_vector_type(4)));
typedef short bf16x8 __attribute__((ext_vector_type(8)));
typedef GAS unsigned gu32;
typedef GAS unsigned long long gu64;
#define RLX_AGENT __ATOMIC_RELAXED, __HIP_MEMORY_SCOPE_AGENT
#define LDS_WAIT() asm volatile("s_waitcnt lgkmcnt(0)" ::: "memory")
#define VM_WAIT() asm volatile("s_waitcnt vmcnt(0)" ::: "memory")
__device__ __forceinline__ unsigned long long rt() { return __builtin_amdgcn_s_memrealtime(); }
__device__ __forceinline__ unsigned f2bf(float f) { unsigned u = __builtin_bit_cast(unsigned, f); return (u + 0x7fffu + ((u >> 16) & 1u)) >> 16; }
__device__ __forceinline__ unsigned pk2(float lo, float hi) { return f2bf(lo) | (f2bf(hi) << 16); }

#define XB_TMO      128
#define XB_XCNT(j)  (256  + 64 * (j))
#define XB_XSUB(j)  (1280 + 64 * (j))
#define XB_XGEN(j)  (2304 + 64 * (j))
#define XB_TOP      3328
#define XB_TOPGEN   3392
#define XCD_BAR_WORDS 3456
#define XB_SPIN_CAP (1u << 18)

__device__ __forceinline__ unsigned xb_ld(unsigned* p)              { return __hip_atomic_load(p, __ATOMIC_RELAXED, __HIP_MEMORY_SCOPE_AGENT); }
__device__ __forceinline__ unsigned xb_add(unsigned* p, unsigned v) { return __hip_atomic_fetch_add(p, v, __ATOMIC_RELAXED, __HIP_MEMORY_SCOPE_AGENT); }
__device__ __forceinline__ unsigned xb_xcc_id() { return (unsigned)__builtin_amdgcn_s_getreg((3 << 11) | 20) & 0xFu; }
#define XB_SPIN(cond, bar) do { unsigned _sp = 0; while (cond) { __builtin_amdgcn_s_sleep(1); \
    if ((++_sp & 255u) == 0u) { if (xb_ld(&(bar)[XB_TMO])) break; if (_sp > XB_SPIN_CAP) { atomicAdd(&(bar)[XB_TMO], 1u); break; } } } } while (0)

struct XcdBarrier {
    unsigned* bar; unsigned x;
    volatile LAS unsigned* st;
};

__device__ __forceinline__ XcdBarrier xcd_barrier_post(unsigned* bar, volatile LAS unsigned* st) {
    XcdBarrier b; b.bar = bar; b.x = xb_xcc_id(); b.st = st;
    if (threadIdx.x == 0) (void)xb_add(&bar[XB_XCNT(b.x)], 1u);
    return b;
}
__device__ __forceinline__ void xcd_barrier_complete(unsigned* bar, unsigned x, unsigned& nloc, unsigned& nx) {
    const unsigned G = gridDim.x * gridDim.y * gridDim.z;
    unsigned sum, cnt, mine, sp = 0u;
    for (;;) {
        sum = 0u; cnt = 0u; mine = 0u;
#pragma unroll
        for (unsigned j = 0; j < 16; ++j) { const unsigned c = xb_ld(&bar[XB_XCNT(j)]); sum += c; cnt += (c > 0u) ? 1u : 0u; mine = (j == x) ? c : mine; }
        if (sum == G) break;
        __builtin_amdgcn_s_sleep(1);
        if ((++sp & 255u) == 0u) { if (xb_ld(&bar[XB_TMO])) break; if (sp > XB_SPIN_CAP) { atomicAdd(&bar[XB_TMO], 1u); break; } }
    }
    nloc = mine > 0u ? mine : 1u; nx = cnt > 0u ? cnt : 1u;
}

__device__ __forceinline__ void xcd_barrier(const XcdBarrier& b) {
    asm volatile("s_waitcnt vmcnt(0)" ::: "memory");
    __syncthreads();
    if (threadIdx.x == 0) {
        unsigned* bar = b.bar;
        __builtin_amdgcn_s_waitcnt(0);
        unsigned nloc = b.st[0], nx = b.st[1];
        if (nloc == 0u) { xcd_barrier_complete(bar, b.x, nloc, nx); b.st[0] = nloc; b.st[1] = nx; }
        const unsigned old = xb_add(&bar[XB_XSUB(b.x)], 1u);
        const unsigned gen = old / nloc;
        if (old + 1u == (gen + 1u) * nloc) {
            __builtin_amdgcn_fence(__ATOMIC_RELEASE, "agent");
            asm volatile("s_waitcnt vmcnt(0)" ::: "memory");
            const unsigned og = xb_add(&bar[XB_TOP], 1u);
            const unsigned tg = og / nx;
            if (og + 1u == (tg + 1u) * nx) xb_add(&bar[XB_TOPGEN], 1u);
            else XB_SPIN(xb_ld(&bar[XB_TOPGEN]) == tg, bar);
            __builtin_amdgcn_fence(__ATOMIC_ACQUIRE, "agent");
            xb_add(&bar[XB_XGEN(b.x)], 1u);
            asm volatile("s_waitcnt vmcnt(0)" ::: "memory");
        } else {
            XB_SPIN(xb_ld(&bar[XB_XGEN(b.x)]) == gen, bar);
            __builtin_amdgcn_fence(__ATOMIC_ACQUIRE, "agent");
            asm volatile("s_waitcnt vmcnt(0)" ::: "memory");
        }
    }
    __syncthreads();
}

constexpr int RING_BYTES = 131072;
constexpr int SEL_HIST_OFF = 131072, SEL_CAND_OFF = SEL_HIST_OFF + 16384, SEL_STAGE_OFF = SEL_CAND_OFF + 4096, MISC_OFF = SEL_STAGE_OFF + 4096, LDS_BYTES = 159744;
static_assert(MISC_OFF + 256 <= LDS_BYTES, "LDS map");

typedef short s16x4 __attribute__((ext_vector_type(4)));
typedef short v4i16_t __attribute__((ext_vector_type(4)));
typedef float f32x16 __attribute__((ext_vector_type(16)));
typedef unsigned u32x2 __attribute__((ext_vector_type(2)));
__device__ __forceinline__ float wave_sum(float v) {
#pragma unroll
    for (int o = 1; o < 64; o <<= 1) v += __shfl_xor(v, o);
    return v;
}
__device__ __forceinline__ unsigned cvtpk(float lo, float hi) { unsigned r; asm volatile("v_cvt_pk_bf16_f32 %0, %1, %2" : "=v"(r) : "v"(lo), "v"(hi)); return r; }
__device__ __forceinline__ float bf_lo(unsigned w) { return __uint_as_float(w << 16); }
__device__ __forceinline__ float bf_hi(unsigned w) { return __uint_as_float(w & 0xffff0000u); }
__device__ __forceinline__ float swap_max(float m) { auto rr = __builtin_amdgcn_permlane32_swap(__float_as_uint(m), __float_as_uint(m), false, false); return fmaxf(__uint_as_float(rr[0]), __uint_as_float(rr[1])); }
__device__ __forceinline__ float swap_sum(float m) { auto rr = __builtin_amdgcn_permlane32_swap(__float_as_uint(m), __float_as_uint(m), false, false); return __uint_as_float(rr[0]) + __uint_as_float(rr[1]); }
__device__ __forceinline__ int crow(int r, int hi) { return (r & 3) + 8 * (r >> 2) + 4 * hi; }
__device__ __forceinline__ unsigned vimg(unsigned row, unsigned ch) { return row * 128u + 16u * (ch ^ ((row & 3u) | (((row >> 1) & 1u) << 2))); }
__device__ __forceinline__ unsigned kimg(unsigned row, unsigned ch) { return row * 128u + 16u * (ch ^ ((row >> 1) & 7u)); }
__device__ __forceinline__ s16x4 vtr(const LAS unsigned char* p) { return __builtin_bit_cast(s16x4, __builtin_amdgcn_ds_read_tr16_b64_v4i16((LAS v4i16_t*)p)); }
#define MFMA32(a, b, c) __builtin_amdgcn_mfma_f32_32x32x16_bf16((a), (b), (c), 0, 0, 0)

struct Frame {
    LAS unsigned char* lds; volatile LAS unsigned* MISC; gu32* ctl;
    int tid, lane, wave, vcu, G, bx;
};
struct Args { const float* in[11]; const int* pos; float* out; unsigned char* ws; int seg; int pad; };
typedef const Args __attribute__((address_space(4)))* cargs_t;

__device__ __forceinline__ int rope_perm64(int c) { return ((c & 31) >> 2) * 8 + (c & 3) + ((c >> 5) << 2); }
template <int KIND> __device__ __forceinline__ int phys_row(int n) {
    if (KIND == 0) { if (n < 9216 && ((n >> 10) % 3) < 2) return (n & ~63) + rope_perm64(n & 63); return n; }
    if (KIND == 1) { if (n < 1280 || (n >= 1536 && n < 2112)) return (n & ~63) + rope_perm64(n & 63); if (n >= 2120) return n + 184; return n; }
    return n;
}
template <int KIND> __device__ __forceinline__ void transpose_item(const float* W, int K, int N, bf16* WT, LAS float* scr, int item, int lane) {
    const int nblk = (N + 31) / 32, kb = item / nblk, nb = item % nblk, k0 = 64 * kb, n0 = 32 * nb;
    const bool nok = n0 + (lane & 31) < N;
#pragma unroll 8
    for (int i = 0; i < 32; ++i) { const int kk = 2 * i + (lane >> 5); scr[kk * 33 + (lane & 31)] = nok ? W[(size_t)(k0 + kk) * N + n0 + (lane & 31)] : 0.f; }
    LDS_WAIT(); asm volatile("" ::: "memory");
    const int c = lane & 7;
#pragma unroll
    for (int j = 0; j < 4; ++j) { const int n = (lane >> 3) + 8 * j; const LAS float* s = scr + (8 * c) * 33 + n;
        v4u o; o.x = pk2(s[0 * 33], s[1 * 33]); o.y = pk2(s[2 * 33], s[3 * 33]); o.z = pk2(s[4 * 33], s[5 * 33]); o.w = pk2(s[6 * 33], s[7 * 33]);
        if (n0 + n < N) *(GAS v4u*)(WT + (size_t)phys_row<KIND>(n0 + n) * K + k0 + 8 * c) = o; }
    LDS_WAIT(); asm volatile("" ::: "memory");
}
__constant__ float INVF[32] = {1.000000000e+00f, 7.498942614e-01f, 5.623413324e-01f, 4.216965139e-01f, 3.162277639e-01f, 2.371373773e-01f, 1.778279394e-01f, 1.333521307e-01f, 1.000000015e-01f, 7.498941571e-02f,
    5.623413250e-02f, 4.216965288e-02f, 3.162277490e-02f, 2.371373773e-02f, 1.778279431e-02f, 1.333521493e-02f, 9.999999776e-03f, 7.498941850e-03f, 5.623413250e-03f, 4.216964822e-03f, 3.162277630e-03f, 2.371373586e-03f,
    1.778279431e-03f, 1.333521446e-03f, 1.000000047e-03f, 7.498942432e-04f, 5.623413017e-04f, 4.216965172e-04f, 3.162277571e-04f, 2.371373703e-04f, 1.778279402e-04f, 1.333521504e-04f};

__device__ __forceinline__ void p_prologue(Frame& F, cargs_t ap) {
    const float* const* in_ = nullptr; (void)in_;
    struct { const float* in[11]; const int* pos; unsigned char* ws; } a;
#pragma unroll
    for (int i = 0; i < 11; ++i) a.in[i] = ap->in[i];
    a.pos = ap->pos; a.ws = ap->ws;
    unsigned char* ws = a.ws;
    LAS float* scr = (LAS float*)(F.lds + F.wave * 12288);
    const int gw = F.vcu * NWAVES + F.wave, NGW = F.G * NWAVES;
    constexpr int I_A = 16 * (A_N / 32), I_B = 16 * ((B_NL + 31) / 32), I_O = 16 * 32;
    constexpr int NITEMS = 2 * I_A + 2 * I_B + 4 * I_O;
    for (int it = gw; it < NITEMS; it += NGW) {
        int r = it;
        if (r < 2 * I_A) { const int l = r / I_A; transpose_item<0>(a.in[6] + (size_t)l * 1024 * A_N, 1024, A_N, (bf16*)(ws + WS_WA) + (size_t)l * A_N * 1024, scr, r % I_A, F.lane); continue; } r -= 2 * I_A;
        if (r < 2 * I_B) { const int l = r / I_B; transpose_item<1>(a.in[8] + (size_t)l * 1024 * B_NL, 1024, B_NL, (bf16*)(ws + WS_WB) + (size_t)l * B_NP * 1024, scr, r % I_B, F.lane); continue; } r -= 2 * I_B;
        { const int l = r / I_O;
          const float* W = ((l & 1) ? a.in[9] : a.in[7]) + (size_t)(l >> 1) * 1024 * 1024;
          transpose_item<2>(W, 1024, 1024, (bf16*)(ws + WS_WO) + (size_t)l * 1024 * 1024, scr, r % I_O, F.lane); }
    }
    { const int gt = (F.vcu * NWAVES + F.wave) * 64 + F.lane, NGT = NGW * 64;
      for (int i = gt; i < 2 * 184 * 128; i += NGT) { const int l = i / (184 * 128), rr = (i / 128) % 184, c = i % 128;
          *(GAS v4u*)((bf16*)(ws + WS_WB) + (size_t)l * B_NP * 1024 + (size_t)(2120 + rr) * 1024 + c * 8) = (v4u){0u, 0u, 0u, 0u}; }
      float* cs = (float*)(ws + WS_COS); float* sn = (float*)(ws + WS_SIN);
      for (int i = gt; i < MTOK * 32; i += NGT) { const int tok = i >> 5, j = i & 31;
          const float angf = (float)a.pos[tok] * INVF[j]; const double x = (double)angf;
          const double k = __builtin_rint(x * 0.15915494309189535); double r = __builtin_fma(-k, 6.283185307179586, x); r = __builtin_fma(-k, 2.4492935982947064e-16, r);
          const float rf = (float)r; cs[i] = __cosf(rf); sn[i] = __sinf(rf); }
    }
    { LAS float* cact = (LAS float*)(F.lds + 98304);
      for (int i = F.tid; i < 8 * 1024; i += NWAVES * 64) { const float v = a.in[1][i]; cact[i] = v / (1.f + __expf(-v)); }
      __syncthreads();
      const float* adaw = a.in[4]; const float* adab = a.in[5]; float* mod = (float*)(ws + WS_MOD);
      const int col = F.lane & 15, kq = F.lane >> 4;
      for (int it = gw; it < 4 * 192; it += NGW) { const int l = it / 192, n0 = (it % 192) * 16;
          float acc[8];
#pragma unroll
          for (int b = 0; b < 8; ++b) acc[b] = 0.f;
          const float* wp = adaw + (size_t)l * 1024 * 3072 + (size_t)(kq * 256) * 3072 + n0 + col;
#pragma unroll 32
          for (int k = 0; k < 256; ++k) { const float w = wp[(size_t)k * 3072];
#pragma unroll
              for (int b = 0; b < 8; ++b) acc[b] += cact[b * 1024 + kq * 256 + k] * w; }
#pragma unroll
          for (int b = 0; b < 8; ++b) { float v = acc[b]; v += __shfl_xor(v, 16); v += __shfl_xor(v, 32); acc[b] = v; }
          if (kq == 0) {
#pragma unroll
              for (int b = 0; b < 8; ++b) mod[((size_t)l * 8 + b) * 3072 + n0 + col] = acc[b] + adab[(size_t)l * 3072 + n0 + col]; }
      }
    }
}

__device__ __forceinline__ void p_norm_mod(Frame& F, const float* hin, const float* g, const float* mod_l, bf16* U) {
    const int gw = F.vcu * NWAVES + F.wave, NGW = F.G * NWAVES;
    for (int r0 = gw * 16; r0 < MTOK; r0 += NGW * 16) {
        const int b = r0 >> 12;
        f32x4 A[4], Bv[4];
#pragma unroll
        for (int j = 0; j < 4; ++j) { const int c = 4 * F.lane + 256 * j; const f32x4 gg = *(const f32x4*)(g + c), sc = *(const f32x4*)(mod_l + (size_t)b * 3072 + 1024 + c);
            A[j] = gg * (sc + 1.0f); Bv[j] = *(const f32x4*)(mod_l + (size_t)b * 3072 + c); }
        for (int rr = 0; rr < 16; ++rr) {
            const int row = r0 + rr; const GAS f32x4* xr = (const GAS f32x4*)(hin + (size_t)row * DM) + F.lane;
            f32x4 v[4]; float s = 0.f;
#pragma unroll
            for (int j = 0; j < 4; ++j) { v[j] = xr[64 * j]; s += (v[j].x * v[j].x + v[j].y * v[j].y) + (v[j].z * v[j].z + v[j].w * v[j].w); }
            const float rstd = 1.0f / sqrtf(wave_sum(s) * (1.f / DM) + NORM_EPS);
            GAS u32x2* o8 = (GAS u32x2*)(U + (size_t)row * DM) + F.lane;
#pragma unroll
            for (int j = 0; j < 4; ++j) { const f32x4 y = (v[j] * rstd) * A[j] + Bv[j]; o8[64 * j] = (u32x2){cvtpk(y.x, y.y), cvtpk(y.z, y.w)}; }
        }
    }
}
__device__ __forceinline__ void p_final_norm(Frame& F, const float* hin, const float* g, float* out) {
    const int gw = F.vcu * NWAVES + F.wave, NGW = F.G * NWAVES;
    f32x4 A[4];
#pragma unroll
    for (int j = 0; j < 4; ++j) A[j] = *(const f32x4*)(g + 4 * F.lane + 256 * j);
    for (int row = gw; row < MTOK; row += NGW) {
        const GAS f32x4* xr = (const GAS f32x4*)(hin + (size_t)row * DM) + F.lane;
        f32x4 v[4]; float s = 0.f;
#pragma unroll
        for (int j = 0; j < 4; ++j) { v[j] = xr[64 * j]; s += (v[j].x * v[j].x + v[j].y * v[j].y) + (v[j].z * v[j].z + v[j].w * v[j].w); }
        const float rstd = 1.0f / sqrtf(wave_sum(s) * (1.f / DM) + NORM_EPS);
        GAS f32x4* o = (GAS f32x4*)(out + (size_t)row * DM) + F.lane;
#pragma unroll
        for (int j = 0; j < 4; ++j) o[64 * j] = (v[j] * rstd) * A[j];
    }
}

__device__ __forceinline__ void attnA_tile(const bf16* Qp, bf16* Op, const bf16* Kp, const bf16* Vp, float* lsep, int lse_stride, int rstride, int i0, LAS unsigned char* vst, int lane) {
    const int q32 = lane & 31, hi = lane >> 5;
    bf16x8 qf[4];
    { const bf16* qrow = Qp + (size_t)(i0 + q32) * rstride + 8 * hi;
#pragma unroll
      for (int ks = 0; ks < 4; ++ks) qf[ks] = *(const bf16x8*)(qrow + 16 * ks); }
    f32x16 o0 = {}, o1 = {};
    float m_run = -INFINITY, l_run = 0.f;
    const int kt0 = (i0 >= 128) ? 0 : (128 - i0) / 32;
    bf16x8 kf[4]; v4u vr[4];
    const int vc = lane & 7, vrow = lane >> 3;
#define ATT_LOADKV(kb_) do { const bf16* kr_ = Kp + (size_t)((kb_) + q32) * rstride + 8 * hi; \
        _Pragma("unroll") for (int ks = 0; ks < 4; ++ks) kf[ks] = *(const bf16x8*)(kr_ + 16 * ks); \
        _Pragma("unroll") for (int i = 0; i < 4; ++i) vr[i] = *(const v4u*)(Vp + (size_t)((kb_) + vrow + 8 * i) * rstride + 8 * vc); } while (0)
    ATT_LOADKV(i0 - 128 + 32 * kt0);
    const int q4 = (lane & 15) >> 2, blk = (lane >> 4) & 1, p4 = lane & 3;
    for (int kt = kt0; kt < 5; ++kt) {
#pragma unroll
        for (int i = 0; i < 4; ++i) *(LAS v4u*)(vst + vimg(vrow + 8 * i, vc)) = vr[i];
        bf16x8 kc[4];
#pragma unroll
        for (int ks = 0; ks < 4; ++ks) kc[ks] = kf[ks];
        if (kt + 1 < 5) ATT_LOADKV(i0 - 128 + 32 * (kt + 1));
        f32x16 p = {};
#pragma unroll
        for (int ks = 0; ks < 4; ++ks) p = MFMA32(kc[ks], qf[ks], p);
        if (kt == 0) {
#pragma unroll
            for (int r = 0; r < 16; ++r) if (crow(r, hi) < q32) p[r] = -INFINITY;
        }
        if (kt == 4) {
#pragma unroll
            for (int r = 0; r < 16; ++r) if (crow(r, hi) > q32) p[r] = -INFINITY;
        }
        float mt = p[0];
#pragma unroll
        for (int r = 1; r < 16; ++r) mt = fmaxf(mt, p[r]);
        mt = swap_max(mt);
        const float m_new = fmaxf(m_run, mt);
        const float alpha = __builtin_amdgcn_exp2f(m_run - m_new);
        float s = 0.f;
#pragma unroll
        for (int r = 0; r < 16; ++r) { p[r] = __builtin_amdgcn_exp2f(p[r] - m_new); s += p[r]; }
        l_run = l_run * alpha + s; m_run = m_new;
#pragma unroll
        for (int r = 0; r < 16; ++r) { o0[r] *= alpha; o1[r] *= alpha; }
        bf16x8 pf[2];
#pragma unroll
        for (int ks = 0; ks < 2; ++ks) { v4u w; w.x = cvtpk(p[8 * ks + 0], p[8 * ks + 1]); w.y = cvtpk(p[8 * ks + 2], p[8 * ks + 3]); w.z = cvtpk(p[8 * ks + 4], p[8 * ks + 5]); w.w = cvtpk(p[8 * ks + 6], p[8 * ks + 7]); pf[ks] = __builtin_bit_cast(bf16x8, w); }
        LDS_WAIT(); asm volatile("" ::: "memory");
#pragma unroll
        for (int ks = 0; ks < 2; ++ks)
#pragma unroll
            for (int d0 = 0; d0 < 2; ++d0) {
                const s16x4 lo = vtr(vst + vimg(16 * ks + 4 * hi + q4, 4 * d0 + 2 * blk + (p4 >> 1)) + 8 * (p4 & 1));
                const s16x4 up = vtr(vst + vimg(16 * ks + 8 + 4 * hi + q4, 4 * d0 + 2 * blk + (p4 >> 1)) + 8 * (p4 & 1));
                const bf16x8 vf = (bf16x8){lo[0], lo[1], lo[2], lo[3], up[0], up[1], up[2], up[3]};
                if (d0 == 0) o0 = MFMA32(vf, pf[ks], o0); else o1 = MFMA32(vf, pf[ks], o1);
            }
        LDS_WAIT(); asm volatile("" ::: "memory");
    }
#undef ATT_LOADKV
    const float l_tot = swap_sum(l_run), inv = 1.0f / l_tot;
    bf16* orow = Op + (size_t)(i0 + q32) * rstride;
#pragma unroll
    for (int g4 = 0; g4 < 4; ++g4) {
        *(u32x2*)(orow + 8 * g4 + 4 * hi) = (u32x2){cvtpk(o0[4 * g4] * inv, o0[4 * g4 + 1] * inv), cvtpk(o0[4 * g4 + 2] * inv, o0[4 * g4 + 3] * inv)};
        *(u32x2*)(orow + 32 + 8 * g4 + 4 * hi) = (u32x2){cvtpk(o1[4 * g4] * inv, o1[4 * g4 + 1] * inv), cvtpk(o1[4 * g4 + 2] * inv, o1[4 * g4 + 3] * inv)};
    }
    if (hi == 0) lsep[(size_t)(i0 + q32) * lse_stride] = m_run + __builtin_amdgcn_logf(l_tot);
}
__device__ __forceinline__ void p_attnA(Frame& F, bf16* act, float* lse, bf16* dump) {
    LAS unsigned char* vst = F.lds + F.wave * 4096;
    constexpr int NBL = MC / SEQ, NUNITS = NBL * 3 * 16 * 16;
    for (int u = F.bx; u < NUNITS; u += F.G) {
        const int cb = u & 15, h = (u >> 4) & 15, g = (u >> 8) % 3, bl = u / 768;
        const int dl = (g == 0) ? 1 : (g == 1 ? 4 : 16), nbk = 16 / dl;
        const int r = cb / nbk, bk = cb % nbk;
        const size_t row_base = (size_t)bl * SEQ + r;
        bf16* Qp = act + (size_t)(3 * g + 0) * (A_SUB / 2) + row_base * 1024 + h * 64;
        const bf16* Kp = act + (size_t)(3 * g + 1) * (A_SUB / 2) + row_base * 1024 + h * 64;
        const bf16* Vp = act + (size_t)(3 * g + 2) * (A_SUB / 2) + row_base * 1024 + h * 64;
        float* lsep = lse + ((size_t)g * MC + row_base) * 16 + h;
        bf16* Op = dump ? dump + row_base * 1024 + h * 64 : Qp;
        attnA_tile(Qp, Op, Kp, Vp, lsep, 16 * dl, dl * 1024, bk * 256 + 32 * F.wave, vst, F.lane);
    }
}
__device__ __forceinline__ void p_mergeA(Frame& F, const bf16* act, const float* lse, bf16* Z  ) {
    const int gw = F.vcu * NWAVES + F.wave, NGW = F.G * NWAVES;
    const int head = F.lane >> 2;
    for (int row = gw; row < MC; row += NGW) {
        float l0 = lse[((size_t)0 * MC + row) * 16 + head], l1 = lse[((size_t)1 * MC + row) * 16 + head], l2 = lse[((size_t)2 * MC + row) * 16 + head];
        const float mx = fmaxf(l0, fmaxf(l1, l2));
        float e0 = __builtin_amdgcn_exp2f(l0 - mx), e1 = __builtin_amdgcn_exp2f(l1 - mx), e2 = __builtin_amdgcn_exp2f(l2 - mx);
        const float inv = 1.0f / (e0 + e1 + e2); e0 *= inv; e1 *= inv; e2 *= inv;
#pragma unroll
        for (int hf = 0; hf < 2; ++hf) {
            const size_t off = (size_t)row * 1024 + 16 * F.lane + 8 * hf;
            const v4u a0 = *(const v4u*)(act + (size_t)0 * (A_SUB / 2) + off), a1 = *(const v4u*)(act + (size_t)3 * (A_SUB / 2) + off), a2 = *(const v4u*)(act + (size_t)6 * (A_SUB / 2) + off),
                      gg = *(const v4u*)(act + (size_t)9 * (A_SUB / 2) + off);
            v4u o;
#pragma unroll
            for (int k = 0; k < 4; ++k) {
                const float ylo = (e0 * bf_lo(a0[k]) + e1 * bf_lo(a1[k]) + e2 * bf_lo(a2[k])) * bf_lo(gg[k]);
                const float yhi = (e0 * bf_hi(a0[k]) + e1 * bf_hi(a1[k]) + e2 * bf_hi(a2[k])) * bf_hi(gg[k]);
                o[k] = cvtpk(ylo, yhi);
            }
            *(v4u*)(Z + off) = o;
        }
    }
}

__device__ __forceinline__ unsigned ordkey(float f) { unsigned u = __float_as_uint(f); if ((u << 1) == 0u) u = 0u; return (u & 0x80000000u) ? ~u : (u | 0x80000000u); }
__device__ __forceinline__ void index_tile(Frame& F, int b, int t0, const bf16* QI, const bf16* KI, const float* WI, unsigned long long* maskw) {
    LAS float* sc = (LAS float*)F.lds;
    LAS unsigned* hist = (LAS unsigned*)(F.lds + SEL_HIST_OFF) + F.wave * 512;
    LAS unsigned* cand = (LAS unsigned*)(F.lds + SEL_CAND_OFF);
    LAS unsigned long long* stage = (LAS unsigned long long*)(F.lds + SEL_STAGE_OFF);
    const int lane = F.lane, c32 = lane & 31, hi = lane >> 5;
    const size_t tok0 = (size_t)b * SEQ + t0;
#ifndef IDX_REP_SCORE
#define IDX_REP_SCORE 1
#endif
#ifndef IDX_REP_SEL
#define IDX_REP_SEL 1
#endif
    for (int rep_ = 0; rep_ < IDX_REP_SCORE; ++rep_) {
        bf16x8 qf[2][4]; f32x4 wv[2][2][2];
        const int tl = 2 * ((c32 >> 2) & 1) + (c32 >> 4), hd = ((c32 >> 3) & 1) * 4 + (c32 & 3);
#pragma unroll
        for (int R = 0; R < 2; ++R) {
            const bf16* qp = QI + (tok0 + 4 * R + tl) * 512 + hd * 64 + 8 * hi;
#pragma unroll
            for (int ks = 0; ks < 4; ++ks) qf[R][ks] = *(const bf16x8*)(qp + 16 * ks);
#pragma unroll
            for (int tt = 0; tt < 2; ++tt) { const float* wp = WI + (tok0 + 4 * R + 2 * hi + tt) * 8; wv[R][tt][0] = *(const f32x4*)wp; wv[R][tt][1] = *(const f32x4*)(wp + 4); }
        }
        const int nkt = (t0 + 8 + 31) >> 5;
        bf16x8 kf[4];
        const bf16* kbase = KI + ((size_t)b * SEQ + c32) * 64 + 8 * hi;
        int kt = F.wave;
        if (kt < nkt) {
#pragma unroll
            for (int ks = 0; ks < 4; ++ks) kf[ks] = *(const bf16x8*)(kbase + (size_t)kt * 32 * 64 + 16 * ks);
        }
        for (; kt < nkt; kt += NWAVES) {
            bf16x8 kc[4];
#pragma unroll
            for (int ks = 0; ks < 4; ++ks) kc[ks] = kf[ks];
            if (kt + NWAVES < nkt) {
#pragma unroll
                for (int ks = 0; ks < 4; ++ks) kf[ks] = *(const bf16x8*)(kbase + (size_t)(kt + NWAVES) * 32 * 64 + 16 * ks);
            }
#pragma unroll
            for (int R = 0; R < 2; ++R) {
                f32x16 acc = {};
#pragma unroll
                for (int ks = 0; ks < 4; ++ks) acc = MFMA32(qf[R][ks], kc[ks], acc);
#pragma unroll
                for (int tt = 0; tt < 2; ++tt) {
                    float s = 0.f;
#pragma unroll
                    for (int i = 0; i < 8; ++i) s += wv[R][tt][i >> 2][i & 3] * fmaxf(acc[8 * tt + i], 0.f);
                    sc[(4 * R + 2 * hi + tt) * 4096 + kt * 32 + c32] = s;
                }
            }
        }
    }
    __syncthreads();
    for (int rep_ = 0; rep_ < IDX_REP_SEL; ++rep_) {
        const int t = t0 + F.wave, n = t + 1;
        const LAS float* scq = sc + F.wave * 4096;
        unsigned long long myword = 0ull;
        bool done = false;
        if (n <= 256) {
            const int j = lane; const int rem = n - 64 * j;
            myword = rem >= 64 ? ~0ull : (rem > 0 ? ((1ull << rem) - 1ull) : 0ull);
            done = true;
        } else {
            float lo = INFINITY, hi = -INFINITY;
            for (int i = 0; i * 256 < n; ++i) { const int idx = 4 * (lane + 64 * i); const f32x4 v = *(const LAS f32x4*)(scq + idx);
#pragma unroll
                for (int e = 0; e < 4; ++e) if (idx + e < n) { lo = fminf(lo, v[e]); hi = fmaxf(hi, v[e]); } }
#pragma unroll
            for (int o = 1; o < 64; o <<= 1) { lo = fminf(lo, __shfl_xor(lo, o)); hi = fmaxf(hi, __shfl_xor(hi, o)); }
            if (hi > lo) {
                const float scale = 512.0f / (hi - lo);
                *(LAS v4u*)(hist + 8 * lane) = (v4u){0u, 0u, 0u, 0u}; *(LAS v4u*)(hist + 8 * lane + 4) = (v4u){0u, 0u, 0u, 0u};
                LDS_WAIT(); asm volatile("" ::: "memory");
                for (int i = 0; i * 256 < n; ++i) { const int idx = 4 * (lane + 64 * i); const f32x4 v = *(const LAS f32x4*)(scq + idx);
#pragma unroll
                    for (int e = 0; e < 4; ++e) if (idx + e < n) { const int bn = min(511, (int)((v[e] - lo) * scale));
                        __hip_atomic_fetch_add(hist + bn, 1u, __ATOMIC_RELAXED, __HIP_MEMORY_SCOPE_WORKGROUP); } }
                LDS_WAIT(); asm volatile("" ::: "memory");
                const v4u c0 = *(const LAS v4u*)(hist + 8 * lane), c1 = *(const LAS v4u*)(hist + 8 * lane + 4);
                unsigned cc[8] = {c0.x, c0.y, c0.z, c0.w, c1.x, c1.y, c1.z, c1.w};
                const unsigned ls = ((c0.x + c0.y) + (c0.z + c0.w)) + ((c1.x + c1.y) + (c1.z + c1.w));
                unsigned inc = ls;
#pragma unroll
                for (int o = 1; o < 64; o <<= 1) { const unsigned v = __shfl_up(inc, o); if (lane >= o) inc += v; }
                const unsigned total = __shfl(inc, 63);
                const unsigned S = total - inc;
                const bool found = (S < 256u) && (256u <= S + ls);
                unsigned acc = S; int bin = 0; unsigned above = S; bool got = false;
#pragma unroll
                for (int q = 7; q >= 0; --q) { if (!got) { if (acc + cc[q] >= 256u) { bin = q; above = acc; got = true; } else acc += cc[q]; } }
                const unsigned long long fm = __ballot(found);
                const int src = fm ? (__ffsll((long long)fm) - 1) : 0;
                const int B = __shfl(8 * lane + bin, src); const unsigned aboveb = __shfl(above, src);
                const unsigned mB = __shfl(cc[0] * 0u + ((bin == 0) ? cc[0] : (bin == 1) ? cc[1] : (bin == 2) ? cc[2] : (bin == 3) ? cc[3] : (bin == 4) ? cc[4] : (bin == 5) ? cc[5] : (bin == 6) ? cc[6] : cc[7]), src);
                const unsigned kk2 = 256u - aboveb;
                if (mB <= 64u) {
                    LAS unsigned* ckey = cand + F.wave * 128; LAS unsigned* cidx = ckey + 64;
                    unsigned base = 0u;
                    for (int j = 0; 64 * j < n; ++j) {
                        const int sidx = 64 * j + lane; const bool v = sidx < n; const float x = scq[sidx];
                        const int bn = min(511, (int)((x - lo) * scale));
                        const bool gt = v && bn > B, eq = v && bn == B;
                        const unsigned long long wj = __ballot(gt), em = __ballot(eq);
                        if (eq) { const unsigned pos = base + (unsigned)__popcll(em & ((1ull << lane) - 1ull)); ckey[pos] = ordkey(x); cidx[pos] = (unsigned)sidx; }
                        base += (unsigned)__popcll(em);
                        if (lane == j) myword = wj;
                    }
                    stage[F.wave * 64 + lane] = myword;
                    LDS_WAIT(); asm volatile("" ::: "memory");
                    const unsigned m = base;
                    const unsigned mykey = (unsigned)lane < m ? ckey[lane] : 0u, myidx = (unsigned)lane < m ? cidx[lane] : 0u;
                    unsigned rank = 0u;
                    for (unsigned f = 0; f < m; ++f) { const unsigned kf = ckey[f]; rank += (kf > mykey || (kf == mykey && f < (unsigned)lane)) ? 1u : 0u; }
                    if ((unsigned)lane < m && rank < kk2)
                        __hip_atomic_fetch_or((LAS unsigned*)stage + F.wave * 128 + (myidx >> 5), 1u << (myidx & 31u), __ATOMIC_RELAXED, __HIP_MEMORY_SCOPE_WORKGROUP);
                    done = true;
                }
            }
        }
        if (!done) {
            unsigned T = 0u; int kk = 256; unsigned prefix = 0u;
#pragma unroll
            for (int pass = 0; pass < 4; ++pass) {
                const int shift = 24 - 8 * pass;
                *(LAS v4u*)(hist + 4 * lane) = (v4u){0u, 0u, 0u, 0u};
                LDS_WAIT(); asm volatile("" ::: "memory");
                for (int s2 = lane; s2 < n; s2 += 64) {
                    const unsigned key = ordkey(scq[s2]);
                    const bool in = (pass == 0) ? true : ((key >> ((shift + 8) & 31)) == prefix);
                    if (in) __hip_atomic_fetch_add(hist + ((key >> shift) & 255u), 1u, __ATOMIC_RELAXED, __HIP_MEMORY_SCOPE_WORKGROUP);
                }
                LDS_WAIT(); asm volatile("" ::: "memory");
                const v4u c = *(const LAS v4u*)(hist + 4 * lane);
                const unsigned ls = c.x + c.y + c.z + c.w;
                unsigned inc = ls;
#pragma unroll
                for (int o = 1; o < 64; o <<= 1) { const unsigned v = __shfl_up(inc, o); if (lane >= o) inc += v; }
                const unsigned total = __shfl(inc, 63);
                const unsigned S = total - inc;
                const bool found = (S < (unsigned)kk) && ((unsigned)kk <= S + ls);
                unsigned acc = S; int bin; unsigned above;
                if (acc + c.w >= (unsigned)kk) { bin = 3; above = acc; }
                else { acc += c.w; if (acc + c.z >= (unsigned)kk) { bin = 2; above = acc; }
                else { acc += c.z; if (acc + c.y >= (unsigned)kk) { bin = 1; above = acc; }
                else { acc += c.y; bin = 0; above = acc; } } }
                const unsigned long long fm = __ballot(found);
                const int src = fm ? (__ffsll((long long)fm) - 1) : 0;
                const int binb = __shfl(4 * lane + bin, src); const unsigned aboveb = __shfl(above, src);
                prefix = (prefix << 8) | (unsigned)binb; kk -= (int)aboveb;
            }
            T = prefix;
            unsigned taken = 0u; myword = 0ull;
            for (int j = 0; 64 * j < n; ++j) {
                const int s2 = 64 * j + lane; const bool v = s2 < n;
                const unsigned key = v ? ordkey(scq[s2]) : 0u;
                const bool gt = v && key > T, eq = v && key == T;
                const unsigned long long em = __ballot(eq);
                const unsigned rank = taken + (unsigned)__popcll(em & ((1ull << lane) - 1ull));
                const bool sel = gt || (eq && rank < (unsigned)kk);
                taken += (unsigned)__popcll(em);
                const unsigned long long w = __ballot(sel);
                if (lane == j) myword = w;
            }
            stage[F.wave * 64 + lane] = myword;
        } else if (n <= 256) stage[F.wave * 64 + lane] = myword;
    }
    __syncthreads();
    { const int j = F.tid >> 3, tq = F.tid & 7; maskw[((size_t)b * 64 + j) * 4096 + t0 + tq] = stage[tq * 64 + j]; }
}
__device__ __forceinline__ void p_index(Frame& F, const bf16* QI, const bf16* KI, const float* WI, unsigned long long* maskw) {
    for (int L = F.vcu; L < 4096; L += F.G) {
        const int i = L >> 8, v = L & 255, b = i >> 1, tt = (i & 1) ? 511 - v : v;
        index_tile(F, b, tt * 8, QI, KI, WI, maskw);
    }
}

__device__ __forceinline__ void attnB_unit(Frame& F, int b, int kvh, int blkq, const bf16* Q, const bf16* K, const bf16* V, const bf16* G, const unsigned long long* maskw, bf16* Z) {
    const int lane = F.lane, q32 = lane & 31, hi = lane >> 5, w = F.wave;
    const int head = 4 * kvh + (w >> 1), tok = blkq * 64 + 32 * (w & 1) + q32;
    const size_t grow = (size_t)b * SEQ + tok;
    const int NT = blkq + 1;
    bf16x8 qf[4];
    { const bf16* qrow = Q + grow * 1024 + head * 64 + 8 * hi;
#pragma unroll
      for (int ks = 0; ks < 4; ++ks) qf[ks] = *(const bf16x8*)(qrow + 16 * ks); }
    LAS unsigned char* Kb = F.lds; LAS unsigned char* Vb = F.lds + 16384;
    const int srow = F.tid >> 3, sch = F.tid & 7;
    const bf16* ksrc = K + ((size_t)b * SEQ + srow) * 256 + kvh * 64 + 8 * sch;
    const bf16* vsrc = V + ((size_t)b * SEQ + srow) * 256 + kvh * 64 + 8 * sch;
    const unsigned long long* mp = maskw + (size_t)b * 64 * 4096 + tok;
    v4u kreg = *(const v4u*)ksrc, vreg = *(const v4u*)vsrc;
    unsigned long long mw_next = mp[0];
    *(LAS v4u*)(Kb + kimg(srow, sch)) = kreg; *(LAS v4u*)(Vb + vimg(srow, sch)) = vreg;
    __syncthreads();
    f32x16 o0 = {}, o1 = {};
    float m_run = -INFINITY, l_run = 0.f;
    const int q4 = (lane & 15) >> 2, blk = (lane >> 4) & 1, p4 = lane & 3;
    for (int j = 0; j < NT; ++j) {
        const unsigned long long mw = mw_next;
        if (j + 1 < NT) { kreg = *(const v4u*)(ksrc + (size_t)(j + 1) * 64 * 256); vreg = *(const v4u*)(vsrc + (size_t)(j + 1) * 64 * 256); mw_next = mp[(size_t)(j + 1) * 4096]; }
        const LAS unsigned char* Kc = Kb + (j & 1) * 8192; const LAS unsigned char* Vc = Vb + (j & 1) * 8192;
#pragma unroll
        for (int sub = 0; sub < 2; ++sub) {
            f32x16 p = {};
#pragma unroll
            for (int ks = 0; ks < 4; ++ks) { const bf16x8 kfr = *(const LAS bf16x8*)(Kc + kimg(32 * sub + q32, 2 * ks + hi)); p = MFMA32(kfr, qf[ks], p); }
            const unsigned bits = (unsigned)(mw >> (32 * sub)) >> (4 * hi);
#pragma unroll
            for (int r = 0; r < 16; ++r) { if (!((bits >> ((r & 3) + 8 * (r >> 2))) & 1u)) p[r] = -INFINITY; }
            float mt = p[0];
#pragma unroll
            for (int r = 1; r < 16; ++r) mt = fmaxf(mt, p[r]);
            mt = swap_max(mt);
            const float m_new = fmaxf(m_run, mt);
            const float m_use = (m_new == -INFINITY) ? 0.f : m_new;
            const float alpha = __builtin_amdgcn_exp2f(m_run - m_use);
            float s = 0.f;
#pragma unroll
            for (int r = 0; r < 16; ++r) { p[r] = __builtin_amdgcn_exp2f(p[r] - m_use); s += p[r]; }
            l_run = l_run * alpha + s; m_run = m_new;
#pragma unroll
            for (int r = 0; r < 16; ++r) { o0[r] *= alpha; o1[r] *= alpha; }
            bf16x8 pf[2];
#pragma unroll
            for (int ks = 0; ks < 2; ++ks) { v4u ww; ww.x = cvtpk(p[8 * ks + 0], p[8 * ks + 1]); ww.y = cvtpk(p[8 * ks + 2], p[8 * ks + 3]); ww.z = cvtpk(p[8 * ks + 4], p[8 * ks + 5]); ww.w = cvtpk(p[8 * ks + 6], p[8 * ks + 7]); pf[ks] = __builtin_bit_cast(bf16x8, ww); }
#pragma unroll
            for (int ks = 0; ks < 2; ++ks)
#pragma unroll
                for (int d0 = 0; d0 < 2; ++d0) {
                    const s16x4 lo = vtr(Vc + vimg(32 * sub + 16 * ks + 4 * hi + q4, 4 * d0 + 2 * blk + (p4 >> 1)) + 8 * (p4 & 1));
                    const s16x4 up = vtr(Vc + vimg(32 * sub + 16 * ks + 8 + 4 * hi + q4, 4 * d0 + 2 * blk + (p4 >> 1)) + 8 * (p4 & 1));
                    const bf16x8 vf = (bf16x8){lo[0], lo[1], lo[2], lo[3], up[0], up[1], up[2], up[3]};
                    if (d0 == 0) o0 = MFMA32(vf, pf[ks], o0); else o1 = MFMA32(vf, pf[ks], o1);
                }
        }
        if (j + 1 < NT) { *(LAS v4u*)(Kb + ((j + 1) & 1) * 8192 + kimg(srow, sch)) = kreg; *(LAS v4u*)(Vb + ((j + 1) & 1) * 8192 + vimg(srow, sch)) = vreg; }
        __syncthreads();
    }
    const float l_tot = swap_sum(l_run), inv = 1.0f / l_tot;
    const bf16* grow_p = G + grow * 1024 + head * 64;
    bf16* zrow = Z + grow * 1024 + head * 64;
#pragma unroll
    for (int g4 = 0; g4 < 4; ++g4) {
        const u32x2 ga = *(const u32x2*)(grow_p + 8 * g4 + 4 * hi), gb = *(const u32x2*)(grow_p + 32 + 8 * g4 + 4 * hi);
        *(u32x2*)(zrow + 8 * g4 + 4 * hi) = (u32x2){cvtpk(o0[4 * g4] * inv * bf_lo(ga.x), o0[4 * g4 + 1] * inv * bf_hi(ga.x)), cvtpk(o0[4 * g4 + 2] * inv * bf_lo(ga.y), o0[4 * g4 + 3] * inv * bf_hi(ga.y))};
        *(u32x2*)(zrow + 32 + 8 * g4 + 4 * hi) = (u32x2){cvtpk(o1[4 * g4] * inv * bf_lo(gb.x), o1[4 * g4 + 1] * inv * bf_hi(gb.x)), cvtpk(o1[4 * g4 + 2] * inv * bf_lo(gb.y), o1[4 * g4 + 3] * inv * bf_hi(gb.y))};
    }
}
__device__ __forceinline__ void p_attnB(Frame& F, const bf16* Q, const bf16* K, const bf16* V, const bf16* G, const unsigned long long* maskw, bf16* Z) {
    for (int L = F.vcu; L < 2048; L += F.G) {
        const int i = L >> 8, v = L & 255, bh = v >> 3, s = v & 7;
        const int blkq = 16 * (i >> 1) + ((i & 1) ? 15 - s : s);
        attnB_unit(F, bh >> 2, bh & 3, blkq, Q, K, V, G, maskw, Z);
    }
}

__device__ __forceinline__ cargs_t fresh_args() { cargs_t p = (cargs_t)__builtin_amdgcn_kernarg_segment_ptr(); asm volatile("" : "+s"(p)); return p; }
__global__ void __launch_bounds__(NWAVES * 64, 2) trunk_fwd(Args args_unused) {
    extern __shared__ __attribute__((aligned(16))) unsigned char lds[];
    Frame F;
    F.lds = (LAS unsigned char*)lds;
    F.MISC = (volatile LAS unsigned*)(F.lds + MISC_OFF);
    F.tid = threadIdx.x; F.lane = F.tid & 63; F.wave = __builtin_amdgcn_readfirstlane(F.tid >> 6);
    F.G = gridDim.x; F.bx = blockIdx.x; { const int bx = blockIdx.x; F.vcu = (F.G % 8 == 0) ? (bx % 8) * (F.G / 8) + bx / 8 : bx; }
    F.ctl = (gu32*)(fresh_args()->ws + WS_CTL);
    if (F.tid < 64) ((LAS unsigned*)(F.lds + MISC_OFF))[F.tid] = 0u;
    __syncthreads();
#if MK_ONE_LAUNCH
    XcdBarrier bar = xcd_barrier_post((unsigned*)(F.ctl + CW_BAR), F.MISC + 8);
#define SEAM() do { XcdBarrier b_ = bar; asm volatile("" : "+s"(b_.bar), "+s"(b_.x)); xcd_barrier(b_); } while (0)
#define RUN 1
#else
    int seam = 0; const int seg = fresh_args()->seg;
#define SEAM() (++seam)
#define RUN (seam == seg)
#endif
#define WSP(off) (A_->ws + (off))
#define FRESH_F() Frame Fp = F; { int t_ = threadIdx.x; asm volatile("" : "+v"(t_)); Fp.tid = t_; Fp.lane = t_ & 63; Fp.wave = __builtin_amdgcn_readfirstlane(t_ >> 6); asm volatile("" : "+s"(Fp.vcu), "+s"(Fp.G), "+s"(Fp.bx)); }
    if (DUP(0)) { { cargs_t A_ = fresh_args(); FRESH_F(); p_prologue(Fp, A_); } SEAM(); }
    if (P_ON(0) && RUN) { cargs_t A_ = fresh_args(); FRESH_F(); p_prologue(Fp, A_); }
    SEAM();
    for (int lp = 0; lp < 2; ++lp) {
        {
            const int layer = 2 * lp;
            for (int rep_ = 0; rep_ < 1 + DUP(1); ++rep_) { if (rep_) SEAM();
            if (P_ON(1) && RUN) { cargs_t A_ = fresh_args(); FRESH_F(); const float* hin = (layer == 0) ? A_->in[0] : A_->out;
                p_norm_mod(Fp, hin, A_->in[3] + (size_t)layer * 1024, (const float*)WSP(WS_MOD) + (size_t)layer * 8 * 3072, (bf16*)WSP(WS_U)); } }
            SEAM();
            for (int ch = 0; ch < NCHUNK; ++ch) {
                for (int rep_ = 0; rep_ < 1 + DUP(2); ++rep_) { if (rep_) SEAM();
                if (P_ON(2) && RUN) { cargs_t A_ = fresh_args();
                    pg8::Gemm g{(bf16*)WSP(WS_U) + (size_t)ch * MC * 1024, (bf16*)WSP(WS_WA) + (size_t)lp * A_N * 1024, MC, A_N, 1024};
                    pg8::StaticOrder S; { int g_ = F.G, b_ = F.bx; asm volatile("" : "+s"(g_), "+s"(b_)); S.init(MC, A_N, g_, b_); }
                    pg8::EpiA E{A_->ws, ch * MC};
                    pg8::gemm_phase<pg8::EpiA, pg8::StaticOrder, true, true>(F.lds, g, S, E);
                } }
                SEAM();
                if (DUP(3)) { { cargs_t A_ = fresh_args(); FRESH_F(); p_attnA(Fp, (bf16*)WSP(WS_ACT), (float*)WSP(WS_LSE), (bf16*)WSP(WS_END_A)); } SEAM(); }
                if (P_ON(3) && RUN) { cargs_t A_ = fresh_args(); FRESH_F(); p_attnA(Fp, (bf16*)WSP(WS_ACT), (float*)WSP(WS_LSE), nullptr); }
                SEAM();
                if (DUP(4)) { { cargs_t A_ = fresh_args(); FRESH_F(); p_mergeA(Fp, (const bf16*)WSP(WS_ACT), (const float*)WSP(WS_LSE), (bf16*)WSP(WS_U) + (size_t)ch * MC * 1024); } SEAM(); }
                if (P_ON(4) && RUN) { cargs_t A_ = fresh_args(); FRESH_F(); p_mergeA(Fp, (const bf16*)WSP(WS_ACT), (const float*)WSP(WS_LSE), (bf16*)WSP(WS_U) + (size_t)ch * MC * 1024); }
                SEAM();
            }
            for (int rep_ = 0; rep_ < 1 + ((DUP(5) && layer == 0) ? 1 : 0); ++rep_) { if (rep_) SEAM();
            if (P_ON(5) && RUN) { cargs_t A_ = fresh_args(); const float* hin = (layer == 0) ? A_->in[0] : A_->out;
                pg8::Gemm g{(bf16*)WSP(WS_U), (bf16*)WSP(WS_WO) + (size_t)layer * 1024 * 1024, MTOK, 1024, 1024};
                pg8::StaticOrder S; { int g_ = F.G, b_ = F.bx; asm volatile("" : "+s"(g_), "+s"(b_)); S.init(MTOK, 1024, g_, b_); }
                pg8::EpiOut E{hin, A_->out, (const float*)WSP(WS_MOD) + (size_t)layer * 8 * 3072 + 2048};
                pg8::gemm_phase<pg8::EpiOut, pg8::StaticOrder, true, true>(F.lds, g, S, E);
            } }
            SEAM();
        }
        {
            const int layer = 2 * lp + 1;
            if (P_ON(6) && RUN) { cargs_t A_ = fresh_args(); FRESH_F();
                p_norm_mod(Fp, A_->out, A_->in[3] + (size_t)layer * 1024, (const float*)WSP(WS_MOD) + (size_t)layer * 8 * 3072, (bf16*)WSP(WS_U)); }
            SEAM();
            for (int rep_ = 0; rep_ < 1 + DUP(7); ++rep_) { if (rep_) SEAM();
            if (P_ON(7) && RUN) { cargs_t A_ = fresh_args();
                pg8::Gemm g{(bf16*)WSP(WS_U), (bf16*)WSP(WS_WB) + (size_t)lp * B_NP * 1024, MTOK, B_NP, 1024};
                pg8::StaticOrder S; { int g_ = F.G, b_ = F.bx; asm volatile("" : "+s"(g_), "+s"(b_)); S.init(MTOK, B_NP, g_, b_); }
                pg8::EpiB E{A_->ws};
                pg8::gemm_phase<pg8::EpiB, pg8::StaticOrder, true, true>(F.lds, g, S, E);
            } }
            SEAM();
            if (DUP(8)) { { cargs_t A_ = fresh_args(); FRESH_F(); p_index(Fp, (const bf16*)WSP(WS_BQI), (const bf16*)WSP(WS_BKI), (const float*)WSP(WS_BWI), (unsigned long long*)WSP(WS_BMASK)); } SEAM(); }
            if (P_ON(8) && RUN) { cargs_t A_ = fresh_args(); FRESH_F(); p_index(Fp, (const bf16*)WSP(WS_BQI), (const bf16*)WSP(WS_BKI), (const float*)WSP(WS_BWI), (unsigned long long*)WSP(WS_BMASK)); }
            SEAM();
            if (DUP(9)) { { cargs_t A_ = fresh_args(); FRESH_F(); p_attnB(Fp, (const bf16*)WSP(WS_BQ), (const bf16*)WSP(WS_BK), (const bf16*)WSP(WS_BV), (const bf16*)WSP(WS_BG), (const unsigned long long*)WSP(WS_BMASK), (bf16*)WSP(WS_U)); } SEAM(); }
            if (P_ON(9) && RUN) { cargs_t A_ = fresh_args(); FRESH_F(); p_attnB(Fp, (const bf16*)WSP(WS_BQ), (const bf16*)WSP(WS_BK), (const bf16*)WSP(WS_BV), (const bf16*)WSP(WS_BG), (const unsigned long long*)WSP(WS_BMASK), (bf16*)WSP(WS_U)); }
            SEAM();
            if (P_ON(10) && RUN) { cargs_t A_ = fresh_args();
                pg8::Gemm g{(bf16*)WSP(WS_U), (bf16*)WSP(WS_WO) + (size_t)layer * 1024 * 1024, MTOK, 1024, 1024};
                pg8::StaticOrder S; { int g_ = F.G, b_ = F.bx; asm volatile("" : "+s"(g_), "+s"(b_)); S.init(MTOK, 1024, g_, b_); }
                pg8::EpiOut E{A_->out, A_->out, (const float*)WSP(WS_MOD) + (size_t)layer * 8 * 3072 + 2048};
                pg8::gemm_phase<pg8::EpiOut, pg8::StaticOrder, true, true>(F.lds, g, S, E);
            }
            SEAM();
        }
    }
    if (P_ON(11) && RUN) { cargs_t A_ = fresh_args(); FRESH_F(); p_final_norm(Fp, A_->out, A_->in[10], A_->out); }
}

extern "C" void kernel_launch(void* const* d_in, const int* in_sizes, int n_in, void* d_out, int out_size, void* d_ws, size_t ws_size, hipStream_t stream) {
    static int grid = 0;
    if (grid == 0) {
        if (n_in != 11 || in_sizes[0] != MTOK * DM || out_size != MTOK * DM || ws_size < WS_NEED) {
            fprintf(stderr, "kernel_launch: unexpected shapes / workspace (n_in %d, in0 %d, out %d, ws %zu, need %zu); nothing launched\n", n_in, n_in > 0 ? in_sizes[0] : -1, out_size, ws_size, (size_t)WS_NEED); grid = -1; return; }
        int dev = 0, cus = 0, per_cu = 0;
        if (hipGetDevice(&dev) != hipSuccess || hipDeviceGetAttribute(&cus, hipDeviceAttributeMultiprocessorCount, dev) != hipSuccess) { fprintf(stderr, "kernel_launch: device query failed\n"); grid = -1; return; }
        if (hipFuncSetAttribute((const void*)trunk_fwd, hipFuncAttributeMaxDynamicSharedMemorySize, LDS_BYTES) != hipSuccess) { fprintf(stderr, "kernel_launch: hipFuncSetAttribute failed\n"); grid = -1; return; }
        if (hipOccupancyMaxActiveBlocksPerMultiprocessor(&per_cu, (const void*)trunk_fwd, NWAVES * 64, LDS_BYTES) != hipSuccess || per_cu < 1)
            fprintf(stderr, "kernel_launch: note: occupancy query reports %d workgroups per CU\n", per_cu);
        (void)hipGetLastError();
        grid = cus;
    }
    if (grid < 0) return;
    if (hipMemsetAsync((char*)d_ws + WS_CTL, 0, CTL_ZERO_BYTES, stream) != hipSuccess) { fprintf(stderr, "kernel_launch: memset failed\n"); return; }
    Args a{};
    for (int i = 0; i < 11; ++i) a.in[i] = (const float*)d_in[i];
    a.pos = (const int*)d_in[2]; a.out = (float*)d_out; a.ws = (unsigned char*)d_ws; a.seg = 0; a.pad = 0;
#if MK_ONE_LAUNCH
    hipLaunchKernelGGL(trunk_fwd, dim3(grid), dim3(NWAVES * 64), LDS_BYTES, stream, a);
#else
    for (int s = 0; s <= N_SEAMS; ++s) { a.seg = s; hipLaunchKernelGGL(trunk_fwd, dim3(grid), dim3(NWAVES * 64), LDS_BYTES, stream, a); }
#endif
    const hipError_t le = hipPeekAtLastError();
    if (le != hipSuccess) fprintf(stderr, "kernel_launch: launch failed: %s\n", hipGetErrorName(le));
}
```

```cpp
#include <hip/hip_runtime.h>
#include <cstdio>
#include <cstdint>
#include <cmath>
constexpr int NWAVES = 8;
constexpr int NB = 8, SEQ = 4096, DM = 1024, MTOK = NB * SEQ;
constexpr int A_N = 10240, B_NL = 3144, B_NP = 3328;
constexpr int MC = 16384, NCHUNK = MTOK / MC;
constexpr float NORM_EPS = 1e-6f;
#ifndef PMASK
#define PMASK 0xffff
#endif
#define P_ON(k) ((PMASK >> (k)) & 1)
#ifndef DUPMASK
#define DUPMASK 0
#endif
#define DUP(k) ((DUPMASK >> (k)) & 1)
#ifndef MK_ONE_LAUNCH
#define MK_ONE_LAUNCH 1
#endif
constexpr int N_SEAMS = 1 + 2 * ((1 + 3 * NCHUNK + 1) + 5);

constexpr size_t MiB = 1u << 20;
constexpr size_t WS_CTL = 0, CTL_ZERO_BYTES = 1 * MiB;
constexpr size_t WS_MOD = 1 * MiB;
constexpr size_t WS_COS = 2 * MiB, WS_SIN = 6 * MiB;
constexpr size_t WS_WA = 10 * MiB;
constexpr size_t WS_WB = 50 * MiB;
constexpr size_t WS_WO = 63 * MiB;
constexpr size_t WS_U = 72 * MiB;
constexpr size_t WS_ACT = 136 * MiB;
constexpr size_t A_SUB = (size_t)MC * 1024 * 2;
constexpr size_t WS_LSE = WS_ACT + 10 * A_SUB;
constexpr size_t WS_END_A = WS_LSE + (size_t)3 * MC * 16 * 4;
constexpr size_t WS_BQ = WS_ACT, WS_BK = WS_BQ + 64 * MiB, WS_BV = WS_BK + 16 * MiB, WS_BQI = WS_BV + 16 * MiB, WS_BKI = WS_BQI + 32 * MiB,
                 WS_BWI = WS_BKI + 4 * MiB, WS_BG = WS_BWI + 2 * MiB, WS_BMASK = WS_BG + 64 * MiB, WS_END_B = WS_BMASK + 16 * MiB;
constexpr size_t WS_NEED = (WS_END_A > WS_END_B ? WS_END_A : WS_END_B);
static_assert(WS_WA + (size_t)2 * A_N * 1024 * 2 <= WS_WB && WS_WB + (size_t)2 * B_NP * 1024 * 2 <= WS_WO && WS_WO + (size_t)4 * 1024 * 1024 * 2 <= WS_U && WS_U + (size_t)MTOK * 1024 * 2 <= WS_ACT, "ws map");
constexpr int CW_BAR = 4096;

namespace pg8 {
#define PG8_LAS __attribute__((address_space(3)))
typedef unsigned short bf16_t;
typedef short bf16x8 __attribute__((ext_vector_type(8)));
typedef float f32x4 __attribute__((ext_vector_type(4)));
typedef unsigned u32x4 __attribute__((ext_vector_type(4)));
constexpr int BM = 256, BK = 64, HALF = 128, HTB = HALF * BK * 2  , STAGE_BYTES = 8 * HTB, NXCD = 8, WGM = 8;

__host__ __device__ __forceinline__ int lds_byte(int r, int c) { const int st = (r >> 4) * 2 + (c >> 5), rr = r & 15, cc = c & 31, ob = rr * 64 + cc * 2; return st * 1024 + (ob ^ (((ob >> 9) & 1) << 5)); }
__host__ __device__ __forceinline__ void stage_rc(int b, int& R, int& C) { const int st = b / 1024, sb = b % 1024, swz = sb ^ (((sb >> 9) & 1) << 5); R = (st >> 1) * 16 + swz / 64; C = (st & 1) * 32 + (swz % 64) / 2; }
__host__ __device__ __forceinline__ int perm32(int rho) { const int n = rho >> 4, i = rho & 15; return 8 * (i >> 2) + 4 * n + (i & 3); }

struct Unit { int pm, pn; };
struct Gemm { const bf16_t* A; const bf16_t* Bt; int M, N, K; };

struct StaticOrder {
    int nM, nN, nwg, G, c;
    __host__ __device__ void init(int M, int N, int G_, int c_) { nM = M / BM; nN = N / BM; nwg = nM * nN; G = G_; c = c_; }
    __host__ __device__ bool next(int i, Unit& u) const {
        const long L = (long)i * G + c; if (L >= nwg) return false;
        int wgid = (int)L; { const int q = nwg / NXCD, r = nwg % NXCD, xcd = wgid % NXCD, off = wgid / NXCD; wgid = (xcd < r ? xcd * (q + 1) : r * (q + 1) + (xcd - r) * q) + off; }
        const int nig = WGM * nN, gid = wgid / nig, fm = gid * WGM, gsz = (nM - fm) < WGM ? (nM - fm) : WGM;
        u.pm = fm + ((wgid % nig) % gsz); u.pn = (wgid % nig) / gsz; return true;
    }
    __device__ __forceinline__ void a_ready(const Unit&) const {}
    __device__ __forceinline__ void done(const Unit&) const {}
};

__device__ __forceinline__ unsigned cvt_pk_bf16(float lo, float hi) { unsigned r; asm volatile("v_cvt_pk_bf16_f32 %0, %1, %2" : "=v"(r) : "v"(lo), "v"(hi)); return r; }
typedef float f32x2 __attribute__((ext_vector_type(2)));
constexpr float C2F = 0.125f * 1.4426950408889634f;
constexpr float WSC = 0.35355339059327373f * 0.125f;
__device__ __forceinline__ float silu_f(float x) { return x * __builtin_amdgcn_rcpf(1.0f + __builtin_amdgcn_exp2f(-1.4426950408889634f * x)); }
__device__ __forceinline__ f32x4 silu4(f32x4 v) { return (f32x4){silu_f(v[0]), silu_f(v[1]), silu_f(v[2]), silu_f(v[3])}; }
__device__ __forceinline__ u32x4 pack8(f32x4 a, f32x4 b) { u32x4 w; w.x = cvt_pk_bf16(a[0], a[1]); w.y = cvt_pk_bf16(a[2], a[3]); w.z = cvt_pk_bf16(b[0], b[1]); w.w = cvt_pk_bf16(b[2], b[3]); return w; }

__device__ __forceinline__ void epi_store_rows(const f32x4 (&acc)[2][2][4][2], int kind, bf16_t* ob, int pitch, int row0, int col0, int j0, const float* cs, const float* sn) {
#pragma unroll
    for (int ai = 0; ai < 2; ++ai)
#pragma unroll
        for (int m = 0; m < 4; ++m) {
            const int row = row0 + ai * HALF + m * 16;
            f32x4 c4 = (f32x4){1.f, 1.f, 1.f, 1.f}, s4 = (f32x4){0.f, 0.f, 0.f, 0.f};
            if (kind < 2) { c4 = *(const f32x4*)(cs + (size_t)row * 32 + j0); s4 = *(const f32x4*)(sn + (size_t)row * 32 + j0); }
            bf16_t* rowp = ob + (size_t)row * pitch + col0;
#pragma unroll
            for (int bj = 0; bj < 2; ++bj) {
                f32x4 v0 = acc[ai][bj][m][0], v1 = acc[ai][bj][m][1];
                if (kind < 2) { const f32x4 o0 = v0 * c4 - v1 * s4, o1 = v1 * c4 + v0 * s4; v0 = o0; v1 = o1; if (kind == 0) { v0 = v0 * C2F; v1 = v1 * C2F; } }
                else if (kind == 3) { v0 = silu4(v0); v1 = silu4(v1); }
                *(u32x4*)(rowp + bj * HALF) = pack8(v0, v1);
            }
        }
}
struct EpiA {
    static constexpr bool PERM = true, AFTER_DRAIN = false;
    unsigned char* ws; int row_off;
    __device__ __forceinline__ void operator()(const f32x4 (&acc)[2][2][4][2], const Unit& u, int wr, int wc, int fr, int fq) const {
        asm volatile("" : "+v"(fr), "+v"(fq));
        const int t = u.pn >> 2, kind = (t == 9) ? 3 : (t % 3);
        const float* cs = (const float*)(ws + WS_COS) + (size_t)row_off * 32; const float* sn = (const float*)(ws + WS_SIN) + (size_t)row_off * 32;
        epi_store_rows(acc, kind, (bf16_t*)(ws + WS_ACT) + (size_t)t * (A_SUB / 2), 1024, u.pm * BM + wr * 64 + fr, (u.pn & 3) * BM + wc * 32 + 8 * fq, 16 * (wc & 1) + 4 * fq, cs, sn);
    }
};
struct EpiB {
    static constexpr bool PERM = true, AFTER_DRAIN = false;
    unsigned char* ws;
    __device__ __forceinline__ void operator()(const f32x4 (&acc)[2][2][4][2], const Unit& u, int wr, int wc, int fr, int fq) const {
        asm volatile("" : "+v"(fr), "+v"(fq));
        bf16_t* Q = (bf16_t*)(ws + WS_BQ); bf16_t* K = (bf16_t*)(ws + WS_BK); bf16_t* V = (bf16_t*)(ws + WS_BV); bf16_t* QI = (bf16_t*)(ws + WS_BQI); bf16_t* KI = (bf16_t*)(ws + WS_BKI); bf16_t* G = (bf16_t*)(ws + WS_BG);
        float* WI = (float*)(ws + WS_BWI); const float* cs = (const float*)(ws + WS_COS); const float* sn = (const float*)(ws + WS_SIN);
        const int pn = u.pn, row0 = u.pm * BM + wr * 64 + fr, cw = wc * 32 + 8 * fq, j0 = 16 * (wc & 1) + 4 * fq;
        if (pn < 4)       epi_store_rows(acc, 0, Q, 1024, row0, pn * BM + cw, j0, cs, sn);
        else if (pn == 4) epi_store_rows(acc, 1, K, 256, row0, cw, j0, cs, sn);
        else if (pn == 5) epi_store_rows(acc, 2, V, 256, row0, cw, j0, cs, sn);
        else if (pn < 8)  epi_store_rows(acc, 1, QI, 512, row0, (pn - 6) * BM + cw, j0, cs, sn);
        else if (pn > 8)  epi_store_rows(acc, 3, G, 1024, row0, (pn - 9) * BM + cw, j0, cs, sn);
        else {
#pragma unroll
            for (int ai = 0; ai < 2; ++ai)
#pragma unroll
                for (int m = 0; m < 4; ++m) {
                    const int row = row0 + ai * HALF + m * 16;
                    const f32x4 v0 = acc[ai][0][m][0], v1 = acc[ai][0][m][1];
                    if (wc < 2) {
                        const f32x4 c4 = *(const f32x4*)(cs + (size_t)row * 32 + j0), s4 = *(const f32x4*)(sn + (size_t)row * 32 + j0);
                        *(u32x4*)(KI + (size_t)row * 64 + cw) = pack8(v0 * c4 - v1 * s4, v1 * c4 + v0 * s4);
                    } else if (wc == 2 && fq == 0) {
                        *(f32x4*)(WI + (size_t)row * 8) = v0 * WSC; *(f32x4*)(WI + (size_t)row * 8 + 4) = v1 * WSC;
                    }
                }
        }
    }
};
struct EpiOut {
    static constexpr bool PERM = false, AFTER_DRAIN = false;
    const float* hin; float* hout; const float* gate;
    __device__ __forceinline__ void operator()(const f32x4 (&acc)[2][2][4][2], const Unit& u, int wr, int wc, int fr, int fq) const {
        asm volatile("" : "+v"(fr), "+v"(fq));
        const int col0 = u.pn * BM + wc * 32 + 4 * fq;
#pragma unroll
        for (int ai = 0; ai < 2; ++ai)
#pragma unroll
            for (int m = 0; m < 4; ++m) {
                const int row = u.pm * BM + ai * HALF + wr * 64 + m * 16 + fr; const int b = row >> 12;
#pragma unroll
                for (int bj = 0; bj < 2; ++bj)
#pragma unroll
                    for (int n = 0; n < 2; ++n) {
                        const int c = col0 + bj * HALF + n * 16;
                        const f32x4 g4 = *(const f32x4*)(gate + (size_t)b * 3072 + c), h4 = *(const f32x4*)(hin + (size_t)row * 1024 + c);
                        *(f32x4*)(hout + (size_t)row * 1024 + c) = h4 + g4 * acc[ai][bj][m][n];
                    }
            }
    }
};

template <class Epi, class Sched, bool ALIGN_EPI = false, bool SP2 = false>
__device__ __forceinline__ void gemm_phase(PG8_LAS unsigned char* lds, const Gemm g, const Sched& S, const Epi& E) {
    int tid_ = threadIdx.x; asm volatile("" : "+v"(tid_));
    const int tid = tid_, wid = __builtin_amdgcn_readfirstlane(tid >> 6), lane = tid & 63, wr = wid >> 2, wc = wid & 3, fr = lane & 15, fq = lane >> 4;
    const int K = g.K, nt = K / BK;
    unsigned voffA[2], voffB[2];
#pragma unroll
    for (int i = 0; i < 2; ++i) { int R, C; stage_rc(tid * 16 + i * 8192, R, C); const int Rb = Epi::PERM ? ((R & ~31) + perm32(R & 31)) : R;
        voffA[i] = (unsigned)(R * K + C) * 2u; voffB[i] = (unsigned)(Rb * K + C) * 2u; }
    const size_t kstep = (size_t)(BK * 2);
    const size_t hstep = (size_t)HALF * K * 2;
    const size_t tstep = 2 * hstep;
    const unsigned ldsw = (unsigned)wid * 1024u;
    const int aoff = lds_byte(wr * 64 + fr, fq * 8), boff = lds_byte(wc * 32 + fr, fq * 8);
#define PG8_SA(b, h) (((b) * 2 + (h)) * HTB)
#define PG8_SB(b, h) ((4 + (b) * 2 + (h)) * HTB)
#define PG8_STAGE(bufoff, gbase, voff) do { _Pragma("unroll") for (int _i = 0; _i < 2; ++_i) \
        __builtin_amdgcn_global_load_lds((const unsigned*)((const char*)(gbase) + (voff)[_i]), (PG8_LAS unsigned*)(lds + (bufoff) + ldsw + _i * 8192), 16, 0, 0); } while (0)
#define PG8_LDA(dst, b, h) do { _Pragma("unroll") for (int m = 0; m < 4; ++m) _Pragma("unroll") for (int k = 0; k < 2; ++k) dst[m][k] = *(const PG8_LAS bf16x8*)(lds + PG8_SA(b, h) + aoff + m * 2048 + k * 1024); } while (0)
#define PG8_LDB(dst, b, h) do { _Pragma("unroll") for (int n = 0; n < 2; ++n) _Pragma("unroll") for (int k = 0; k < 2; ++k) dst[n][k] = *(const PG8_LAS bf16x8*)(lds + PG8_SB(b, h) + boff + n * 2048 + k * 1024); } while (0)
#define PG8_MMA(ai, bj, At, Bt) do { __builtin_amdgcn_s_setprio(1); _Pragma("unroll") for (int m = 0; m < 4; ++m) _Pragma("unroll") for (int n = 0; n < 2; ++n) _Pragma("unroll") for (int k = 0; k < 2; ++k) \
        acc[ai][bj][m][n] = __builtin_amdgcn_mfma_f32_16x16x32_bf16(Bt[n][k], At[m][k], acc[ai][bj][m][n], 0, 0, 0); __builtin_amdgcn_s_setprio(0); } while (0)
#define PG8_WAIT_V(n) asm volatile("s_waitcnt vmcnt(" #n ")" ::: "memory")
#define PG8_WAIT_L(n) asm volatile("s_waitcnt lgkmcnt(" #n ")" ::: "memory")
#define PG8_BAR __builtin_amdgcn_s_barrier()
#define PG8_SCHED __builtin_amdgcn_sched_barrier(0)
    Unit cur, nxt; int ui = 0;
    if (!S.next(0, cur)) return;
    f32x4 acc[2][2][4][2];
#pragma unroll
    for (int a = 0; a < 2; ++a)
#pragma unroll
        for (int b = 0; b < 2; ++b)
#pragma unroll
            for (int m = 0; m < 4; ++m)
#pragma unroll
                for (int n = 0; n < 2; ++n) acc[a][b][m][n] = (f32x4){0.f, 0.f, 0.f, 0.f};
    bf16x8 At[4][2], B0[2][2], B1[2][2];
    const char* cA = (const char*)g.A + (size_t)cur.pm * tstep; const char* cB = (const char*)g.Bt + (size_t)cur.pn * tstep;
    S.a_ready(cur);
    if constexpr (SP2) {
        PG8_STAGE(PG8_SB(0, 0), cB, voffB); PG8_STAGE(PG8_SB(0, 1), cB + hstep, voffB); PG8_STAGE(PG8_SA(0, 0), cA, voffA); PG8_STAGE(PG8_SA(0, 1), cA + hstep, voffA);
        if (wr == 1) PG8_BAR;
        PG8_WAIT_V(2); PG8_BAR;
        PG8_STAGE(PG8_SB(1, 0), cB + kstep, voffB); PG8_STAGE(PG8_SA(1, 0), cA + kstep, voffA); PG8_STAGE(PG8_SB(1, 1), cB + hstep + kstep, voffB);
        PG8_WAIT_V(6); PG8_BAR;
    } else {
        PG8_STAGE(PG8_SB(0, 0), cB, voffB); PG8_STAGE(PG8_SA(0, 0), cA, voffA); PG8_STAGE(PG8_SB(0, 1), cB + hstep, voffB); PG8_STAGE(PG8_SA(0, 1), cA + hstep, voffA);
        if (wr == 1) PG8_BAR;
        PG8_WAIT_V(4); PG8_BAR;
        PG8_STAGE(PG8_SB(1, 0), cB + kstep, voffB); PG8_STAGE(PG8_SA(1, 0), cA + kstep, voffA); PG8_STAGE(PG8_SB(1, 1), cB + hstep + kstep, voffB);
        PG8_WAIT_V(6); PG8_BAR;
    }
    for (;;) {
        const bool has_next = S.next(ui + 1, nxt);
        const char* nA = has_next ? (const char*)g.A + (size_t)nxt.pm * tstep : cA; const char* nB = has_next ? (const char*)g.Bt + (size_t)nxt.pn * tstep : cB;
        for (int t = 0; t < nt; t += 2) {
            const bool last = (t == nt - 2);
            const char* a1 = cA + (size_t)(t + 1) * kstep;
            const char* a2 = last ? nA : cA + (size_t)(t + 2) * kstep; const char* b2 = last ? nB : cB + (size_t)(t + 2) * kstep;
            const char* a3 = a2 + kstep; const char* b3 = b2 + kstep;
            if (last && has_next) S.a_ready(nxt);
            if constexpr (SP2) {
            PG8_LDB(B0, 0, 0); PG8_LDB(B1, 0, 1); PG8_SCHED; PG8_LDA(At, 0, 0); PG8_STAGE(PG8_SA(1, 1), a1 + hstep, voffA);
            PG8_WAIT_V(8); PG8_WAIT_L(0); PG8_BAR; PG8_MMA(0, 0, At, B0); PG8_MMA(0, 1, At, B1); PG8_BAR; PG8_SCHED;
            PG8_LDA(At, 0, 1); PG8_STAGE(PG8_SB(0, 0), b2, voffB); PG8_STAGE(PG8_SB(0, 1), b2 + hstep, voffB); PG8_STAGE(PG8_SA(0, 0), a2, voffA);
            PG8_WAIT_V(8); PG8_WAIT_L(0); PG8_BAR; PG8_MMA(1, 0, At, B0); PG8_MMA(1, 1, At, B1); PG8_BAR; PG8_SCHED;
            PG8_LDB(B0, 1, 0); PG8_LDB(B1, 1, 1); PG8_SCHED; PG8_LDA(At, 1, 0); PG8_STAGE(PG8_SA(0, 1), a2 + hstep, voffA);
            PG8_WAIT_V(8); PG8_WAIT_L(0); PG8_BAR; PG8_MMA(0, 0, At, B0); PG8_MMA(0, 1, At, B1); PG8_BAR; PG8_SCHED;
            PG8_LDA(At, 1, 1); PG8_STAGE(PG8_SB(1, 0), b3, voffB); PG8_STAGE(PG8_SB(1, 1), b3 + hstep, voffB); PG8_STAGE(PG8_SA(1, 0), a3, voffA);
            PG8_WAIT_V(8); PG8_WAIT_L(0); PG8_BAR; PG8_MMA(1, 0, At, B0); PG8_MMA(1, 1, At, B1); PG8_BAR; PG8_SCHED;
            } else {
            PG8_LDB(B0, 0, 0); PG8_SCHED; PG8_LDA(At, 0, 0); PG8_STAGE(PG8_SA(1, 1), a1 + hstep, voffA);
            PG8_WAIT_L(8); PG8_BAR; PG8_WAIT_L(0); PG8_MMA(0, 0, At, B0); PG8_BAR; PG8_SCHED;
            PG8_LDB(B1, 0, 1); PG8_STAGE(PG8_SB(0, 0), b2, voffB);
            PG8_BAR; PG8_WAIT_L(0); PG8_MMA(0, 1, At, B1); PG8_BAR;
            PG8_LDA(At, 0, 1); PG8_STAGE(PG8_SA(0, 0), a2, voffA);
            PG8_BAR; PG8_WAIT_L(0); PG8_MMA(1, 0, At, B0); PG8_BAR; PG8_SCHED;
            PG8_STAGE(PG8_SB(0, 1), b2 + hstep, voffB);
            PG8_WAIT_V(6); PG8_BAR; PG8_MMA(1, 1, At, B1); PG8_BAR;
            PG8_LDB(B0, 1, 0); PG8_SCHED; PG8_LDA(At, 1, 0); PG8_STAGE(PG8_SA(0, 1), a2 + hstep, voffA);
            PG8_WAIT_L(8); PG8_BAR; PG8_WAIT_L(0); PG8_MMA(0, 0, At, B0); PG8_BAR; PG8_SCHED;
            PG8_LDB(B1, 1, 1); PG8_STAGE(PG8_SB(1, 0), b3, voffB);
            PG8_BAR; PG8_WAIT_L(0); PG8_MMA(0, 1, At, B1); PG8_BAR;
            PG8_LDA(At, 1, 1); PG8_STAGE(PG8_SA(1, 0), a3, voffA);
            PG8_BAR; PG8_WAIT_L(0); PG8_MMA(1, 0, At, B0); PG8_BAR; PG8_SCHED;
            PG8_STAGE(PG8_SB(1, 1), b3 + hstep, voffB);
            PG8_WAIT_V(6); PG8_BAR; PG8_MMA(1, 1, At, B1); PG8_BAR;
            }
        }
        if constexpr (ALIGN_EPI) { if (wr == 0) PG8_BAR; }
        if constexpr (!Epi::AFTER_DRAIN) { E(acc, cur, wr, wc, fr, fq); S.done(cur); }
        if (!has_next) break;
#pragma unroll
        for (int a = 0; a < 2; ++a)
#pragma unroll
            for (int b = 0; b < 2; ++b)
#pragma unroll
                for (int m = 0; m < 4; ++m)
#pragma unroll
                    for (int n = 0; n < 2; ++n) acc[a][b][m][n] = (f32x4){0.f, 0.f, 0.f, 0.f};
        cur = nxt; cA = nA; cB = nB; ++ui;
        if constexpr (ALIGN_EPI) { if (wr == 1) PG8_BAR; }
    }
    PG8_WAIT_V(0);
    if constexpr (!ALIGN_EPI) { if (wr == 0) PG8_BAR; }
    PG8_BAR;
    if constexpr (Epi::AFTER_DRAIN) { E.fused(acc, cur, wr, wc, fr, fq, lds, wid, lane); S.done(cur); }
#undef PG8_SA
#undef PG8_SB
#undef PG8_STAGE
#undef PG8_LDA
#undef PG8_LDB
#undef PG8_MMA
#undef PG8_WAIT_V
#undef PG8_WAIT_L
#undef PG8_BAR
#undef PG8_SCHED
}
}
#define GAS __attribute__((address_space(1)))
#define LAS __attribute__((address_space(3)))
typedef unsigned short bf16;
typedef unsigned v4u __attribute__((ext_vector_type(4)));
typedef float f32x4 __attribute__((ext_vector_type(4)));
typedef short bf16x8 __attribute__((ext_vector_type(8)));
typedef GAS unsigned gu32;
typedef GAS unsigned long long gu64;
#define RLX_AGENT __ATOMIC_RELAXED, __HIP_MEMORY_SCOPE_AGENT
#define LDS_WAIT() asm volatile("s_waitcnt lgkmcnt(0)" ::: "memory")
#define VM_WAIT() asm volatile("s_waitcnt vmcnt(0)" ::: "memory")
__device__ __forceinline__ unsigned long long rt() { return __builtin_amdgcn_s_memrealtime(); }
__device__ __forceinline__ unsigned f2bf(float f) { unsigned u = __builtin_bit_cast(unsigned, f); return (u + 0x7fffu + ((u >> 16) & 1u)) >> 16; }
__device__ __forceinline__ unsigned pk2(float lo, float hi) { return f2bf(lo) | (f2bf(hi) << 16); }

#define XB_TMO      128
#define XB_XCNT(j)  (256  + 64 * (j))
#define XB_XSUB(j)  (1280 + 64 * (j))
#define XB_XGEN(j)  (2304 + 64 * (j))
#define XB_TOP      3328
#define XB_TOPGEN   3392
#define XCD_BAR_WORDS 3456
#define XB_SPIN_CAP (1u << 18)

__device__ __forceinline__ unsigned xb_ld(unsigned* p)              { return __hip_atomic_load(p, __ATOMIC_RELAXED, __HIP_MEMORY_SCOPE_AGENT); }
__device__ __forceinline__ unsigned xb_add(unsigned* p, unsigned v) { return __hip_atomic_fetch_add(p, v, __ATOMIC_RELAXED, __HIP_MEMORY_SCOPE_AGENT); }
__device__ __forceinline__ unsigned xb_xcc_id() { return (unsigned)__builtin_amdgcn_s_getreg((3 << 11) | 20) & 0xFu; }
#define XB_SPIN(cond, bar) do { unsigned _sp = 0; while (cond) { __builtin_amdgcn_s_sleep(1); \
    if ((++_sp & 255u) == 0u) { if (xb_ld(&(bar)[XB_TMO])) break; if (_sp > XB_SPIN_CAP) { atomicAdd(&(bar)[XB_TMO], 1u); break; } } } } while (0)

struct XcdBarrier {
    unsigned* bar; unsigned x;
    volatile LAS unsigned* st;
};

__device__ __forceinline__ XcdBarrier xcd_barrier_post(unsigned* bar, volatile LAS unsigned* st) {
    XcdBarrier b; b.bar = bar; b.x = xb_xcc_id(); b.st = st;
    if (threadIdx.x == 0) (void)xb_add(&bar[XB_XCNT(b.x)], 1u);
    return b;
}
__device__ __forceinline__ void xcd_barrier_complete(unsigned* bar, unsigned x, unsigned& nloc, unsigned& nx) {
    const unsigned G = gridDim.x * gridDim.y * gridDim.z;
    unsigned sum, cnt, mine, sp = 0u;
    for (;;) {
        sum = 0u; cnt = 0u; mine = 0u;
#pragma unroll
        for (unsigned j = 0; j < 16; ++j) { const unsigned c = xb_ld(&bar[XB_XCNT(j)]); sum += c; cnt += (c > 0u) ? 1u : 0u; mine = (j == x) ? c : mine; }
        if (sum == G) break;
        __builtin_amdgcn_s_sleep(1);
        if ((++sp & 255u) == 0u) { if (xb_ld(&bar[XB_TMO])) break; if (sp > XB_SPIN_CAP) { atomicAdd(&bar[XB_TMO], 1u); break; } }
    }
    nloc = mine > 0u ? mine : 1u; nx = cnt > 0u ? cnt : 1u;
}

__device__ __forceinline__ void xcd_barrier(const XcdBarrier& b) {
    asm volatile("s_waitcnt vmcnt(0)" ::: "memory");
    __syncthreads();
    if (threadIdx.x == 0) {
        unsigned* bar = b.bar;
        __builtin_amdgcn_s_waitcnt(0);
        unsigned nloc = b.st[0], nx = b.st[1];
        if (nloc == 0u) { xcd_barrier_complete(bar, b.x, nloc, nx); b.st[0] = nloc; b.st[1] = nx; }
        const unsigned old = xb_add(&bar[XB_XSUB(b.x)], 1u);
        const unsigned gen = old / nloc;
        if (old + 1u == (gen + 1u) * nloc) {
            __builtin_amdgcn_fence(__ATOMIC_RELEASE, "agent");
            asm volatile("s_waitcnt vmcnt(0)" ::: "memory");
            const unsigned og = xb_add(&bar[XB_TOP], 1u);
            const unsigned tg = og / nx;
            if (og + 1u == (tg + 1u) * nx) xb_add(&bar[XB_TOPGEN], 1u);
            else XB_SPIN(xb_ld(&bar[XB_TOPGEN]) == tg, bar);
            __builtin_amdgcn_fence(__ATOMIC_ACQUIRE, "agent");
            xb_add(&bar[XB_XGEN(b.x)], 1u);
            asm volatile("s_waitcnt vmcnt(0)" ::: "memory");
        } else {
            XB_SPIN(xb_ld(&bar[XB_XGEN(b.x)]) == gen, bar);
            __builtin_amdgcn_fence(__ATOMIC_ACQUIRE, "agent");
            asm volatile("s_waitcnt vmcnt(0)" ::: "memory");
        }
    }
    __syncthreads();
}

constexpr int RING_BYTES = 131072;
constexpr int SEL_HIST_OFF = 131072, SEL_CAND_OFF = SEL_HIST_OFF + 16384, SEL_STAGE_OFF = SEL_CAND_OFF + 4096, MISC_OFF = SEL_STAGE_OFF + 4096, LDS_BYTES = 159744;
static_assert(MISC_OFF + 256 <= LDS_BYTES, "LDS map");

typedef short s16x4 __attribute__((ext_vector_type(4)));
typedef short v4i16_t __attribute__((ext_vector_type(4)));
typedef float f32x16 __attribute__((ext_vector_type(16)));
typedef unsigned u32x2 __attribute__((ext_vector_type(2)));
__device__ __forceinline__ float wave_sum(float v) {
#pragma unroll
    for (int o = 1; o < 64; o <<= 1) v += __shfl_xor(v, o);
    return v;
}
__device__ __forceinline__ unsigned cvtpk(float lo, float hi) { unsigned r; asm volatile("v_cvt_pk_bf16_f32 %0, %1, %2" : "=v"(r) : "v"(lo), "v"(hi)); return r; }
__device__ __forceinline__ float bf_lo(unsigned w) { return __uint_as_float(w << 16); }
__device__ __forceinline__ float bf_hi(unsigned w) { return __uint_as_float(w & 0xffff0000u); }
__device__ __forceinline__ float swap_max(float m) { auto rr = __builtin_amdgcn_permlane32_swap(__float_as_uint(m), __float_as_uint(m), false, false); return fmaxf(__uint_as_float(rr[0]), __uint_as_float(rr[1])); }
__device__ __forceinline__ float swap_sum(float m) { auto rr = __builtin_amdgcn_permlane32_swap(__float_as_uint(m), __float_as_uint(m), false, false); return __uint_as_float(rr[0]) + __uint_as_float(rr[1]); }
__device__ __forceinline__ int crow(int r, int hi) { return (r & 3) + 8 * (r >> 2) + 4 * hi; }
__device__ __forceinline__ unsigned vimg(unsigned row, unsigned ch) { return row * 128u + 16u * (ch ^ ((row & 3u) | (((row >> 1) & 1u) << 2))); }
__device__ __forceinline__ unsigned kimg(unsigned row, unsigned ch) { return row * 128u + 16u * (ch ^ ((row >> 1) & 7u)); }
__device__ __forceinline__ s16x4 vtr(const LAS unsigned char* p) { return __builtin_bit_cast(s16x4, __builtin_amdgcn_ds_read_tr16_b64_v4i16((LAS v4i16_t*)p)); }
#define MFMA32(a, b, c) __builtin_amdgcn_mfma_f32_32x32x16_bf16((a), (b), (c), 0, 0, 0)

struct Frame {
    LAS unsigned char* lds; volatile LAS unsigned* MISC; gu32* ctl;
    int tid, lane, wave, vcu, G, bx;
};
struct Args { const float* in[11]; const int* pos; float* out; unsigned char* ws; int seg; int pad; };
typedef const Args __attribute__((address_space(4)))* cargs_t;

__device__ __forceinline__ int rope_perm64(int c) { return ((c & 31) >> 2) * 8 + (c & 3) + ((c >> 5) << 2); }
template <int KIND> __device__ __forceinline__ int phys_row(int n) {
    if (KIND == 0) { if (n < 9216 && ((n >> 10) % 3) < 2) return (n & ~63) + rope_perm64(n & 63); return n; }
    if (KIND == 1) { if (n < 1280 || (n >= 1536 && n < 2112)) return (n & ~63) + rope_perm64(n & 63); if (n >= 2120) return n + 184; return n; }
    return n;
}
template <int KIND> __device__ __forceinline__ void transpose_item(const float* W, int K, int N, bf16* WT, LAS float* scr, int item, int lane) {
    const int nblk = (N + 31) / 32, kb = item / nblk, nb = item % nblk, k0 = 64 * kb, n0 = 32 * nb;
    const bool nok = n0 + (lane & 31) < N;
#pragma unroll 8
    for (int i = 0; i < 32; ++i) { const int kk = 2 * i + (lane >> 5); scr[kk * 33 + (lane & 31)] = nok ? W[(size_t)(k0 + kk) * N + n0 + (lane & 31)] : 0.f; }
    LDS_WAIT(); asm volatile("" ::: "memory");
    const int c = lane & 7;
#pragma unroll
    for (int j = 0; j < 4; ++j) { const int n = (lane >> 3) + 8 * j; const LAS float* s = scr + (8 * c) * 33 + n;
        v4u o; o.x = pk2(s[0 * 33], s[1 * 33]); o.y = pk2(s[2 * 33], s[3 * 33]); o.z = pk2(s[4 * 33], s[5 * 33]); o.w = pk2(s[6 * 33], s[7 * 33]);
        if (n0 + n < N) *(GAS v4u*)(WT + (size_t)phys_row<KIND>(n0 + n) * K + k0 + 8 * c) = o; }
    LDS_WAIT(); asm volatile("" ::: "memory");
}
__constant__ float INVF[32] = {1.000000000e+00f, 7.498942614e-01f, 5.623413324e-01f, 4.216965139e-01f, 3.162277639e-01f, 2.371373773e-01f, 1.778279394e-01f, 1.333521307e-01f, 1.000000015e-01f, 7.498941571e-02f,
    5.623413250e-02f, 4.216965288e-02f, 3.162277490e-02f, 2.371373773e-02f, 1.778279431e-02f, 1.333521493e-02f, 9.999999776e-03f, 7.498941850e-03f, 5.623413250e-03f, 4.216964822e-03f, 3.162277630e-03f, 2.371373586e-03f,
    1.778279431e-03f, 1.333521446e-03f, 1.000000047e-03f, 7.498942432e-04f, 5.623413017e-04f, 4.216965172e-04f, 3.162277571e-04f, 2.371373703e-04f, 1.778279402e-04f, 1.333521504e-04f};

__device__ __forceinline__ void p_prologue(Frame& F, cargs_t ap) {
    const float* const* in_ = nullptr; (void)in_;
    struct { const float* in[11]; const int* pos; unsigned char* ws; } a;
#pragma unroll
    for (int i = 0; i < 11; ++i) a.in[i] = ap->in[i];
    a.pos = ap->pos; a.ws = ap->ws;
    unsigned char* ws = a.ws;
    LAS float* scr = (LAS float*)(F.lds + F.wave * 12288);
    const int gw = F.vcu * NWAVES + F.wave, NGW = F.G * NWAVES;
    constexpr int I_A = 16 * (A_N / 32), I_B = 16 * ((B_NL + 31) / 32), I_O = 16 * 32;
    constexpr int NITEMS = 2 * I_A + 2 * I_B + 4 * I_O;
    for (int it = gw; it < NITEMS; it += NGW) {
        int r = it;
        if (r < 2 * I_A) { const int l = r / I_A; transpose_item<0>(a.in[6] + (size_t)l * 1024 * A_N, 1024, A_N, (bf16*)(ws + WS_WA) + (size_t)l * A_N * 1024, scr, r % I_A, F.lane); continue; } r -= 2 * I_A;
        if (r < 2 * I_B) { const int l = r / I_B; transpose_item<1>(a.in[8] + (size_t)l * 1024 * B_NL, 1024, B_NL, (bf16*)(ws + WS_WB) + (size_t)l * B_NP * 1024, scr, r % I_B, F.lane); continue; } r -= 2 * I_B;
        { const int l = r / I_O;
          const float* W = ((l & 1) ? a.in[9] : a.in[7]) + (size_t)(l >> 1) * 1024 * 1024;
          transpose_item<2>(W, 1024, 1024, (bf16*)(ws + WS_WO) + (size_t)l * 1024 * 1024, scr, r % I_O, F.lane); }
    }
    { const int gt = (F.vcu * NWAVES + F.wave) * 64 + F.lane, NGT = NGW * 64;
      for (int i = gt; i < 2 * 184 * 128; i += NGT) { const int l = i / (184 * 128), rr = (i / 128) % 184, c = i % 128;
          *(GAS v4u*)((bf16*)(ws + WS_WB) + (size_t)l * B_NP * 1024 + (size_t)(2120 + rr) * 1024 + c * 8) = (v4u){0u, 0u, 0u, 0u}; }
      float* cs = (float*)(ws + WS_COS); float* sn = (float*)(ws + WS_SIN);
      for (int i = gt; i < MTOK * 32; i += NGT) { const int tok = i >> 5, j = i & 31;
          const float angf = (float)a.pos[tok] * INVF[j]; const double x = (double)angf;
          const double k = __builtin_rint(x * 0.15915494309189535); double r = __builtin_fma(-k, 6.283185307179586, x); r = __builtin_fma(-k, 2.4492935982947064e-16, r);
          const float rf = (float)r; cs[i] = __cosf(rf); sn[i] = __sinf(rf); }
    }
    { LAS float* cact = (LAS float*)(F.lds + 98304);
      for (int i = F.tid; i < 8 * 1024; i += NWAVES * 64) { const float v = a.in[1][i]; cact[i] = v / (1.f + __expf(-v)); }
      __syncthreads();
      const float* adaw = a.in[4]; const float* adab = a.in[5]; float* mod = (float*)(ws + WS_MOD);
      const int col = F.lane & 15, kq = F.lane >> 4;
      for (int it = gw; it < 4 * 192; it += NGW) { const int l = it / 192, n0 = (it % 192) * 16;
          float acc[8];
#pragma unroll
          for (int b = 0; b < 8; ++b) acc[b] = 0.f;
          const float* wp = adaw + (size_t)l * 1024 * 3072 + (size_t)(kq * 256) * 3072 + n0 + col;
#pragma unroll 32
          for (int k = 0; k < 256; ++k) { const float w = wp[(size_t)k * 3072];
#pragma unroll
              for (int b = 0; b < 8; ++b) acc[b] += cact[b * 1024 + kq * 256 + k] * w; }
#pragma unroll
          for (int b = 0; b < 8; ++b) { float v = acc[b]; v += __shfl_xor(v, 16); v += __shfl_xor(v, 32); acc[b] = v; }
          if (kq == 0) {
#pragma unroll
              for (int b = 0; b < 8; ++b) mod[((size_t)l * 8 + b) * 3072 + n0 + col] = acc[b] + adab[(size_t)l * 3072 + n0 + col]; }
      }
    }
}

__device__ __forceinline__ void p_norm_mod(Frame& F, const float* hin, const float* g, const float* mod_l, bf16* U) {
    const int gw = F.vcu * NWAVES + F.wave, NGW = F.G * NWAVES;
    for (int r0 = gw * 16; r0 < MTOK; r0 += NGW * 16) {
        const int b = r0 >> 12;
        f32x4 A[4], Bv[4];
#pragma unroll
        for (int j = 0; j < 4; ++j) { const int c = 4 * F.lane + 256 * j; const f32x4 gg = *(const f32x4*)(g + c), sc = *(const f32x4*)(mod_l + (size_t)b * 3072 + 1024 + c);
            A[j] = gg * (sc + 1.0f); Bv[j] = *(const f32x4*)(mod_l + (size_t)b * 3072 + c); }
        for (int rr = 0; rr < 16; ++rr) {
            const int row = r0 + rr; const GAS f32x4* xr = (const GAS f32x4*)(hin + (size_t)row * DM) + F.lane;
            f32x4 v[4]; float s = 0.f;
#pragma unroll
            for (int j = 0; j < 4; ++j) { v[j] = xr[64 * j]; s += (v[j].x * v[j].x + v[j].y * v[j].y) + (v[j].z * v[j].z + v[j].w * v[j].w); }
            const float rstd = 1.0f / sqrtf(wave_sum(s) * (1.f / DM) + NORM_EPS);
            GAS u32x2* o8 = (GAS u32x2*)(U + (size_t)row * DM) + F.lane;
#pragma unroll
            for (int j = 0; j < 4; ++j) { const f32x4 y = (v[j] * rstd) * A[j] + Bv[j]; o8[64 * j] = (u32x2){cvtpk(y.x, y.y), cvtpk(y.z, y.w)}; }
        }
    }
}
__device__ __forceinline__ void p_final_norm(Frame& F, const float* hin, const float* g, float* out) {
    const int gw = F.vcu * NWAVES + F.wave, NGW = F.G * NWAVES;
    f32x4 A[4];
#pragma unroll
    for (int j = 0; j < 4; ++j) A[j] = *(const f32x4*)(g + 4 * F.lane + 256 * j);
    for (int row = gw; row < MTOK; row += NGW) {
        const GAS f32x4* xr = (const GAS f32x4*)(hin + (size_t)row * DM) + F.lane;
        f32x4 v[4]; float s = 0.f;
#pragma unroll
        for (int j = 0; j < 4; ++j) { v[j] = xr[64 * j]; s += (v[j].x * v[j].x + v[j].y * v[j].y) + (v[j].z * v[j].z + v[j].w * v[j].w); }
        const float rstd = 1.0f / sqrtf(wave_sum(s) * (1.f / DM) + NORM_EPS);
        GAS f32x4* o = (GAS f32x4*)(out + (size_t)row * DM) + F.lane;
#pragma unroll
        for (int j = 0; j < 4; ++j) o[64 * j] = (v[j] * rstd) * A[j];
    }
}

__device__ __forceinline__ void attnA_tile(const bf16* Qp, bf16* Op, const bf16* Kp, const bf16* Vp, float* lsep, int lse_stride, int rstride, int i0, LAS unsigned char* vst, int lane) {
    const int q32 = lane & 31, hi = lane >> 5;
    bf16x8 qf[4];
    { const bf16* qrow = Qp + (size_t)(i0 + q32) * rstride + 8 * hi;
#pragma unroll
      for (int ks = 0; ks < 4; ++ks) qf[ks] = *(const bf16x8*)(qrow + 16 * ks); }
    f32x16 o0 = {}, o1 = {};
    float m_run = -INFINITY, l_run = 0.f;
    const int kt0 = (i0 >= 128) ? 0 : (128 - i0) / 32;
    bf16x8 kf[4]; v4u vr[4];
    const int vc = lane & 7, vrow = lane >> 3;
#define ATT_LOADKV(kb_) do { const bf16* kr_ = Kp + (size_t)((kb_) + q32) * rstride + 8 * hi; \
        _Pragma("unroll") for (int ks = 0; ks < 4; ++ks) kf[ks] = *(const bf16x8*)(kr_ + 16 * ks); \
        _Pragma("unroll") for (int i = 0; i < 4; ++i) vr[i] = *(const v4u*)(Vp + (size_t)((kb_) + vrow + 8 * i) * rstride + 8 * vc); } while (0)
    ATT_LOADKV(i0 - 128 + 32 * kt0);
    const int q4 = (lane & 15) >> 2, blk = (lane >> 4) & 1, p4 = lane & 3;
    for (int kt = kt0; kt < 5; ++kt) {
#pragma unroll
        for (int i = 0; i < 4; ++i) *(LAS v4u*)(vst + vimg(vrow + 8 * i, vc)) = vr[i];
        bf16x8 kc[4];
#pragma unroll
        for (int ks = 0; ks < 4; ++ks) kc[ks] = kf[ks];
        if (kt + 1 < 5) ATT_LOADKV(i0 - 128 + 32 * (kt + 1));
        f32x16 p = {};
#pragma unroll
        for (int ks = 0; ks < 4; ++ks) p = MFMA32(kc[ks], qf[ks], p);
        if (kt == 0) {
#pragma unroll
            for (int r = 0; r < 16; ++r) if (crow(r, hi) < q32) p[r] = -INFINITY;
        }
        if (kt == 4) {
#pragma unroll
            for (int r = 0; r < 16; ++r) if (crow(r, hi) > q32) p[r] = -INFINITY;
        }
        float mt = p[0];
#pragma unroll
        for (int r = 1; r < 16; ++r) mt = fmaxf(mt, p[r]);
        mt = swap_max(mt);
        const float m_new = fmaxf(m_run, mt);
        const float alpha = __builtin_amdgcn_exp2f(m_run - m_new);
        float s = 0.f;
#pragma unroll
        for (int r = 0; r < 16; ++r) { p[r] = __builtin_amdgcn_exp2f(p[r] - m_new); s += p[r]; }
        l_run = l_run * alpha + s; m_run = m_new;
#pragma unroll
        for (int r = 0; r < 16; ++r) { o0[r] *= alpha; o1[r] *= alpha; }
        bf16x8 pf[2];
#pragma unroll
        for (int ks = 0; ks < 2; ++ks) { v4u w; w.x = cvtpk(p[8 * ks + 0], p[8 * ks + 1]); w.y = cvtpk(p[8 * ks + 2], p[8 * ks + 3]); w.z = cvtpk(p[8 * ks + 4], p[8 * ks + 5]); w.w = cvtpk(p[8 * ks + 6], p[8 * ks + 7]); pf[ks] = __builtin_bit_cast(bf16x8, w); }
        LDS_WAIT(); asm volatile("" ::: "memory");
#pragma unroll
        for (int ks = 0; ks < 2; ++ks)
#pragma unroll
            for (int d0 = 0; d0 < 2; ++d0) {
                const s16x4 lo = vtr(vst + vimg(16 * ks + 4 * hi + q4, 4 * d0 + 2 * blk + (p4 >> 1)) + 8 * (p4 & 1));
                const s16x4 up = vtr(vst + vimg(16 * ks + 8 + 4 * hi + q4, 4 * d0 + 2 * blk + (p4 >> 1)) + 8 * (p4 & 1));
                const bf16x8 vf = (bf16x8){lo[0], lo[1], lo[2], lo[3], up[0], up[1], up[2], up[3]};
                if (d0 == 0) o0 = MFMA32(vf, pf[ks], o0); else o1 = MFMA32(vf, pf[ks], o1);
            }
        LDS_WAIT(); asm volatile("" ::: "memory");
    }
#undef ATT_LOADKV
    const float l_tot = swap_sum(l_run), inv = 1.0f / l_tot;
    bf16* orow = Op + (size_t)(i0 + q32) * rstride;
#pragma unroll
    for (int g4 = 0; g4 < 4; ++g4) {
        *(u32x2*)(orow + 8 * g4 + 4 * hi) = (u32x2){cvtpk(o0[4 * g4] * inv, o0[4 * g4 + 1] * inv), cvtpk(o0[4 * g4 + 2] * inv, o0[4 * g4 + 3] * inv)};
        *(u32x2*)(orow + 32 + 8 * g4 + 4 * hi) = (u32x2){cvtpk(o1[4 * g4] * inv, o1[4 * g4 + 1] * inv), cvtpk(o1[4 * g4 + 2] * inv, o1[4 * g4 + 3] * inv)};
    }
    if (hi == 0) lsep[(size_t)(i0 + q32) * lse_stride] = m_run + __builtin_amdgcn_logf(l_tot);
}
__device__ __forceinline__ void p_attnA(Frame& F, bf16* act, float* lse, bf16* dump) {
    LAS unsigned char* vst = F.lds + F.wave * 4096;
    constexpr int NBL = MC / SEQ, NUNITS = NBL * 3 * 16 * 16;
    for (int u = F.bx; u < NUNITS; u += F.G) {
        const int cb = u & 15, h = (u >> 4) & 15, g = (u >> 8) % 3, bl = u / 768;
        const int dl = (g == 0) ? 1 : (g == 1 ? 4 : 16), nbk = 16 / dl;
        const int r = cb / nbk, bk = cb % nbk;
        const size_t row_base = (size_t)bl * SEQ + r;
        bf16* Qp = act + (size_t)(3 * g + 0) * (A_SUB / 2) + row_base * 1024 + h * 64;
        const bf16* Kp = act + (size_t)(3 * g + 1) * (A_SUB / 2) + row_base * 1024 + h * 64;
        const bf16* Vp = act + (size_t)(3 * g + 2) * (A_SUB / 2) + row_base * 1024 + h * 64;
        float* lsep = lse + ((size_t)g * MC + row_base) * 16 + h;
        bf16* Op = dump ? dump + row_base * 1024 + h * 64 : Qp;
        attnA_tile(Qp, Op, Kp, Vp, lsep, 16 * dl, dl * 1024, bk * 256 + 32 * F.wave, vst, F.lane);
    }
}
__device__ __forceinline__ void p_mergeA(Frame& F, const bf16* act, const float* lse, bf16* Z  ) {
    const int gw = F.vcu * NWAVES + F.wave, NGW = F.G * NWAVES;
    const int head = F.lane >> 2;
    for (int row = gw; row < MC; row += NGW) {
        float l0 = lse[((size_t)0 * MC + row) * 16 + head], l1 = lse[((size_t)1 * MC + row) * 16 + head], l2 = lse[((size_t)2 * MC + row) * 16 + head];
        const float mx = fmaxf(l0, fmaxf(l1, l2));
        float e0 = __builtin_amdgcn_exp2f(l0 - mx), e1 = __builtin_amdgcn_exp2f(l1 - mx), e2 = __builtin_amdgcn_exp2f(l2 - mx);
        const float inv = 1.0f / (e0 + e1 + e2); e0 *= inv; e1 *= inv; e2 *= inv;
#pragma unroll
        for (int hf = 0; hf < 2; ++hf) {
            const size_t off = (size_t)row * 1024 + 16 * F.lane + 8 * hf;
            const v4u a0 = *(const v4u*)(act + (size_t)0 * (A_SUB / 2) + off), a1 = *(const v4u*)(act + (size_t)3 * (A_SUB / 2) + off), a2 = *(const v4u*)(act + (size_t)6 * (A_SUB / 2) + off),
                      gg = *(const v4u*)(act + (size_t)9 * (A_SUB / 2) + off);
            v4u o;
#pragma unroll
            for (int k = 0; k < 4; ++k) {
                const float ylo = (e0 * bf_lo(a0[k]) + e1 * bf_lo(a1[k]) + e2 * bf_lo(a2[k])) * bf_lo(gg[k]);
                const float yhi = (e0 * bf_hi(a0[k]) + e1 * bf_hi(a1[k]) + e2 * bf_hi(a2[k])) * bf_hi(gg[k]);
                o[k] = cvtpk(ylo, yhi);
            }
            *(v4u*)(Z + off) = o;
        }
    }
}

__device__ __forceinline__ unsigned ordkey(float f) { unsigned u = __float_as_uint(f); if ((u << 1) == 0u) u = 0u; return (u & 0x80000000u) ? ~u : (u | 0x80000000u); }
__device__ __forceinline__ void index_tile(Frame& F, int b, int t0, const bf16* QI, const bf16* KI, const float* WI, unsigned long long* maskw) {
    LAS float* sc = (LAS float*)F.lds;
    LAS unsigned* hist = (LAS unsigned*)(F.lds + SEL_HIST_OFF) + F.wave * 512;
    LAS unsigned* cand = (LAS unsigned*)(F.lds + SEL_CAND_OFF);
    LAS unsigned long long* stage = (LAS unsigned long long*)(F.lds + SEL_STAGE_OFF);
    const int lane = F.lane, c32 = lane & 31, hi = lane >> 5;
    const size_t tok0 = (size_t)b * SEQ + t0;
#ifndef IDX_REP_SCORE
#define IDX_REP_SCORE 1
#endif
#ifndef IDX_REP_SEL
#define IDX_REP_SEL 1
#endif
    for (int rep_ = 0; rep_ < IDX_REP_SCORE; ++rep_) {
        bf16x8 qf[2][4]; f32x4 wv[2][2][2];
        const int tl = 2 * ((c32 >> 2) & 1) + (c32 >> 4), hd = ((c32 >> 3) & 1) * 4 + (c32 & 3);
#pragma unroll
        for (int R = 0; R < 2; ++R) {
            const bf16* qp = QI + (tok0 + 4 * R + tl) * 512 + hd * 64 + 8 * hi;
#pragma unroll
            for (int ks = 0; ks < 4; ++ks) qf[R][ks] = *(const bf16x8*)(qp + 16 * ks);
#pragma unroll
            for (int tt = 0; tt < 2; ++tt) { const float* wp = WI + (tok0 + 4 * R + 2 * hi + tt) * 8; wv[R][tt][0] = *(const f32x4*)wp; wv[R][tt][1] = *(const f32x4*)(wp + 4); }
        }
        const int nkt = (t0 + 8 + 31) >> 5;
        bf16x8 kf[4];
        const bf16* kbase = KI + ((size_t)b * SEQ + c32) * 64 + 8 * hi;
        int kt = F.wave;
        if (kt < nkt) {
#pragma unroll
            for (int ks = 0; ks < 4; ++ks) kf[ks] = *(const bf16x8*)(kbase + (size_t)kt * 32 * 64 + 16 * ks);
        }
        for (; kt < nkt; kt += NWAVES) {
            bf16x8 kc[4];
#pragma unroll
            for (int ks = 0; ks < 4; ++ks) kc[ks] = kf[ks];
            if (kt + NWAVES < nkt) {
#pragma unroll
                for (int ks = 0; ks < 4; ++ks) kf[ks] = *(const bf16x8*)(kbase + (size_t)(kt + NWAVES) * 32 * 64 + 16 * ks);
            }
#pragma unroll
            for (int R = 0; R < 2; ++R) {
                f32x16 acc = {};
#pragma unroll
                for (int ks = 0; ks < 4; ++ks) acc = MFMA32(qf[R][ks], kc[ks], acc);
#pragma unroll
                for (int tt = 0; tt < 2; ++tt) {
                    float s = 0.f;
#pragma unroll
                    for (int i = 0; i < 8; ++i) s += wv[R][tt][i >> 2][i & 3] * fmaxf(acc[8 * tt + i], 0.f);
                    sc[(4 * R + 2 * hi + tt) * 4096 + kt * 32 + c32] = s;
                }
            }
        }
    }
    __syncthreads();
    for (int rep_ = 0; rep_ < IDX_REP_SEL; ++rep_) {
        const int t = t0 + F.wave, n = t + 1;
        const LAS float* scq = sc + F.wave * 4096;
        unsigned long long myword = 0ull;
        bool done = false;
        if (n <= 256) {
            const int j = lane; const int rem = n - 64 * j;
            myword = rem >= 64 ? ~0ull : (rem > 0 ? ((1ull << rem) - 1ull) : 0ull);
            done = true;
        } else {
            float lo = INFINITY, hi = -INFINITY;
            for (int i = 0; i * 256 < n; ++i) { const int idx = 4 * (lane + 64 * i); const f32x4 v = *(const LAS f32x4*)(scq + idx);
#pragma unroll
                for (int e = 0; e < 4; ++e) if (idx + e < n) { lo = fminf(lo, v[e]); hi = fmaxf(hi, v[e]); } }
#pragma unroll
            for (int o = 1; o < 64; o <<= 1) { lo = fminf(lo, __shfl_xor(lo, o)); hi = fmaxf(hi, __shfl_xor(hi, o)); }
            if (hi > lo) {
                const float scale = 512.0f / (hi - lo);
                *(LAS v4u*)(hist + 8 * lane) = (v4u){0u, 0u, 0u, 0u}; *(LAS v4u*)(hist + 8 * lane + 4) = (v4u){0u, 0u, 0u, 0u};
                LDS_WAIT(); asm volatile("" ::: "memory");
                for (int i = 0; i * 256 < n; ++i) { const int idx = 4 * (lane + 64 * i); const f32x4 v = *(const LAS f32x4*)(scq + idx);
#pragma unroll
                    for (int e = 0; e < 4; ++e) if (idx + e < n) { const int bn = min(511, (int)((v[e] - lo) * scale));
                        __hip_atomic_fetch_add(hist + bn, 1u, __ATOMIC_RELAXED, __HIP_MEMORY_SCOPE_WORKGROUP); } }
                LDS_WAIT(); asm volatile("" ::: "memory");
                const v4u c0 = *(const LAS v4u*)(hist + 8 * lane), c1 = *(const LAS v4u*)(hist + 8 * lane + 4);
                unsigned cc[8] = {c0.x, c0.y, c0.z, c0.w, c1.x, c1.y, c1.z, c1.w};
                const unsigned ls = ((c0.x + c0.y) + (c0.z + c0.w)) + ((c1.x + c1.y) + (c1.z + c1.w));
                unsigned inc = ls;
#pragma unroll
                for (int o = 1; o < 64; o <<= 1) { const unsigned v = __shfl_up(inc, o); if (lane >= o) inc += v; }
                const unsigned total = __shfl(inc, 63);
                const unsigned S = total - inc;
                const bool found = (S < 256u) && (256u <= S + ls);
                unsigned acc = S; int bin = 0; unsigned above = S; bool got = false;
#pragma unroll
                for (int q = 7; q >= 0; --q) { if (!got) { if (acc + cc[q] >= 256u) { bin = q; above = acc; got = true; } else acc += cc[q]; } }
                const unsigned long long fm = __ballot(found);
                const int src = fm ? (__ffsll((long long)fm) - 1) : 0;
                const int B = __shfl(8 * lane + bin, src); const unsigned aboveb = __shfl(above, src);
                const unsigned mB = __shfl(cc[0] * 0u + ((bin == 0) ? cc[0] : (bin == 1) ? cc[1] : (bin == 2) ? cc[2] : (bin == 3) ? cc[3] : (bin == 4) ? cc[4] : (bin == 5) ? cc[5] : (bin == 6) ? cc[6] : cc[7]), src);
                const unsigned kk2 = 256u - aboveb;
                if (mB <= 64u) {
                    LAS unsigned* ckey = cand + F.wave * 128; LAS unsigned* cidx = ckey + 64;
                    unsigned base = 0u;
                    for (int j = 0; 64 * j < n; ++j) {
                        const int sidx = 64 * j + lane; const bool v = sidx < n; const float x = scq[sidx];
                        const int bn = min(511, (int)((x - lo) * scale));
                        const bool gt = v && bn > B, eq = v && bn == B;
                        const unsigned long long wj = __ballot(gt), em = __ballot(eq);
                        if (eq) { const unsigned pos = base + (unsigned)__popcll(em & ((1ull << lane) - 1ull)); ckey[pos] = ordkey(x); cidx[pos] = (unsigned)sidx; }
                        base += (unsigned)__popcll(em);
                        if (lane == j) myword = wj;
                    }
                    stage[F.wave * 64 + lane] = myword;
                    LDS_WAIT(); asm volatile("" ::: "memory");
                    const unsigned m = base;
                    const unsigned mykey = (unsigned)lane < m ? ckey[lane] : 0u, myidx = (unsigned)lane < m ? cidx[lane] : 0u;
                    unsigned rank = 0u;
                    for (unsigned f = 0; f < m; ++f) { const unsigned kf = ckey[f]; rank += (kf > mykey || (kf == mykey && f < (unsigned)lane)) ? 1u : 0u; }
                    if ((unsigned)lane < m && rank < kk2)
                        __hip_atomic_fetch_or((LAS unsigned*)stage + F.wave * 128 + (myidx >> 5), 1u << (myidx & 31u), __ATOMIC_RELAXED, __HIP_MEMORY_SCOPE_WORKGROUP);
                    done = true;
                }
            }
        }
        if (!done) {
            unsigned T = 0u; int kk = 256; unsigned prefix = 0u;
#pragma unroll
            for (int pass = 0; pass < 4; ++pass) {
                const int shift = 24 - 8 * pass;
                *(LAS v4u*)(hist + 4 * lane) = (v4u){0u, 0u, 0u, 0u};
                LDS_WAIT(); asm volatile("" ::: "memory");
                for (int s2 = lane; s2 < n; s2 += 64) {
                    const unsigned key = ordkey(scq[s2]);
                    const bool in = (pass == 0) ? true : ((key >> ((shift + 8) & 31)) == prefix);
                    if (in) __hip_atomic_fetch_add(hist + ((key >> shift) & 255u), 1u, __ATOMIC_RELAXED, __HIP_MEMORY_SCOPE_WORKGROUP);
                }
                LDS_WAIT(); asm volatile("" ::: "memory");
                const v4u c = *(const LAS v4u*)(hist + 4 * lane);
                const unsigned ls = c.x + c.y + c.z + c.w;
                unsigned inc = ls;
#pragma unroll
                for (int o = 1; o < 64; o <<= 1) { const unsigned v = __shfl_up(inc, o); if (lane >= o) inc += v; }
                const unsigned total = __shfl(inc, 63);
                const unsigned S = total - inc;
                const bool found = (S < (unsigned)kk) && ((unsigned)kk <= S + ls);
                unsigned acc = S; int bin; unsigned above;
                if (acc + c.w >= (unsigned)kk) { bin = 3; above = acc; }
                else { acc += c.w; if (acc + c.z >= (unsigned)kk) { bin = 2; above = acc; }
                else { acc += c.z; if (acc + c.y >= (unsigned)kk) { bin = 1; above = acc; }
                else { acc += c.y; bin = 0; above = acc; } } }
                const unsigned long long fm = __ballot(found);
                const int src = fm ? (__ffsll((long long)fm) - 1) : 0;
                const int binb = __shfl(4 * lane + bin, src); const unsigned aboveb = __shfl(above, src);
                prefix = (prefix << 8) | (unsigned)binb; kk -= (int)aboveb;
            }
            T = prefix;
            unsigned taken = 0u; myword = 0ull;
            for (int j = 0; 64 * j < n; ++j) {
                const int s2 = 64 * j + lane; const bool v = s2 < n;
                const unsigned key = v ? ordkey(scq[s2]) : 0u;
                const bool gt = v && key > T, eq = v && key == T;
                const unsigned long long em = __ballot(eq);
                const unsigned rank = taken + (unsigned)__popcll(em & ((1ull << lane) - 1ull));
                const bool sel = gt || (eq && rank < (unsigned)kk);
                taken += (unsigned)__popcll(em);
                const unsigned long long w = __ballot(sel);
                if (lane == j) myword = w;
            }
            stage[F.wave * 64 + lane] = myword;
        } else if (n <= 256) stage[F.wave * 64 + lane] = myword;
    }
    __syncthreads();
    { const int j = F.tid >> 3, tq = F.tid & 7; maskw[((size_t)b * 64 + j) * 4096 + t0 + tq] = stage[tq * 64 + j]; }
}
__device__ __forceinline__ void p_index(Frame& F, const bf16* QI, const bf16* KI, const float* WI, unsigned long long* maskw) {
    for (int L = F.vcu; L < 4096; L += F.G) {
        const int i = L >> 8, v = L & 255, b = i >> 1, tt = (i & 1) ? 511 - v : v;
        index_tile(F, b, tt * 8, QI, KI, WI, maskw);
    }
}

__device__ __forceinline__ float mask_sel(float p, unsigned bits, int c) {
    const unsigned m = (unsigned)__builtin_amdgcn_sbfe((int)bits, (unsigned)c, 1u);
    return __uint_as_float((m & __float_as_uint(p)) | (~m & 0xff800000u));
}
__device__ __forceinline__ void attnB_unit(Frame& F, int b, int kvh, int blkq, const bf16* Q, const bf16* K, const bf16* V, const bf16* G, const unsigned long long* maskw, bf16* Z) {
    const int lane = F.lane, q32 = lane & 31, hi = lane >> 5, w = F.wave;
    const int head = 4 * kvh + (w >> 1), tok = blkq * 64 + 32 * (w & 1) + q32;
    const size_t grow = (size_t)b * SEQ + tok;
    const int NT = blkq + 1;
    bf16x8 qf[4];
    { const bf16* qrow = Q + grow * 1024 + head * 64 + 8 * hi;
#pragma unroll
      for (int ks = 0; ks < 4; ++ks) qf[ks] = *(const bf16x8*)(qrow + 16 * ks); }
    LAS unsigned char* Kb = F.lds; LAS unsigned char* Vb = F.lds + 16384;
    const int srow = F.tid >> 3, sch = F.tid & 7;
    const bf16* ksrc = K + ((size_t)b * SEQ + srow) * 256 + kvh * 64 + 8 * sch;
    const bf16* vsrc = V + ((size_t)b * SEQ + srow) * 256 + kvh * 64 + 8 * sch;
    const unsigned long long* mp = maskw + (size_t)b * 64 * 4096 + tok;
    v4u kreg = *(const v4u*)ksrc, vreg = *(const v4u*)vsrc;
    unsigned long long mw_next = mp[0];
    *(LAS v4u*)(Kb + kimg(srow, sch)) = kreg; *(LAS v4u*)(Vb + vimg(srow, sch)) = vreg;
    __syncthreads();
    f32x16 o0 = {}, o1 = {}, ol = {}, negm = {};
    const short one = (q32 == 0) ? (short)0x3F80 : (short)0;
    const bf16x8 ones = (bf16x8){one, one, one, one, one, one, one, one};
    const int q4 = (lane & 15) >> 2, blk = (lane >> 4) & 1, p4 = lane & 3;
    const unsigned koff0 = kimg(q32, hi), voff0 = vimg(4 * hi + q4, 2 * blk + (p4 >> 1)) + 8 * (p4 & 1);
    for (int j = 0; j < NT; ++j) {
        const unsigned long long mw = mw_next;
        if (j + 1 < NT) { kreg = *(const v4u*)(ksrc + (size_t)(j + 1) * 64 * 256); vreg = *(const v4u*)(vsrc + (size_t)(j + 1) * 64 * 256); mw_next = mp[(size_t)(j + 1) * 4096]; }
        const LAS unsigned char* Kc = Kb + (j & 1) * 8192; const LAS unsigned char* Vc = Vb + (j & 1) * 8192;
        f32x16 p0 = negm, p1 = negm;
#pragma unroll
        for (int ks = 0; ks < 4; ++ks) {
            const bf16x8 ka = *(const LAS bf16x8*)(Kc + kimg(q32, 2 * ks + hi)), kb2 = *(const LAS bf16x8*)(Kc + kimg(32 + q32, 2 * ks + hi));
            p0 = MFMA32(ka, qf[ks], p0); p1 = MFMA32(kb2, qf[ks], p1);
        }
        const unsigned b0 = (unsigned)mw >> (4 * hi), b1 = (unsigned)(mw >> 32) >> (4 * hi);
#pragma unroll
        for (int r = 0; r < 16; ++r) { p0[r] = mask_sel(p0[r], b0, (r & 3) + 8 * (r >> 2)); p1[r] = mask_sel(p1[r], b1, (r & 3) + 8 * (r >> 2)); }
        float rm = fmaxf(p0[0], p1[0]);
#pragma unroll
        for (int r = 1; r < 16; ++r) rm = fmaxf(fmaxf(rm, p0[r]), p1[r]);
        rm = swap_max(rm);
        if (j == 0 || __any(rm > 8.0f)) {
            const float delta = (j == 0) ? ((rm > -INFINITY) ? rm : 0.f) : fmaxf(rm, 0.f);
#pragma unroll
            for (int r = 0; r < 16; ++r) { p0[r] -= delta; p1[r] -= delta; negm[r] -= delta; }
            if (j != 0) { const float alpha = __builtin_amdgcn_exp2f(-delta);
#pragma unroll
                for (int r = 0; r < 16; ++r) { o0[r] *= alpha; o1[r] *= alpha; ol[r] *= alpha; } }
        }
#pragma unroll
        for (int r = 0; r < 16; ++r) { p0[r] = __builtin_amdgcn_exp2f(p0[r]); p1[r] = __builtin_amdgcn_exp2f(p1[r]); }
        bf16x8 pf[4];
#pragma unroll
        for (int ks = 0; ks < 2; ++ks) {
            v4u wa, wb;
            wa.x = cvtpk(p0[8 * ks + 0], p0[8 * ks + 1]); wa.y = cvtpk(p0[8 * ks + 2], p0[8 * ks + 3]); wa.z = cvtpk(p0[8 * ks + 4], p0[8 * ks + 5]); wa.w = cvtpk(p0[8 * ks + 6], p0[8 * ks + 7]);
            wb.x = cvtpk(p1[8 * ks + 0], p1[8 * ks + 1]); wb.y = cvtpk(p1[8 * ks + 2], p1[8 * ks + 3]); wb.z = cvtpk(p1[8 * ks + 4], p1[8 * ks + 5]); wb.w = cvtpk(p1[8 * ks + 6], p1[8 * ks + 7]);
            pf[ks] = __builtin_bit_cast(bf16x8, wa); pf[2 + ks] = __builtin_bit_cast(bf16x8, wb);
        }
#pragma unroll
        for (int kq = 0; kq < 4; ++kq) {
#pragma unroll
            for (int d0 = 0; d0 < 2; ++d0) {
                const s16x4 lo = vtr(Vc + vimg(16 * kq + 4 * hi + q4, 4 * d0 + 2 * blk + (p4 >> 1)) + 8 * (p4 & 1));
                const s16x4 up = vtr(Vc + vimg(16 * kq + 8 + 4 * hi + q4, 4 * d0 + 2 * blk + (p4 >> 1)) + 8 * (p4 & 1));
                const bf16x8 vf = (bf16x8){lo[0], lo[1], lo[2], lo[3], up[0], up[1], up[2], up[3]};
                if (d0 == 0) o0 = MFMA32(vf, pf[kq], o0); else o1 = MFMA32(vf, pf[kq], o1);
            }
            ol = MFMA32(ones, pf[kq], ol);
        }
        if (j + 1 < NT) { *(LAS v4u*)(Kb + ((j + 1) & 1) * 8192 + kimg(srow, sch)) = kreg; *(LAS v4u*)(Vb + ((j + 1) & 1) * 8192 + vimg(srow, sch)) = vreg; }
        __syncthreads();
    }
    (void)koff0; (void)voff0;
    const float l_tot = swap_sum(ol[0]), inv = 1.0f / l_tot;
    const bf16* grow_p = G + grow * 1024 + head * 64;
    bf16* zrow = Z + grow * 1024 + head * 64;
#pragma unroll
    for (int g4 = 0; g4 < 4; ++g4) {
        const u32x2 ga = *(const u32x2*)(grow_p + 8 * g4 + 4 * hi), gb = *(const u32x2*)(grow_p + 32 + 8 * g4 + 4 * hi);
        *(u32x2*)(zrow + 8 * g4 + 4 * hi) = (u32x2){cvtpk(o0[4 * g4] * inv * bf_lo(ga.x), o0[4 * g4 + 1] * inv * bf_hi(ga.x)), cvtpk(o0[4 * g4 + 2] * inv * bf_lo(ga.y), o0[4 * g4 + 3] * inv * bf_hi(ga.y))};
        *(u32x2*)(zrow + 32 + 8 * g4 + 4 * hi) = (u32x2){cvtpk(o1[4 * g4] * inv * bf_lo(gb.x), o1[4 * g4 + 1] * inv * bf_hi(gb.x)), cvtpk(o1[4 * g4 + 2] * inv * bf_lo(gb.y), o1[4 * g4 + 3] * inv * bf_hi(gb.y))};
    }
}
__device__ __forceinline__ void p_attnB(Frame& F, const bf16* Q, const bf16* K, const bf16* V, const bf16* G, const unsigned long long* maskw, bf16* Z) {
    for (int L = F.vcu; L < 2048; L += F.G) {
        const int i = L >> 8, v = L & 255, bh = v >> 3, s = v & 7;
        const int blkq = 16 * (i >> 1) + ((i & 1) ? 15 - s : s);
        attnB_unit(F, bh >> 2, bh & 3, blkq, Q, K, V, G, maskw, Z);
    }
}

__device__ __forceinline__ cargs_t fresh_args() { cargs_t p = (cargs_t)__builtin_amdgcn_kernarg_segment_ptr(); asm volatile("" : "+s"(p)); return p; }
__global__ void __launch_bounds__(NWAVES * 64, 2) trunk_fwd(Args args_unused) {
    extern __shared__ __attribute__((aligned(16))) unsigned char lds[];
    Frame F;
    F.lds = (LAS unsigned char*)lds;
    F.MISC = (volatile LAS unsigned*)(F.lds + MISC_OFF);
    F.tid = threadIdx.x; F.lane = F.tid & 63; F.wave = __builtin_amdgcn_readfirstlane(F.tid >> 6);
    F.G = gridDim.x; F.bx = blockIdx.x; { const int bx = blockIdx.x; F.vcu = (F.G % 8 == 0) ? (bx % 8) * (F.G / 8) + bx / 8 : bx; }
    F.ctl = (gu32*)(fresh_args()->ws + WS_CTL);
    if (F.tid < 64) ((LAS unsigned*)(F.lds + MISC_OFF))[F.tid] = 0u;
    __syncthreads();
#if MK_ONE_LAUNCH
    XcdBarrier bar = xcd_barrier_post((unsigned*)(F.ctl + CW_BAR), F.MISC + 8);
#define SEAM() do { XcdBarrier b_ = bar; asm volatile("" : "+s"(b_.bar), "+s"(b_.x)); xcd_barrier(b_); } while (0)
#define RUN 1
#else
    int seam = 0; const int seg = fresh_args()->seg;
#define SEAM() (++seam)
#define RUN (seam == seg)
#endif
#define WSP(off) (A_->ws + (off))
#define FRESH_F() Frame Fp = F; { int t_ = threadIdx.x; asm volatile("" : "+v"(t_)); Fp.tid = t_; Fp.lane = t_ & 63; Fp.wave = __builtin_amdgcn_readfirstlane(t_ >> 6); asm volatile("" : "+s"(Fp.vcu), "+s"(Fp.G), "+s"(Fp.bx)); }
    if (DUP(0)) { { cargs_t A_ = fresh_args(); FRESH_F(); p_prologue(Fp, A_); } SEAM(); }
    if (P_ON(0) && RUN) { cargs_t A_ = fresh_args(); FRESH_F(); p_prologue(Fp, A_); }
    SEAM();
    for (int lp = 0; lp < 2; ++lp) {
        {
            const int layer = 2 * lp;
            for (int rep_ = 0; rep_ < 1 + DUP(1); ++rep_) { if (rep_) SEAM();
            if (P_ON(1) && RUN) { cargs_t A_ = fresh_args(); FRESH_F(); const float* hin = (layer == 0) ? A_->in[0] : A_->out;
                p_norm_mod(Fp, hin, A_->in[3] + (size_t)layer * 1024, (const float*)WSP(WS_MOD) + (size_t)layer * 8 * 3072, (bf16*)WSP(WS_U)); } }
            SEAM();
            for (int ch = 0; ch < NCHUNK; ++ch) {
                for (int rep_ = 0; rep_ < 1 + DUP(2); ++rep_) { if (rep_) SEAM();
                if (P_ON(2) && RUN) { cargs_t A_ = fresh_args();
                    pg8::Gemm g{(bf16*)WSP(WS_U) + (size_t)ch * MC * 1024, (bf16*)WSP(WS_WA) + (size_t)lp * A_N * 1024, MC, A_N, 1024};
                    pg8::StaticOrder S; { int g_ = F.G, b_ = F.bx; asm volatile("" : "+s"(g_), "+s"(b_)); S.init(MC, A_N, g_, b_); }
                    pg8::EpiA E{A_->ws, ch * MC};
                    pg8::gemm_phase<pg8::EpiA, pg8::StaticOrder, true, true>(F.lds, g, S, E);
                } }
                SEAM();
                if (DUP(3)) { { cargs_t A_ = fresh_args(); FRESH_F(); p_attnA(Fp, (bf16*)WSP(WS_ACT), (float*)WSP(WS_LSE), (bf16*)WSP(WS_END_A)); } SEAM(); }
                if (P_ON(3) && RUN) { cargs_t A_ = fresh_args(); FRESH_F(); p_attnA(Fp, (bf16*)WSP(WS_ACT), (float*)WSP(WS_LSE), nullptr); }
                SEAM();
                if (DUP(4)) { { cargs_t A_ = fresh_args(); FRESH_F(); p_mergeA(Fp, (const bf16*)WSP(WS_ACT), (const float*)WSP(WS_LSE), (bf16*)WSP(WS_U) + (size_t)ch * MC * 1024); } SEAM(); }
                if (P_ON(4) && RUN) { cargs_t A_ = fresh_args(); FRESH_F(); p_mergeA(Fp, (const bf16*)WSP(WS_ACT), (const float*)WSP(WS_LSE), (bf16*)WSP(WS_U) + (size_t)ch * MC * 1024); }
                SEAM();
            }
            for (int rep_ = 0; rep_ < 1 + ((DUP(5) && layer == 0) ? 1 : 0); ++rep_) { if (rep_) SEAM();
            if (P_ON(5) && RUN) { cargs_t A_ = fresh_args(); const float* hin = (layer == 0) ? A_->in[0] : A_->out;
                pg8::Gemm g{(bf16*)WSP(WS_U), (bf16*)WSP(WS_WO) + (size_t)layer * 1024 * 1024, MTOK, 1024, 1024};
                pg8::StaticOrder S; { int g_ = F.G, b_ = F.bx; asm volatile("" : "+s"(g_), "+s"(b_)); S.init(MTOK, 1024, g_, b_); }
                pg8::EpiOut E{hin, A_->out, (const float*)WSP(WS_MOD) + (size_t)layer * 8 * 3072 + 2048};
                pg8::gemm_phase<pg8::EpiOut, pg8::StaticOrder, true, true>(F.lds, g, S, E);
            } }
            SEAM();
        }
        {
            const int layer = 2 * lp + 1;
            if (P_ON(6) && RUN) { cargs_t A_ = fresh_args(); FRESH_F();
                p_norm_mod(Fp, A_->out, A_->in[3] + (size_t)layer * 1024, (const float*)WSP(WS_MOD) + (size_t)layer * 8 * 3072, (bf16*)WSP(WS_U)); }
            SEAM();
            for (int rep_ = 0; rep_ < 1 + DUP(7); ++rep_) { if (rep_) SEAM();
            if (P_ON(7) && RUN) { cargs_t A_ = fresh_args();
                pg8::Gemm g{(bf16*)WSP(WS_U), (bf16*)WSP(WS_WB) + (size_t)lp * B_NP * 1024, MTOK, B_NP, 1024};
                pg8::StaticOrder S; { int g_ = F.G, b_ = F.bx; asm volatile("" : "+s"(g_), "+s"(b_)); S.init(MTOK, B_NP, g_, b_); }
                pg8::EpiB E{A_->ws};
                pg8::gemm_phase<pg8::EpiB, pg8::StaticOrder, true, true>(F.lds, g, S, E);
            } }
            SEAM();
            if (DUP(8)) { { cargs_t A_ = fresh_args(); FRESH_F(); p_index(Fp, (const bf16*)WSP(WS_BQI), (const bf16*)WSP(WS_BKI), (const float*)WSP(WS_BWI), (unsigned long long*)WSP(WS_BMASK)); } SEAM(); }
            if (P_ON(8) && RUN) { cargs_t A_ = fresh_args(); FRESH_F(); p_index(Fp, (const bf16*)WSP(WS_BQI), (const bf16*)WSP(WS_BKI), (const float*)WSP(WS_BWI), (unsigned long long*)WSP(WS_BMASK)); }
            SEAM();
            if (DUP(9)) { { cargs_t A_ = fresh_args(); FRESH_F(); p_attnB(Fp, (const bf16*)WSP(WS_BQ), (const bf16*)WSP(WS_BK), (const bf16*)WSP(WS_BV), (const bf16*)WSP(WS_BG), (const unsigned long long*)WSP(WS_BMASK), (bf16*)WSP(WS_U)); } SEAM(); }
            if (P_ON(9) && RUN) { cargs_t A_ = fresh_args(); FRESH_F(); p_attnB(Fp, (const bf16*)WSP(WS_BQ), (const bf16*)WSP(WS_BK), (const bf16*)WSP(WS_BV), (const bf16*)WSP(WS_BG), (const unsigned long long*)WSP(WS_BMASK), (bf16*)WSP(WS_U)); }
            SEAM();
            if (P_ON(10) && RUN) { cargs_t A_ = fresh_args();
                pg8::Gemm g{(bf16*)WSP(WS_U), (bf16*)WSP(WS_WO) + (size_t)layer * 1024 * 1024, MTOK, 1024, 1024};
                pg8::StaticOrder S; { int g_ = F.G, b_ = F.bx; asm volatile("" : "+s"(g_), "+s"(b_)); S.init(MTOK, 1024, g_, b_); }
                pg8::EpiOut E{A_->out, A_->out, (const float*)WSP(WS_MOD) + (size_t)layer * 8 * 3072 + 2048};
                pg8::gemm_phase<pg8::EpiOut, pg8::StaticOrder, true, true>(F.lds, g, S, E);
            }
            SEAM();
        }
    }
    if (P_ON(11) && RUN) { cargs_t A_ = fresh_args(); FRESH_F(); p_final_norm(Fp, A_->out, A_->in[10], A_->out); }
}

extern "C" void kernel_launch(void* const* d_in, const int* in_sizes, int n_in, void* d_out, int out_size, void* d_ws, size_t ws_size, hipStream_t stream) {
    static int grid = 0;
    if (grid == 0) {
        if (n_in != 11 || in_sizes[0] != MTOK * DM || out_size != MTOK * DM || ws_size < WS_NEED) {
            fprintf(stderr, "kernel_launch: unexpected shapes / workspace (n_in %d, in0 %d, out %d, ws %zu, need %zu); nothing launched\n", n_in, n_in > 0 ? in_sizes[0] : -1, out_size, ws_size, (size_t)WS_NEED); grid = -1; return; }
        int dev = 0, cus = 0, per_cu = 0;
        if (hipGetDevice(&dev) != hipSuccess || hipDeviceGetAttribute(&cus, hipDeviceAttributeMultiprocessorCount, dev) != hipSuccess) { fprintf(stderr, "kernel_launch: device query failed\n"); grid = -1; return; }
        if (hipFuncSetAttribute((const void*)trunk_fwd, hipFuncAttributeMaxDynamicSharedMemorySize, LDS_BYTES) != hipSuccess) { fprintf(stderr, "kernel_launch: hipFuncSetAttribute failed\n"); grid = -1; return; }
        if (hipOccupancyMaxActiveBlocksPerMultiprocessor(&per_cu, (const void*)trunk_fwd, NWAVES * 64, LDS_BYTES) != hipSuccess || per_cu < 1)
            fprintf(stderr, "kernel_launch: note: occupancy query reports %d workgroups per CU\n", per_cu);
        (void)hipGetLastError();
        grid = cus;
    }
    if (grid < 0) return;
    if (hipMemsetAsync((char*)d_ws + WS_CTL, 0, CTL_ZERO_BYTES, stream) != hipSuccess) { fprintf(stderr, "kernel_launch: memset failed\n"); return; }
    Args a{};
    for (int i = 0; i < 11; ++i) a.in[i] = (const float*)d_in[i];
    a.pos = (const int*)d_in[2]; a.out = (float*)d_out; a.ws = (unsigned char*)d_ws; a.seg = 0; a.pad = 0;
#if MK_ONE_LAUNCH
    hipLaunchKernelGGL(trunk_fwd, dim3(grid), dim3(NWAVES * 64), LDS_BYTES, stream, a);
#else
    for (int s = 0; s <= N_SEAMS; ++s) { a.seg = s; hipLaunchKernelGGL(trunk_fwd, dim3(grid), dim3(NWAVES * 64), LDS_BYTES, stream, a); }
#endif
    const hipError_t le = hipPeekAtLastError();
    if (le != hipSuccess) fprintf(stderr, "kernel_launch: launch failed: %s\n", hipGetErrorName(le));
}
```

```cpp
#include <hip/hip_runtime.h>
#include <cstdio>
#include <cstdint>
#include <cmath>
constexpr int NWAVES = 8;
constexpr int NB = 8, SEQ = 4096, DM = 1024, MTOK = NB * SEQ;
constexpr int A_N = 10240, B_NL = 3144, B_NP = 3328;
constexpr int MC = 16384, NCHUNK = MTOK / MC;
constexpr float NORM_EPS = 1e-6f;
#ifndef PMASK
#define PMASK 0xffff
#endif
#define P_ON(k) ((PMASK >> (k)) & 1)
#ifndef DUPMASK
#define DUPMASK 0
#endif
#define DUP(k) ((DUPMASK >> (k)) & 1)
#ifndef MK_ONE_LAUNCH
#define MK_ONE_LAUNCH 1
#endif
constexpr int N_SEAMS = 1 + 2 * ((1 + 3 * NCHUNK + 1) + 5);

constexpr size_t MiB = 1u << 20;
constexpr size_t WS_CTL = 0, CTL_ZERO_BYTES = 1 * MiB;
constexpr size_t WS_MOD = 1 * MiB;
constexpr size_t WS_COS = 2 * MiB, WS_SIN = 6 * MiB;
constexpr size_t WS_WA = 10 * MiB;
constexpr size_t WS_WB = 50 * MiB;
constexpr size_t WS_WO = 63 * MiB;
constexpr size_t WS_U = 72 * MiB;
constexpr size_t WS_ACT = 136 * MiB;
constexpr size_t A_SUB = (size_t)MC * 1024 * 2;
constexpr size_t WS_LSE = WS_ACT + 10 * A_SUB;
constexpr size_t WS_END_A = WS_LSE + (size_t)3 * MC * 16 * 4;
constexpr size_t WS_BQ = WS_ACT, WS_BK = WS_BQ + 64 * MiB, WS_BV = WS_BK + 16 * MiB, WS_BQI = WS_BV + 16 * MiB, WS_BKI = WS_BQI + 32 * MiB,
                 WS_BWI = WS_BKI + 4 * MiB, WS_BG = WS_BWI + 2 * MiB, WS_BMASK = WS_BG + 64 * MiB, WS_END_B = WS_BMASK + 16 * MiB;
constexpr size_t WS_NEED = (WS_END_A > WS_END_B ? WS_END_A : WS_END_B);
static_assert(WS_WA + (size_t)2 * A_N * 1024 * 2 <= WS_WB && WS_WB + (size_t)2 * B_NP * 1024 * 2 <= WS_WO && WS_WO + (size_t)4 * 1024 * 1024 * 2 <= WS_U && WS_U + (size_t)MTOK * 1024 * 2 <= WS_ACT, "ws map");
constexpr int CW_BAR = 4096;

namespace pg8 {
#define PG8_LAS __attribute__((address_space(3)))
typedef unsigned short bf16_t;
typedef short bf16x8 __attribute__((ext_vector_type(8)));
typedef float f32x4 __attribute__((ext_vector_type(4)));
typedef unsigned u32x4 __attribute__((ext_vector_type(4)));
constexpr int BM = 256, BK = 64, HALF = 128, HTB = HALF * BK * 2  , STAGE_BYTES = 8 * HTB, NXCD = 8, WGM = 8;

__host__ __device__ __forceinline__ int lds_byte(int r, int c) { const int st = (r >> 4) * 2 + (c >> 5), rr = r & 15, cc = c & 31, ob = rr * 64 + cc * 2; return st * 1024 + (ob ^ (((ob >> 9) & 1) << 5)); }
__host__ __device__ __forceinline__ void stage_rc(int b, int& R, int& C) { const int st = b / 1024, sb = b % 1024, swz = sb ^ (((sb >> 9) & 1) << 5); R = (st >> 1) * 16 + swz / 64; C = (st & 1) * 32 + (swz % 64) / 2; }
__host__ __device__ __forceinline__ int perm32(int rho) { const int n = rho >> 4, i = rho & 15; return 8 * (i >> 2) + 4 * n + (i & 3); }

struct Unit { int pm, pn; };
struct Gemm { const bf16_t* A; const bf16_t* Bt; int M, N, K; };

struct StaticOrder {
    int nM, nN, nwg, G, c;
    __host__ __device__ void init(int M, int N, int G_, int c_) { nM = M / BM; nN = N / BM; nwg = nM * nN; G = G_; c = c_; }
    __host__ __device__ bool next(int i, Unit& u) const {
        const long L = (long)i * G + c; if (L >= nwg) return false;
        int wgid = (int)L; { const int q = nwg / NXCD, r = nwg % NXCD, xcd = wgid % NXCD, off = wgid / NXCD; wgid = (xcd < r ? xcd * (q + 1) : r * (q + 1) + (xcd - r) * q) + off; }
        const int nig = WGM * nN, gid = wgid / nig, fm = gid * WGM, gsz = (nM - fm) < WGM ? (nM - fm) : WGM;
        u.pm = fm + ((wgid % nig) % gsz); u.pn = (wgid % nig) / gsz; return true;
    }
    __device__ __forceinline__ void a_ready(const Unit&) const {}
    __device__ __forceinline__ void done(const Unit&) const {}
};

__device__ __forceinline__ unsigned cvt_pk_bf16(float lo, float hi) { unsigned r; asm volatile("v_cvt_pk_bf16_f32 %0, %1, %2" : "=v"(r) : "v"(lo), "v"(hi)); return r; }
typedef float f32x2 __attribute__((ext_vector_type(2)));
constexpr float C2F = 0.125f * 1.4426950408889634f;
constexpr float WSC = 0.35355339059327373f * 0.125f;
__device__ __forceinline__ float silu_f(float x) { return x * __builtin_amdgcn_rcpf(1.0f + __builtin_amdgcn_exp2f(-1.4426950408889634f * x)); }
__device__ __forceinline__ f32x4 silu4(f32x4 v) { return (f32x4){silu_f(v[0]), silu_f(v[1]), silu_f(v[2]), silu_f(v[3])}; }
__device__ __forceinline__ u32x4 pack8(f32x4 a, f32x4 b) { u32x4 w; w.x = cvt_pk_bf16(a[0], a[1]); w.y = cvt_pk_bf16(a[2], a[3]); w.z = cvt_pk_bf16(b[0], b[1]); w.w = cvt_pk_bf16(b[2], b[3]); return w; }

__device__ __forceinline__ void epi_store_rows(const f32x4 (&acc)[2][2][4][2], int kind, bf16_t* ob, int pitch, int row0, int col0, int j0, const float* cs, const float* sn) {
#pragma unroll
    for (int ai = 0; ai < 2; ++ai) {
        f32x4 c4[8], s4[8];
        if (kind < 2) {
#pragma unroll
            for (int i = 0; i < 4; ++i) { const int row = row0 + ai * HALF + i * 16;
                c4[ai * 4 + i] = *(const f32x4*)(cs + (size_t)row * 32 + j0); s4[ai * 4 + i] = *(const f32x4*)(sn + (size_t)row * 32 + j0); }
        }
#pragma unroll
        for (int m = 0; m < 4; ++m) {
            const int row = row0 + ai * HALF + m * 16;
            bf16_t* rowp = ob + (size_t)row * pitch + col0;
#pragma unroll
            for (int bj = 0; bj < 2; ++bj) {
                f32x4 v0 = acc[ai][bj][m][0], v1 = acc[ai][bj][m][1];
                if (kind < 2) { const f32x4 o0 = v0 * c4[ai * 4 + m] - v1 * s4[ai * 4 + m], o1 = v1 * c4[ai * 4 + m] + v0 * s4[ai * 4 + m]; v0 = o0; v1 = o1; if (kind == 0) { v0 = v0 * C2F; v1 = v1 * C2F; } }
                else if (kind == 3) { v0 = silu4(v0); v1 = silu4(v1); }
                *(u32x4*)(rowp + bj * HALF) = pack8(v0, v1);
            }
        }
    }
}
struct EpiA {
    static constexpr bool PERM = true, AFTER_DRAIN = false;
    unsigned char* ws; int row_off;
    __device__ __forceinline__ void operator()(const f32x4 (&acc)[2][2][4][2], const Unit& u, int wr, int wc, int fr, int fq) const {
        asm volatile("" : "+v"(fr), "+v"(fq));
        const int t = u.pn >> 2, kind = (t == 9) ? 3 : (t % 3);
        const float* cs = (const float*)(ws + WS_COS) + (size_t)row_off * 32; const float* sn = (const float*)(ws + WS_SIN) + (size_t)row_off * 32;
        epi_store_rows(acc, kind, (bf16_t*)(ws + WS_ACT) + (size_t)t * (A_SUB / 2), 1024, u.pm * BM + wr * 64 + fr, (u.pn & 3) * BM + wc * 32 + 8 * fq, 16 * (wc & 1) + 4 * fq, cs, sn);
    }
};
struct EpiB {
    static constexpr bool PERM = true, AFTER_DRAIN = false;
    unsigned char* ws;
    __device__ __forceinline__ void operator()(const f32x4 (&acc)[2][2][4][2], const Unit& u, int wr, int wc, int fr, int fq) const {
        asm volatile("" : "+v"(fr), "+v"(fq));
        bf16_t* Q = (bf16_t*)(ws + WS_BQ); bf16_t* K = (bf16_t*)(ws + WS_BK); bf16_t* V = (bf16_t*)(ws + WS_BV); bf16_t* QI = (bf16_t*)(ws + WS_BQI); bf16_t* KI = (bf16_t*)(ws + WS_BKI); bf16_t* G = (bf16_t*)(ws + WS_BG);
        float* WI = (float*)(ws + WS_BWI); const float* cs = (const float*)(ws + WS_COS); const float* sn = (const float*)(ws + WS_SIN);
        const int pn = u.pn, row0 = u.pm * BM + wr * 64 + fr, cw = wc * 32 + 8 * fq, j0 = 16 * (wc & 1) + 4 * fq;
        if (pn < 4)       epi_store_rows(acc, 0, Q, 1024, row0, pn * BM + cw, j0, cs, sn);
        else if (pn == 4) epi_store_rows(acc, 1, K, 256, row0, cw, j0, cs, sn);
        else if (pn == 5) epi_store_rows(acc, 2, V, 256, row0, cw, j0, cs, sn);
        else if (pn < 8)  epi_store_rows(acc, 1, QI, 512, row0, (pn - 6) * BM + cw, j0, cs, sn);
        else if (pn > 8)  epi_store_rows(acc, 3, G, 1024, row0, (pn - 9) * BM + cw, j0, cs, sn);
        else {
#pragma unroll
            for (int ai = 0; ai < 2; ++ai)
#pragma unroll
                for (int m = 0; m < 4; ++m) {
                    const int row = row0 + ai * HALF + m * 16;
                    const f32x4 v0 = acc[ai][0][m][0], v1 = acc[ai][0][m][1];
                    if (wc < 2) {
                        const f32x4 c4 = *(const f32x4*)(cs + (size_t)row * 32 + j0), s4 = *(const f32x4*)(sn + (size_t)row * 32 + j0);
                        *(u32x4*)(KI + (size_t)row * 64 + cw) = pack8(v0 * c4 - v1 * s4, v1 * c4 + v0 * s4);
                    } else if (wc == 2 && fq == 0) {
                        *(f32x4*)(WI + (size_t)row * 8) = v0 * WSC; *(f32x4*)(WI + (size_t)row * 8 + 4) = v1 * WSC;
                    }
                }
        }
    }
};
struct EpiOut {
    static constexpr bool PERM = false, AFTER_DRAIN = false;
    const float* hin; float* hout; const float* gate;
    __device__ __forceinline__ void operator()(const f32x4 (&acc)[2][2][4][2], const Unit& u, int wr, int wc, int fr, int fq) const {
        asm volatile("" : "+v"(fr), "+v"(fq));
        const int col0 = u.pn * BM + wc * 32 + 4 * fq;
        const int b = (u.pm * BM) >> 12;
        f32x4 g4[2][2];
#pragma unroll
        for (int bj = 0; bj < 2; ++bj)
#pragma unroll
            for (int n = 0; n < 2; ++n) g4[bj][n] = *(const f32x4*)(gate + (size_t)b * 3072 + col0 + bj * HALF + n * 16);
#pragma unroll
        for (int ai = 0; ai < 2; ++ai) {
#pragma unroll
          for (int mh = 0; mh < 2; ++mh) {
            f32x4 h4[4][2][2];
#pragma unroll
            for (int m = 2 * mh; m < 2 * mh + 2; ++m) { const int row = u.pm * BM + ai * HALF + wr * 64 + m * 16 + fr;
#pragma unroll
                for (int bj = 0; bj < 2; ++bj)
#pragma unroll
                    for (int n = 0; n < 2; ++n) h4[m][bj][n] = *(const f32x4*)(hin + (size_t)row * 1024 + col0 + bj * HALF + n * 16); }
#pragma unroll
            for (int m = 2 * mh; m < 2 * mh + 2; ++m) { const int row = u.pm * BM + ai * HALF + wr * 64 + m * 16 + fr;
#pragma unroll
                for (int bj = 0; bj < 2; ++bj)
#pragma unroll
                    for (int n = 0; n < 2; ++n) *(f32x4*)(hout + (size_t)row * 1024 + col0 + bj * HALF + n * 16) = h4[m][bj][n] + g4[bj][n] * acc[ai][bj][m][n]; }
          }
        }
    }
};

template <class Epi, class Sched, bool ALIGN_EPI = false, bool SP2 = false>
__device__ __forceinline__ void gemm_phase(PG8_LAS unsigned char* lds, const Gemm g, const Sched& S, const Epi& E) {
    int tid_ = threadIdx.x; asm volatile("" : "+v"(tid_));
    const int tid = tid_, wid = __builtin_amdgcn_readfirstlane(tid >> 6), lane = tid & 63, wr = wid >> 2, wc = wid & 3, fr = lane & 15, fq = lane >> 4;
    const int K = g.K, nt = K / BK;
    unsigned voffA[2], voffB[2];
#pragma unroll
    for (int i = 0; i < 2; ++i) { int R, C; stage_rc(tid * 16 + i * 8192, R, C); const int Rb = Epi::PERM ? ((R & ~31) + perm32(R & 31)) : R;
        voffA[i] = (unsigned)(R * K + C) * 2u; voffB[i] = (unsigned)(Rb * K + C) * 2u; }
    const size_t kstep = (size_t)(BK * 2);
    const size_t hstep = (size_t)HALF * K * 2;
    const size_t tstep = 2 * hstep;
    const unsigned ldsw = (unsigned)wid * 1024u;
    const int aoff = lds_byte(wr * 64 + fr, fq * 8), boff = lds_byte(wc * 32 + fr, fq * 8);
#define PG8_SA(b, h) (((b) * 2 + (h)) * HTB)
#define PG8_SB(b, h) ((4 + (b) * 2 + (h)) * HTB)
#define PG8_STAGE(bufoff, gbase, voff) do { _Pragma("unroll") for (int _i = 0; _i < 2; ++_i) \
        __builtin_amdgcn_global_load_lds((const unsigned*)((const char*)(gbase) + (voff)[_i]), (PG8_LAS unsigned*)(lds + (bufoff) + ldsw + _i * 8192), 16, 0, 0); } while (0)
#define PG8_LDA(dst, b, h) do { _Pragma("unroll") for (int m = 0; m < 4; ++m) _Pragma("unroll") for (int k = 0; k < 2; ++k) dst[m][k] = *(const PG8_LAS bf16x8*)(lds + PG8_SA(b, h) + aoff + m * 2048 + k * 1024); } while (0)
#define PG8_LDB(dst, b, h) do { _Pragma("unroll") for (int n = 0; n < 2; ++n) _Pragma("unroll") for (int k = 0; k < 2; ++k) dst[n][k] = *(const PG8_LAS bf16x8*)(lds + PG8_SB(b, h) + boff + n * 2048 + k * 1024); } while (0)
#define PG8_MMA(ai, bj, At, Bt) do { __builtin_amdgcn_s_setprio(1); _Pragma("unroll") for (int m = 0; m < 4; ++m) _Pragma("unroll") for (int n = 0; n < 2; ++n) _Pragma("unroll") for (int k = 0; k < 2; ++k) \
        acc[ai][bj][m][n] = __builtin_amdgcn_mfma_f32_16x16x32_bf16(Bt[n][k], At[m][k], acc[ai][bj][m][n], 0, 0, 0); __builtin_amdgcn_s_setprio(0); } while (0)
#define PG8_WAIT_V(n) asm volatile("s_waitcnt vmcnt(" #n ")" ::: "memory")
#define PG8_WAIT_L(n) asm volatile("s_waitcnt lgkmcnt(" #n ")" ::: "memory")
#define PG8_BAR __builtin_amdgcn_s_barrier()
#define PG8_SCHED __builtin_amdgcn_sched_barrier(0)
    Unit cur, nxt; int ui = 0;
    if (!S.next(0, cur)) return;
    f32x4 acc[2][2][4][2];
#pragma unroll
    for (int a = 0; a < 2; ++a)
#pragma unroll
        for (int b = 0; b < 2; ++b)
#pragma unroll
            for (int m = 0; m < 4; ++m)
#pragma unroll
                for (int n = 0; n < 2; ++n) acc[a][b][m][n] = (f32x4){0.f, 0.f, 0.f, 0.f};
    bf16x8 At[4][2], B0[2][2], B1[2][2];
    const char* cA = (const char*)g.A + (size_t)cur.pm * tstep; const char* cB = (const char*)g.Bt + (size_t)cur.pn * tstep;
    S.a_ready(cur);
    if constexpr (SP2) {
        PG8_STAGE(PG8_SB(0, 0), cB, voffB); PG8_STAGE(PG8_SB(0, 1), cB + hstep, voffB); PG8_STAGE(PG8_SA(0, 0), cA, voffA); PG8_STAGE(PG8_SA(0, 1), cA + hstep, voffA);
        if (wr == 1) PG8_BAR;
        PG8_WAIT_V(2); PG8_BAR;
        PG8_STAGE(PG8_SB(1, 0), cB + kstep, voffB); PG8_STAGE(PG8_SA(1, 0), cA + kstep, voffA); PG8_STAGE(PG8_SB(1, 1), cB + hstep + kstep, voffB);
        PG8_WAIT_V(6); PG8_BAR;
    } else {
        PG8_STAGE(PG8_SB(0, 0), cB, voffB); PG8_STAGE(PG8_SA(0, 0), cA, voffA); PG8_STAGE(PG8_SB(0, 1), cB + hstep, voffB); PG8_STAGE(PG8_SA(0, 1), cA + hstep, voffA);
        if (wr == 1) PG8_BAR;
        PG8_WAIT_V(4); PG8_BAR;
        PG8_STAGE(PG8_SB(1, 0), cB + kstep, voffB); PG8_STAGE(PG8_SA(1, 0), cA + kstep, voffA); PG8_STAGE(PG8_SB(1, 1), cB + hstep + kstep, voffB);
        PG8_WAIT_V(6); PG8_BAR;
    }
    for (;;) {
        const bool has_next = S.next(ui + 1, nxt);
        const char* nA = has_next ? (const char*)g.A + (size_t)nxt.pm * tstep : cA; const char* nB = has_next ? (const char*)g.Bt + (size_t)nxt.pn * tstep : cB;
        for (int t = 0; t < nt; t += 2) {
            const bool last = (t == nt - 2);
            const char* a1 = cA + (size_t)(t + 1) * kstep;
            const char* a2 = last ? nA : cA + (size_t)(t + 2) * kstep; const char* b2 = last ? nB : cB + (size_t)(t + 2) * kstep;
            const char* a3 = a2 + kstep; const char* b3 = b2 + kstep;
            if (last && has_next) S.a_ready(nxt);
            if constexpr (SP2) {
            PG8_LDB(B0, 0, 0); PG8_LDB(B1, 0, 1); PG8_SCHED; PG8_LDA(At, 0, 0); PG8_STAGE(PG8_SA(1, 1), a1 + hstep, voffA);
            PG8_WAIT_V(8); PG8_WAIT_L(0); PG8_BAR; PG8_MMA(0, 0, At, B0); PG8_MMA(0, 1, At, B1); PG8_BAR; PG8_SCHED;
            PG8_LDA(At, 0, 1); PG8_STAGE(PG8_SB(0, 0), b2, voffB); PG8_STAGE(PG8_SB(0, 1), b2 + hstep, voffB); PG8_STAGE(PG8_SA(0, 0), a2, voffA);
            PG8_WAIT_V(8); PG8_WAIT_L(0); PG8_BAR; PG8_MMA(1, 0, At, B0); PG8_MMA(1, 1, At, B1); PG8_BAR; PG8_SCHED;
            PG8_LDB(B0, 1, 0); PG8_LDB(B1, 1, 1); PG8_SCHED; PG8_LDA(At, 1, 0); PG8_STAGE(PG8_SA(0, 1), a2 + hstep, voffA);
            PG8_WAIT_V(8); PG8_WAIT_L(0); PG8_BAR; PG8_MMA(0, 0, At, B0); PG8_MMA(0, 1, At, B1); PG8_BAR; PG8_SCHED;
            PG8_LDA(At, 1, 1); PG8_STAGE(PG8_SB(1, 0), b3, voffB); PG8_STAGE(PG8_SB(1, 1), b3 + hstep, voffB); PG8_STAGE(PG8_SA(1, 0), a3, voffA);
            PG8_WAIT_V(8); PG8_WAIT_L(0); PG8_BAR; PG8_MMA(1, 0, At, B0); PG8_MMA(1, 1, At, B1); PG8_BAR; PG8_SCHED;
            } else {
            PG8_LDB(B0, 0, 0); PG8_SCHED; PG8_LDA(At, 0, 0); PG8_STAGE(PG8_SA(1, 1), a1 + hstep, voffA);
            PG8_WAIT_L(8); PG8_BAR; PG8_WAIT_L(0); PG8_MMA(0, 0, At, B0); PG8_BAR; PG8_SCHED;
            PG8_LDB(B1, 0, 1); PG8_STAGE(PG8_SB(0, 0), b2, voffB);
            PG8_BAR; PG8_WAIT_L(0); PG8_MMA(0, 1, At, B1); PG8_BAR;
            PG8_LDA(At, 0, 1); PG8_STAGE(PG8_SA(0, 0), a2, voffA);
            PG8_BAR; PG8_WAIT_L(0); PG8_MMA(1, 0, At, B0); PG8_BAR; PG8_SCHED;
            PG8_STAGE(PG8_SB(0, 1), b2 + hstep, voffB);
            PG8_WAIT_V(6); PG8_BAR; PG8_MMA(1, 1, At, B1); PG8_BAR;
            PG8_LDB(B0, 1, 0); PG8_SCHED; PG8_LDA(At, 1, 0); PG8_STAGE(PG8_SA(0, 1), a2 + hstep, voffA);
            PG8_WAIT_L(8); PG8_BAR; PG8_WAIT_L(0); PG8_MMA(0, 0, At, B0); PG8_BAR; PG8_SCHED;
            PG8_LDB(B1, 1, 1); PG8_STAGE(PG8_SB(1, 0), b3, voffB);
            PG8_BAR; PG8_WAIT_L(0); PG8_MMA(0, 1, At, B1); PG8_BAR;
            PG8_LDA(At, 1, 1); PG8_STAGE(PG8_SA(1, 0), a3, voffA);
            PG8_BAR; PG8_WAIT_L(0); PG8_MMA(1, 0, At, B0); PG8_BAR; PG8_SCHED;
            PG8_STAGE(PG8_SB(1, 1), b3 + hstep, voffB);
            PG8_WAIT_V(6); PG8_BAR; PG8_MMA(1, 1, At, B1); PG8_BAR;
            }
        }
        if constexpr (ALIGN_EPI) { if (wr == 0) PG8_BAR; }
        if constexpr (!Epi::AFTER_DRAIN) { E(acc, cur, wr, wc, fr, fq); S.done(cur); }
        if (!has_next) break;
#pragma unroll
        for (int a = 0; a < 2; ++a)
#pragma unroll
            for (int b = 0; b < 2; ++b)
#pragma unroll
                for (int m = 0; m < 4; ++m)
#pragma unroll
                    for (int n = 0; n < 2; ++n) acc[a][b][m][n] = (f32x4){0.f, 0.f, 0.f, 0.f};
        cur = nxt; cA = nA; cB = nB; ++ui;
        if constexpr (ALIGN_EPI) { if (wr == 1) PG8_BAR; }
    }
    PG8_WAIT_V(0);
    if constexpr (!ALIGN_EPI) { if (wr == 0) PG8_BAR; }
    PG8_BAR;
    if constexpr (Epi::AFTER_DRAIN) { E.fused(acc, cur, wr, wc, fr, fq, lds, wid, lane); S.done(cur); }
#undef PG8_SA
#undef PG8_SB
#undef PG8_STAGE
#undef PG8_LDA
#undef PG8_LDB
#undef PG8_MMA
#undef PG8_WAIT_V
#undef PG8_WAIT_L
#undef PG8_BAR
#undef PG8_SCHED
}
}
#define GAS __attribute__((address_space(1)))
#define LAS __attribute__((address_space(3)))
typedef unsigned short bf16;
typedef unsigned v4u __attribute__((ext_vector_type(4)));
typedef float f32x4 __attribute__((ext_vector_type(4)));
typedef short bf16x8 __attribute__((ext_vector_type(8)));
typedef GAS unsigned gu32;
typedef GAS unsigned long long gu64;
#define RLX_AGENT __ATOMIC_RELAXED, __HIP_MEMORY_SCOPE_AGENT
#define LDS_WAIT() asm volatile("s_waitcnt lgkmcnt(0)" ::: "memory")
#define VM_WAIT() asm volatile("s_waitcnt vmcnt(0)" ::: "memory")
__device__ __forceinline__ unsigned long long rt() { return __builtin_amdgcn_s_memrealtime(); }
__device__ __forceinline__ unsigned f2bf(float f) { unsigned u = __builtin_bit_cast(unsigned, f); return (u + 0x7fffu + ((u >> 16) & 1u)) >> 16; }
__device__ __forceinline__ unsigned pk2(float lo, float hi) { return f2bf(lo) | (f2bf(hi) << 16); }

#define XB_TMO      128
#define XB_XCNT(j)  (256  + 64 * (j))
#define XB_XSUB(j)  (1280 + 64 * (j))
#define XB_XGEN(j)  (2304 + 64 * (j))
#define XB_TOP      3328
#define XB_TOPGEN   3392
#define XCD_BAR_WORDS 3456
#define XB_SPIN_CAP (1u << 18)

__device__ __forceinline__ unsigned xb_ld(unsigned* p)              { return __hip_atomic_load(p, __ATOMIC_RELAXED, __HIP_MEMORY_SCOPE_AGENT); }
__device__ __forceinline__ unsigned xb_add(unsigned* p, unsigned v) { return __hip_atomic_fetch_add(p, v, __ATOMIC_RELAXED, __HIP_MEMORY_SCOPE_AGENT); }
__device__ __forceinline__ unsigned xb_xcc_id() { return (unsigned)__builtin_amdgcn_s_getreg((3 << 11) | 20) & 0xFu; }
#define XB_SPIN(cond, bar) do { unsigned _sp = 0; while (cond) { __builtin_amdgcn_s_sleep(1); \
    if ((++_sp & 255u) == 0u) { if (xb_ld(&(bar)[XB_TMO])) break; if (_sp > XB_SPIN_CAP) { atomicAdd(&(bar)[XB_TMO], 1u); break; } } } } while (0)

struct XcdBarrier {
    unsigned* bar; unsigned x;
    volatile LAS unsigned* st;
};

__device__ __forceinline__ XcdBarrier xcd_barrier_post(unsigned* bar, volatile LAS unsigned* st) {
    XcdBarrier b; b.bar = bar; b.x = xb_xcc_id(); b.st = st;
    if (threadIdx.x == 0) (void)xb_add(&bar[XB_XCNT(b.x)], 1u);
    return b;
}
__device__ __forceinline__ void xcd_barrier_complete(unsigned* bar, unsigned x, unsigned& nloc, unsigned& nx) {
    const unsigned G = gridDim.x * gridDim.y * gridDim.z;
    unsigned sum, cnt, mine, sp = 0u;
    for (;;) {
        sum = 0u; cnt = 0u; mine = 0u;
#pragma unroll
        for (unsigned j = 0; j < 16; ++j) { const unsigned c = xb_ld(&bar[XB_XCNT(j)]); sum += c; cnt += (c > 0u) ? 1u : 0u; mine = (j == x) ? c : mine; }
        if (sum == G) break;
        __builtin_amdgcn_s_sleep(1);
        if ((++sp & 255u) == 0u) { if (xb_ld(&bar[XB_TMO])) break; if (sp > XB_SPIN_CAP) { atomicAdd(&bar[XB_TMO], 1u); break; } }
    }
    nloc = mine > 0u ? mine : 1u; nx = cnt > 0u ? cnt : 1u;
}

__device__ __forceinline__ void xcd_barrier(const XcdBarrier& b) {
    asm volatile("s_waitcnt vmcnt(0)" ::: "memory");
    __syncthreads();
    if (threadIdx.x == 0) {
        unsigned* bar = b.bar;
        __builtin_amdgcn_s_waitcnt(0);
        unsigned nloc = b.st[0], nx = b.st[1];
        if (nloc == 0u) { xcd_barrier_complete(bar, b.x, nloc, nx); b.st[0] = nloc; b.st[1] = nx; }
        const unsigned old = xb_add(&bar[XB_XSUB(b.x)], 1u);
        const unsigned gen = old / nloc;
        if (old + 1u == (gen + 1u) * nloc) {
            __builtin_amdgcn_fence(__ATOMIC_RELEASE, "agent");
            asm volatile("s_waitcnt vmcnt(0)" ::: "memory");
            const unsigned og = xb_add(&bar[XB_TOP], 1u);
            const unsigned tg = og / nx;
            if (og + 1u == (tg + 1u) * nx) xb_add(&bar[XB_TOPGEN], 1u);
            else XB_SPIN(xb_ld(&bar[XB_TOPGEN]) == tg, bar);
            __builtin_amdgcn_fence(__ATOMIC_ACQUIRE, "agent");
            xb_add(&bar[XB_XGEN(b.x)], 1u);
            asm volatile("s_waitcnt vmcnt(0)" ::: "memory");
        } else {
            XB_SPIN(xb_ld(&bar[XB_XGEN(b.x)]) == gen, bar);
            __builtin_amdgcn_fence(__ATOMIC_ACQUIRE, "agent");
            asm volatile("s_waitcnt vmcnt(0)" ::: "memory");
        }
    }
    __syncthreads();
}

constexpr int RING_BYTES = 131072;
constexpr int SEL_HIST_OFF = 131072, SEL_CAND_OFF = SEL_HIST_OFF + 16384, SEL_STAGE_OFF = SEL_CAND_OFF + 4096, MISC_OFF = SEL_STAGE_OFF + 4096, LDS_BYTES = 159744;
static_assert(MISC_OFF + 256 <= LDS_BYTES, "LDS map");

typedef short s16x4 __attribute__((ext_vector_type(4)));
typedef short v4i16_t __attribute__((ext_vector_type(4)));
typedef float f32x16 __attribute__((ext_vector_type(16)));
typedef unsigned u32x2 __attribute__((ext_vector_type(2)));
__device__ __forceinline__ float wave_sum(float v) {
#pragma unroll
    for (int o = 1; o < 64; o <<= 1) v += __shfl_xor(v, o);
    return v;
}
__device__ __forceinline__ unsigned cvtpk(float lo, float hi) { unsigned r; asm volatile("v_cvt_pk_bf16_f32 %0, %1, %2" : "=v"(r) : "v"(lo), "v"(hi)); return r; }
__device__ __forceinline__ float bf_lo(unsigned w) { return __uint_as_float(w << 16); }
__device__ __forceinline__ float bf_hi(unsigned w) { return __uint_as_float(w & 0xffff0000u); }
__device__ __forceinline__ float swap_max(float m) { auto rr = __builtin_amdgcn_permlane32_swap(__float_as_uint(m), __float_as_uint(m), false, false); return fmaxf(__uint_as_float(rr[0]), __uint_as_float(rr[1])); }
__device__ __forceinline__ float swap_sum(float m) { auto rr = __builtin_amdgcn_permlane32_swap(__float_as_uint(m), __float_as_uint(m), false, false); return __uint_as_float(rr[0]) + __uint_as_float(rr[1]); }
__device__ __forceinline__ int crow(int r, int hi) { return (r & 3) + 8 * (r >> 2) + 4 * hi; }
__device__ __forceinline__ unsigned vimg(unsigned row, unsigned ch) { return row * 128u + 16u * (ch ^ ((row & 3u) | (((row >> 1) & 1u) << 2))); }
__device__ __forceinline__ unsigned kimg(unsigned row, unsigned ch) { return row * 128u + 16u * (ch ^ ((row >> 1) & 7u)); }
__device__ __forceinline__ s16x4 vtr(const LAS unsigned char* p) { return __builtin_bit_cast(s16x4, __builtin_amdgcn_ds_read_tr16_b64_v4i16((LAS v4i16_t*)p)); }
#define MFMA32(a, b, c) __builtin_amdgcn_mfma_f32_32x32x16_bf16((a), (b), (c), 0, 0, 0)

struct Frame {
    LAS unsigned char* lds; volatile LAS unsigned* MISC; gu32* ctl;
    int tid, lane, wave, vcu, G, bx;
};
struct Args { const float* in[11]; const int* pos; float* out; unsigned char* ws; int seg; int pad; };
typedef const Args __attribute__((address_space(4)))* cargs_t;

__device__ __forceinline__ int rope_perm64(int c) { return ((c & 31) >> 2) * 8 + (c & 3) + ((c >> 5) << 2); }
template <int KIND> __device__ __forceinline__ int phys_row(int n) {
    if (KIND == 0) { if (n < 9216 && ((n >> 10) % 3) < 2) return (n & ~63) + rope_perm64(n & 63); return n; }
    if (KIND == 1) { if (n < 1280 || (n >= 1536 && n < 2112)) return (n & ~63) + rope_perm64(n & 63); if (n >= 2120) return n + 184; return n; }
    return n;
}
template <int KIND> __device__ __forceinline__ void transpose_item(const float* W, int K, int N, bf16* WT, LAS float* scr, int item, int lane) {
    const int nblk = (N + 31) / 32, kb = item / nblk, nb = item % nblk, k0 = 64 * kb, n0 = 32 * nb;
    const bool nok = n0 + (lane & 31) < N;
#pragma unroll 8
    for (int i = 0; i < 32; ++i) { const int kk = 2 * i + (lane >> 5); scr[kk * 33 + (lane & 31)] = nok ? W[(size_t)(k0 + kk) * N + n0 + (lane & 31)] : 0.f; }
    LDS_WAIT(); asm volatile("" ::: "memory");
    const int c = lane & 7;
#pragma unroll
    for (int j = 0; j < 4; ++j) { const int n = (lane >> 3) + 8 * j; const LAS float* s = scr + (8 * c) * 33 + n;
        v4u o; o.x = pk2(s[0 * 33], s[1 * 33]); o.y = pk2(s[2 * 33], s[3 * 33]); o.z = pk2(s[4 * 33], s[5 * 33]); o.w = pk2(s[6 * 33], s[7 * 33]);
        if (n0 + n < N) *(GAS v4u*)(WT + (size_t)phys_row<KIND>(n0 + n) * K + k0 + 8 * c) = o; }
    LDS_WAIT(); asm volatile("" ::: "memory");
}
__constant__ float INVF[32] = {1.000000000e+00f, 7.498942614e-01f, 5.623413324e-01f, 4.216965139e-01f, 3.162277639e-01f, 2.371373773e-01f, 1.778279394e-01f, 1.333521307e-01f, 1.000000015e-01f, 7.498941571e-02f,
    5.623413250e-02f, 4.216965288e-02f, 3.162277490e-02f, 2.371373773e-02f, 1.778279431e-02f, 1.333521493e-02f, 9.999999776e-03f, 7.498941850e-03f, 5.623413250e-03f, 4.216964822e-03f, 3.162277630e-03f, 2.371373586e-03f,
    1.778279431e-03f, 1.333521446e-03f, 1.000000047e-03f, 7.498942432e-04f, 5.623413017e-04f, 4.216965172e-04f, 3.162277571e-04f, 2.371373703e-04f, 1.778279402e-04f, 1.333521504e-04f};

__device__ __forceinline__ void p_prologue(Frame& F, cargs_t ap) {
    const float* const* in_ = nullptr; (void)in_;
    struct { const float* in[11]; const int* pos; unsigned char* ws; } a;
#pragma unroll
    for (int i = 0; i < 11; ++i) a.in[i] = ap->in[i];
    a.pos = ap->pos; a.ws = ap->ws;
    unsigned char* ws = a.ws;
    LAS float* scr = (LAS float*)(F.lds + F.wave * 12288);
    const int gw = F.vcu * NWAVES + F.wave, NGW = F.G * NWAVES;
    constexpr int I_A = 16 * (A_N / 32), I_B = 16 * ((B_NL + 31) / 32), I_O = 16 * 32;
    constexpr int NITEMS = 2 * I_A + 2 * I_B + 4 * I_O;
    for (int it = gw; it < NITEMS; it += NGW) {
        int r = it;
        if (r < 2 * I_A) { const int l = r / I_A; transpose_item<0>(a.in[6] + (size_t)l * 1024 * A_N, 1024, A_N, (bf16*)(ws + WS_WA) + (size_t)l * A_N * 1024, scr, r % I_A, F.lane); continue; } r -= 2 * I_A;
        if (r < 2 * I_B) { const int l = r / I_B; transpose_item<1>(a.in[8] + (size_t)l * 1024 * B_NL, 1024, B_NL, (bf16*)(ws + WS_WB) + (size_t)l * B_NP * 1024, scr, r % I_B, F.lane); continue; } r -= 2 * I_B;
        { const int l = r / I_O;
          const float* W = ((l & 1) ? a.in[9] : a.in[7]) + (size_t)(l >> 1) * 1024 * 1024;
          transpose_item<2>(W, 1024, 1024, (bf16*)(ws + WS_WO) + (size_t)l * 1024 * 1024, scr, r % I_O, F.lane); }
    }
    { const int gt = (F.vcu * NWAVES + F.wave) * 64 + F.lane, NGT = NGW * 64;
      for (int i = gt; i < 2 * 184 * 128; i += NGT) { const int l = i / (184 * 128), rr = (i / 128) % 184, c = i % 128;
          *(GAS v4u*)((bf16*)(ws + WS_WB) + (size_t)l * B_NP * 1024 + (size_t)(2120 + rr) * 1024 + c * 8) = (v4u){0u, 0u, 0u, 0u}; }
      float* cs = (float*)(ws + WS_COS); float* sn = (float*)(ws + WS_SIN);
      for (int i = gt; i < MTOK * 32; i += NGT) { const int tok = i >> 5, j = i & 31;
          const float angf = (float)a.pos[tok] * INVF[j]; const double x = (double)angf;
          const double k = __builtin_rint(x * 0.15915494309189535); double r = __builtin_fma(-k, 6.283185307179586, x); r = __builtin_fma(-k, 2.4492935982947064e-16, r);
          const float rf = (float)r; cs[i] = __cosf(rf); sn[i] = __sinf(rf); }
    }
    { LAS float* cact = (LAS float*)(F.lds + 98304);
      for (int i = F.tid; i < 8 * 1024; i += NWAVES * 64) { const float v = a.in[1][i]; cact[i] = v / (1.f + __expf(-v)); }
      __syncthreads();
      const float* adaw = a.in[4]; const float* adab = a.in[5]; float* mod = (float*)(ws + WS_MOD);
      const int col = F.lane & 15, kq = F.lane >> 4;
      for (int it = gw; it < 4 * 192; it += NGW) { const int l = it / 192, n0 = (it % 192) * 16;
          float acc[8];
#pragma unroll
          for (int b = 0; b < 8; ++b) acc[b] = 0.f;
          const float* wp = adaw + (size_t)l * 1024 * 3072 + (size_t)(kq * 256) * 3072 + n0 + col;
#pragma unroll 32
          for (int k = 0; k < 256; ++k) { const float w = wp[(size_t)k * 3072];
#pragma unroll
              for (int b = 0; b < 8; ++b) acc[b] += cact[b * 1024 + kq * 256 + k] * w; }
#pragma unroll
          for (int b = 0; b < 8; ++b) { float v = acc[b]; v += __shfl_xor(v, 16); v += __shfl_xor(v, 32); acc[b] = v; }
          if (kq == 0) {
#pragma unroll
              for (int b = 0; b < 8; ++b) mod[((size_t)l * 8 + b) * 3072 + n0 + col] = acc[b] + adab[(size_t)l * 3072 + n0 + col]; }
      }
    }
}

__device__ __forceinline__ void p_norm_mod(Frame& F, const float* hin, const float* g, const float* mod_l, bf16* U) {
    const int gw = F.vcu * NWAVES + F.wave, NGW = F.G * NWAVES;
    for (int r0 = gw * 16; r0 < MTOK; r0 += NGW * 16) {
        const int b = r0 >> 12;
        f32x4 A[4], Bv[4];
#pragma unroll
        for (int j = 0; j < 4; ++j) { const int c = 4 * F.lane + 256 * j; const f32x4 gg = *(const f32x4*)(g + c), sc = *(const f32x4*)(mod_l + (size_t)b * 3072 + 1024 + c);
            A[j] = gg * (sc + 1.0f); Bv[j] = *(const f32x4*)(mod_l + (size_t)b * 3072 + c); }
        for (int rr = 0; rr < 16; ++rr) {
            const int row = r0 + rr; const GAS f32x4* xr = (const GAS f32x4*)(hin + (size_t)row * DM) + F.lane;
            f32x4 v[4]; float s = 0.f;
#pragma unroll
            for (int j = 0; j < 4; ++j) { v[j] = xr[64 * j]; s += (v[j].x * v[j].x + v[j].y * v[j].y) + (v[j].z * v[j].z + v[j].w * v[j].w); }
            const float rstd = 1.0f / sqrtf(wave_sum(s) * (1.f / DM) + NORM_EPS);
            GAS u32x2* o8 = (GAS u32x2*)(U + (size_t)row * DM) + F.lane;
#pragma unroll
            for (int j = 0; j < 4; ++j) { const f32x4 y = (v[j] * rstd) * A[j] + Bv[j]; o8[64 * j] = (u32x2){cvtpk(y.x, y.y), cvtpk(y.z, y.w)}; }
        }
    }
}
__device__ __forceinline__ void p_final_norm(Frame& F, const float* hin, const float* g, float* out) {
    const int gw = F.vcu * NWAVES + F.wave, NGW = F.G * NWAVES;
    f32x4 A[4];
#pragma unroll
    for (int j = 0; j < 4; ++j) A[j] = *(const f32x4*)(g + 4 * F.lane + 256 * j);
    for (int row = gw; row < MTOK; row += NGW) {
        const GAS f32x4* xr = (const GAS f32x4*)(hin + (size_t)row * DM) + F.lane;
        f32x4 v[4]; float s = 0.f;
#pragma unroll
        for (int j = 0; j < 4; ++j) { v[j] = xr[64 * j]; s += (v[j].x * v[j].x + v[j].y * v[j].y) + (v[j].z * v[j].z + v[j].w * v[j].w); }
        const float rstd = 1.0f / sqrtf(wave_sum(s) * (1.f / DM) + NORM_EPS);
        GAS f32x4* o = (GAS f32x4*)(out + (size_t)row * DM) + F.lane;
#pragma unroll
        for (int j = 0; j < 4; ++j) o[64 * j] = (v[j] * rstd) * A[j];
    }
}

__device__ __forceinline__ void attnA_tile(const bf16* Qp, bf16* Op, const bf16* Kp, const bf16* Vp, float* lsep, int lse_stride, int rstride, int i0, LAS unsigned char* vst, int lane) {
    const int q32 = lane & 31, hi = lane >> 5;
    bf16x8 qf[4];
    { const bf16* qrow = Qp + (size_t)(i0 + q32) * rstride + 8 * hi;
#pragma unroll
      for (int ks = 0; ks < 4; ++ks) qf[ks] = *(const bf16x8*)(qrow + 16 * ks); }
    f32x16 o0 = {}, o1 = {};
    float m_run = -INFINITY, l_run = 0.f;
    const int kt0 = (i0 >= 128) ? 0 : (128 - i0) / 32;
    bf16x8 kf[4]; v4u vr[4];
    const int vc = lane & 7, vrow = lane >> 3;
#define ATT_LOADKV(kb_) do { const bf16* kr_ = Kp + (size_t)((kb_) + q32) * rstride + 8 * hi; \
        _Pragma("unroll") for (int ks = 0; ks < 4; ++ks) kf[ks] = *(const bf16x8*)(kr_ + 16 * ks); \
        _Pragma("unroll") for (int i = 0; i < 4; ++i) vr[i] = *(const v4u*)(Vp + (size_t)((kb_) + vrow + 8 * i) * rstride + 8 * vc); } while (0)
    ATT_LOADKV(i0 - 128 + 32 * kt0);
    const int q4 = (lane & 15) >> 2, blk = (lane >> 4) & 1, p4 = lane & 3;
    for (int kt = kt0; kt < 5; ++kt) {
#pragma unroll
        for (int i = 0; i < 4; ++i) *(LAS v4u*)(vst + vimg(vrow + 8 * i, vc)) = vr[i];
        bf16x8 kc[4];
#pragma unroll
        for (int ks = 0; ks < 4; ++ks) kc[ks] = kf[ks];
        if (kt + 1 < 5) ATT_LOADKV(i0 - 128 + 32 * (kt + 1));
        f32x16 p = {};
#pragma unroll
        for (int ks = 0; ks < 4; ++ks) p = MFMA32(kc[ks], qf[ks], p);
        if (kt == 0) {
#pragma unroll
            for (int r = 0; r < 16; ++r) if (crow(r, hi) < q32) p[r] = -INFINITY;
        }
        if (kt == 4) {
#pragma unroll
            for (int r = 0; r < 16; ++r) if (crow(r, hi) > q32) p[r] = -INFINITY;
        }
        float mt = p[0];
#pragma unroll
        for (int r = 1; r < 16; ++r) mt = fmaxf(mt, p[r]);
        mt = swap_max(mt);
        const float m_new = fmaxf(m_run, mt);
        const float alpha = __builtin_amdgcn_exp2f(m_run - m_new);
        float s = 0.f;
#pragma unroll
        for (int r = 0; r < 16; ++r) { p[r] = __builtin_amdgcn_exp2f(p[r] - m_new); s += p[r]; }
        l_run = l_run * alpha + s; m_run = m_new;
#pragma unroll
        for (int r = 0; r < 16; ++r) { o0[r] *= alpha; o1[r] *= alpha; }
        bf16x8 pf[2];
#pragma unroll
        for (int ks = 0; ks < 2; ++ks) { v4u w; w.x = cvtpk(p[8 * ks + 0], p[8 * ks + 1]); w.y = cvtpk(p[8 * ks + 2], p[8 * ks + 3]); w.z = cvtpk(p[8 * ks + 4], p[8 * ks + 5]); w.w = cvtpk(p[8 * ks + 6], p[8 * ks + 7]); pf[ks] = __builtin_bit_cast(bf16x8, w); }
        LDS_WAIT(); asm volatile("" ::: "memory");
#pragma unroll
        for (int ks = 0; ks < 2; ++ks)
#pragma unroll
            for (int d0 = 0; d0 < 2; ++d0) {
                const s16x4 lo = vtr(vst + vimg(16 * ks + 4 * hi + q4, 4 * d0 + 2 * blk + (p4 >> 1)) + 8 * (p4 & 1));
                const s16x4 up = vtr(vst + vimg(16 * ks + 8 + 4 * hi + q4, 4 * d0 + 2 * blk + (p4 >> 1)) + 8 * (p4 & 1));
                const bf16x8 vf = (bf16x8){lo[0], lo[1], lo[2], lo[3], up[0], up[1], up[2], up[3]};
                if (d0 == 0) o0 = MFMA32(vf, pf[ks], o0); else o1 = MFMA32(vf, pf[ks], o1);
            }
        LDS_WAIT(); asm volatile("" ::: "memory");
    }
#undef ATT_LOADKV
    const float l_tot = swap_sum(l_run), inv = 1.0f / l_tot;
    bf16* orow = Op + (size_t)(i0 + q32) * rstride;
#pragma unroll
    for (int g4 = 0; g4 < 4; ++g4) {
        *(u32x2*)(orow + 8 * g4 + 4 * hi) = (u32x2){cvtpk(o0[4 * g4] * inv, o0[4 * g4 + 1] * inv), cvtpk(o0[4 * g4 + 2] * inv, o0[4 * g4 + 3] * inv)};
        *(u32x2*)(orow + 32 + 8 * g4 + 4 * hi) = (u32x2){cvtpk(o1[4 * g4] * inv, o1[4 * g4 + 1] * inv), cvtpk(o1[4 * g4 + 2] * inv, o1[4 * g4 + 3] * inv)};
    }
    if (hi == 0) lsep[(size_t)(i0 + q32) * lse_stride] = m_run + __builtin_amdgcn_logf(l_tot);
}
__device__ __forceinline__ void p_attnA(Frame& F, bf16* act, float* lse, bf16* dump) {
    LAS unsigned char* vst = F.lds + F.wave * 4096;
    constexpr int NBL = MC / SEQ, NUNITS = NBL * 3 * 16 * 16;
    for (int u = F.bx; u < NUNITS; u += F.G) {
        const int cb = u & 15, h = (u >> 4) & 15, g = (u >> 8) % 3, bl = u / 768;
        const int dl = (g == 0) ? 1 : (g == 1 ? 4 : 16), nbk = 16 / dl;
        const int r = cb / nbk, bk = cb % nbk;
        const size_t row_base = (size_t)bl * SEQ + r;
        bf16* Qp = act + (size_t)(3 * g + 0) * (A_SUB / 2) + row_base * 1024 + h * 64;
        const bf16* Kp = act + (size_t)(3 * g + 1) * (A_SUB / 2) + row_base * 1024 + h * 64;
        const bf16* Vp = act + (size_t)(3 * g + 2) * (A_SUB / 2) + row_base * 1024 + h * 64;
        float* lsep = lse + ((size_t)g * MC + row_base) * 16 + h;
        bf16* Op = dump ? dump + row_base * 1024 + h * 64 : Qp;
        attnA_tile(Qp, Op, Kp, Vp, lsep, 16 * dl, dl * 1024, bk * 256 + 32 * F.wave, vst, F.lane);
    }
}
__device__ __forceinline__ void p_mergeA(Frame& F, const bf16* act, const float* lse, bf16* Z  ) {
    const int gw = F.vcu * NWAVES + F.wave, NGW = F.G * NWAVES;
    const int head = F.lane >> 2;
    for (int row = gw; row < MC; row += NGW) {
        float l0 = lse[((size_t)0 * MC + row) * 16 + head], l1 = lse[((size_t)1 * MC + row) * 16 + head], l2 = lse[((size_t)2 * MC + row) * 16 + head];
        const float mx = fmaxf(l0, fmaxf(l1, l2));
        float e0 = __builtin_amdgcn_exp2f(l0 - mx), e1 = __builtin_amdgcn_exp2f(l1 - mx), e2 = __builtin_amdgcn_exp2f(l2 - mx);
        const float inv = 1.0f / (e0 + e1 + e2); e0 *= inv; e1 *= inv; e2 *= inv;
#pragma unroll
        for (int hf = 0; hf < 2; ++hf) {
            const size_t off = (size_t)row * 1024 + 16 * F.lane + 8 * hf;
            const v4u a0 = *(const v4u*)(act + (size_t)0 * (A_SUB / 2) + off), a1 = *(const v4u*)(act + (size_t)3 * (A_SUB / 2) + off), a2 = *(const v4u*)(act + (size_t)6 * (A_SUB / 2) + off),
                      gg = *(const v4u*)(act + (size_t)9 * (A_SUB / 2) + off);
            v4u o;
#pragma unroll
            for (int k = 0; k < 4; ++k) {
                const float ylo = (e0 * bf_lo(a0[k]) + e1 * bf_lo(a1[k]) + e2 * bf_lo(a2[k])) * bf_lo(gg[k]);
                const float yhi = (e0 * bf_hi(a0[k]) + e1 * bf_hi(a1[k]) + e2 * bf_hi(a2[k])) * bf_hi(gg[k]);
                o[k] = cvtpk(ylo, yhi);
            }
            *(v4u*)(Z + off) = o;
        }
    }
}

__device__ __forceinline__ unsigned ordkey(float f) { unsigned u = __float_as_uint(f); if ((u << 1) == 0u) u = 0u; return (u & 0x80000000u) ? ~u : (u | 0x80000000u); }
__device__ __forceinline__ void index_tile(Frame& F, int b, int t0, const bf16* QI, const bf16* KI, const float* WI, unsigned long long* maskw) {
    LAS float* sc = (LAS float*)F.lds;
    LAS unsigned* hist = (LAS unsigned*)(F.lds + SEL_HIST_OFF) + F.wave * 512;
    LAS unsigned* cand = (LAS unsigned*)(F.lds + SEL_CAND_OFF);
    LAS unsigned long long* stage = (LAS unsigned long long*)(F.lds + SEL_STAGE_OFF);
    const int lane = F.lane, c32 = lane & 31, hi = lane >> 5;
    const size_t tok0 = (size_t)b * SEQ + t0;
#ifndef IDX_REP_SCORE
#define IDX_REP_SCORE 1
#endif
#ifndef IDX_REP_SEL
#define IDX_REP_SEL 1
#endif
    for (int rep_ = 0; rep_ < IDX_REP_SCORE; ++rep_) {
        bf16x8 qf[2][4]; f32x4 wv[2][2][2];
        const int tl = 2 * ((c32 >> 2) & 1) + (c32 >> 4), hd = ((c32 >> 3) & 1) * 4 + (c32 & 3);
#pragma unroll
        for (int R = 0; R < 2; ++R) {
            const bf16* qp = QI + (tok0 + 4 * R + tl) * 512 + hd * 64 + 8 * hi;
#pragma unroll
            for (int ks = 0; ks < 4; ++ks) qf[R][ks] = *(const bf16x8*)(qp + 16 * ks);
#pragma unroll
            for (int tt = 0; tt < 2; ++tt) { const float* wp = WI + (tok0 + 4 * R + 2 * hi + tt) * 8; wv[R][tt][0] = *(const f32x4*)wp; wv[R][tt][1] = *(const f32x4*)(wp + 4); }
        }
        const int nkt = (t0 + 8 + 31) >> 5;
        bf16x8 kf[4];
        const bf16* kbase = KI + ((size_t)b * SEQ + c32) * 64 + 8 * hi;
        int kt = F.wave;
        if (kt < nkt) {
#pragma unroll
            for (int ks = 0; ks < 4; ++ks) kf[ks] = *(const bf16x8*)(kbase + (size_t)kt * 32 * 64 + 16 * ks);
        }
        for (; kt < nkt; kt += NWAVES) {
            bf16x8 kc[4];
#pragma unroll
            for (int ks = 0; ks < 4; ++ks) kc[ks] = kf[ks];
            if (kt + NWAVES < nkt) {
#pragma unroll
                for (int ks = 0; ks < 4; ++ks) kf[ks] = *(const bf16x8*)(kbase + (size_t)(kt + NWAVES) * 32 * 64 + 16 * ks);
            }
#pragma unroll
            for (int R = 0; R < 2; ++R) {
                f32x16 acc = {};
#pragma unroll
                for (int ks = 0; ks < 4; ++ks) acc = MFMA32(qf[R][ks], kc[ks], acc);
#pragma unroll
                for (int tt = 0; tt < 2; ++tt) {
                    float s = 0.f;
#pragma unroll
                    for (int i = 0; i < 8; ++i) s += wv[R][tt][i >> 2][i & 3] * fmaxf(acc[8 * tt + i], 0.f);
                    sc[(4 * R + 2 * hi + tt) * 4096 + kt * 32 + c32] = s;
                }
            }
        }
    }
    __syncthreads();
    for (int rep_ = 0; rep_ < IDX_REP_SEL; ++rep_) {
        const int t = t0 + F.wave, n = t + 1;
        const LAS float* scq = sc + F.wave * 4096;
        unsigned long long myword = 0ull;
        bool done = false;
        if (n <= 256) {
            const int j = lane; const int rem = n - 64 * j;
            myword = rem >= 64 ? ~0ull : (rem > 0 ? ((1ull << rem) - 1ull) : 0ull);
            done = true;
        } else {
            float lo = INFINITY, hi = -INFINITY;
            for (int i = 0; i * 256 < n; ++i) { const int idx = 4 * (lane + 64 * i); const f32x4 v = *(const LAS f32x4*)(scq + idx);
#pragma unroll
                for (int e = 0; e < 4; ++e) if (idx + e < n) { lo = fminf(lo, v[e]); hi = fmaxf(hi, v[e]); } }
#pragma unroll
            for (int o = 1; o < 64; o <<= 1) { lo = fminf(lo, __shfl_xor(lo, o)); hi = fmaxf(hi, __shfl_xor(hi, o)); }
            if (hi > lo) {
                const float scale = 512.0f / (hi - lo);
                *(LAS v4u*)(hist + 8 * lane) = (v4u){0u, 0u, 0u, 0u}; *(LAS v4u*)(hist + 8 * lane + 4) = (v4u){0u, 0u, 0u, 0u};
                LDS_WAIT(); asm volatile("" ::: "memory");
                for (int i = 0; i * 256 < n; ++i) { const int idx = 4 * (lane + 64 * i); const f32x4 v = *(const LAS f32x4*)(scq + idx);
#pragma unroll
                    for (int e = 0; e < 4; ++e) if (idx + e < n) { const int bn = min(511, (int)((v[e] - lo) * scale));
                        __hip_atomic_fetch_add(hist + bn, 1u, __ATOMIC_RELAXED, __HIP_MEMORY_SCOPE_WORKGROUP); } }
                LDS_WAIT(); asm volatile("" ::: "memory");
                const v4u c0 = *(const LAS v4u*)(hist + 8 * lane), c1 = *(const LAS v4u*)(hist + 8 * lane + 4);
                unsigned cc[8] = {c0.x, c0.y, c0.z, c0.w, c1.x, c1.y, c1.z, c1.w};
                const unsigned ls = ((c0.x + c0.y) + (c0.z + c0.w)) + ((c1.x + c1.y) + (c1.z + c1.w));
                unsigned inc = ls;
#pragma unroll
                for (int o = 1; o < 64; o <<= 1) { const unsigned v = __shfl_up(inc, o); if (lane >= o) inc += v; }
                const unsigned total = __shfl(inc, 63);
                const unsigned S = total - inc;
                const bool found = (S < 256u) && (256u <= S + ls);
                unsigned acc = S; int bin = 0; unsigned above = S; bool got = false;
#pragma unroll
                for (int q = 7; q >= 0; --q) { if (!got) { if (acc + cc[q] >= 256u) { bin = q; above = acc; got = true; } else acc += cc[q]; } }
                const unsigned long long fm = __ballot(found);
                const int src = fm ? (__ffsll((long long)fm) - 1) : 0;
                const int B = __shfl(8 * lane + bin, src); const unsigned aboveb = __shfl(above, src);
                const unsigned mB = __shfl(cc[0] * 0u + ((bin == 0) ? cc[0] : (bin == 1) ? cc[1] : (bin == 2) ? cc[2] : (bin == 3) ? cc[3] : (bin == 4) ? cc[4] : (bin == 5) ? cc[5] : (bin == 6) ? cc[6] : cc[7]), src);
                const unsigned kk2 = 256u - aboveb;
                if (mB <= 64u) {
                    LAS unsigned* ckey = cand + F.wave * 128; LAS unsigned* cidx = ckey + 64;
                    unsigned base = 0u;
                    for (int j = 0; 64 * j < n; ++j) {
                        const int sidx = 64 * j + lane; const bool v = sidx < n; const float x = scq[sidx];
                        const int bn = min(511, (int)((x - lo) * scale));
                        const bool gt = v && bn > B, eq = v && bn == B;
                        const unsigned long long wj = __ballot(gt), em = __ballot(eq);
                        if (eq) { const unsigned pos = base + (unsigned)__popcll(em & ((1ull << lane) - 1ull)); ckey[pos] = ordkey(x); cidx[pos] = (unsigned)sidx; }
                        base += (unsigned)__popcll(em);
                        if (lane == j) myword = wj;
                    }
                    stage[F.wave * 64 + lane] = myword;
                    LDS_WAIT(); asm volatile("" ::: "memory");
                    const unsigned m = base;
                    const unsigned mykey = (unsigned)lane < m ? ckey[lane] : 0u, myidx = (unsigned)lane < m ? cidx[lane] : 0u;
                    unsigned rank = 0u;
                    for (unsigned f = 0; f < m; ++f) { const unsigned kf = ckey[f]; rank += (kf > mykey || (kf == mykey && f < (unsigned)lane)) ? 1u : 0u; }
                    if ((unsigned)lane < m && rank < kk2)
                        __hip_atomic_fetch_or((LAS unsigned*)stage + F.wave * 128 + (myidx >> 5), 1u << (myidx & 31u), __ATOMIC_RELAXED, __HIP_MEMORY_SCOPE_WORKGROUP);
                    done = true;
                }
            }
        }
        if (!done) {
            unsigned T = 0u; int kk = 256; unsigned prefix = 0u;
#pragma unroll
            for (int pass = 0; pass < 4; ++pass) {
                const int shift = 24 - 8 * pass;
                *(LAS v4u*)(hist + 4 * lane) = (v4u){0u, 0u, 0u, 0u};
                LDS_WAIT(); asm volatile("" ::: "memory");
                for (int s2 = lane; s2 < n; s2 += 64) {
                    const unsigned key = ordkey(scq[s2]);
                    const bool in = (pass == 0) ? true : ((key >> ((shift + 8) & 31)) == prefix);
                    if (in) __hip_atomic_fetch_add(hist + ((key >> shift) & 255u), 1u, __ATOMIC_RELAXED, __HIP_MEMORY_SCOPE_WORKGROUP);
                }
                LDS_WAIT(); asm volatile("" ::: "memory");
                const v4u c = *(const LAS v4u*)(hist + 4 * lane);
                const unsigned ls = c.x + c.y + c.z + c.w;
                unsigned inc = ls;
#pragma unroll
                for (int o = 1; o < 64; o <<= 1) { const unsigned v = __shfl_up(inc, o); if (lane >= o) inc += v; }
                const unsigned total = __shfl(inc, 63);
                const unsigned S = total - inc;
                const bool found = (S < (unsigned)kk) && ((unsigned)kk <= S + ls);
                unsigned acc = S; int bin; unsigned above;
                if (acc + c.w >= (unsigned)kk) { bin = 3; above = acc; }
                else { acc += c.w; if (acc + c.z >= (unsigned)kk) { bin = 2; above = acc; }
                else { acc += c.z; if (acc + c.y >= (unsigned)kk) { bin = 1; above = acc; }
                else { acc += c.y; bin = 0; above = acc; } } }
                const unsigned long long fm = __ballot(found);
                const int src = fm ? (__ffsll((long long)fm) - 1) : 0;
                const int binb = __shfl(4 * lane + bin, src); const unsigned aboveb = __shfl(above, src);
                prefix = (prefix << 8) | (unsigned)binb; kk -= (int)aboveb;
            }
            T = prefix;
            unsigned taken = 0u; myword = 0ull;
            for (int j = 0; 64 * j < n; ++j) {
                const int s2 = 64 * j + lane; const bool v = s2 < n;
                const unsigned key = v ? ordkey(scq[s2]) : 0u;
                const bool gt = v && key > T, eq = v && key == T;
                const unsigned long long em = __ballot(eq);
                const unsigned rank = taken + (unsigned)__popcll(em & ((1ull << lane) - 1ull));
                const bool sel = gt || (eq && rank < (unsigned)kk);
                taken += (unsigned)__popcll(em);
                const unsigned long long w = __ballot(sel);
                if (lane == j) myword = w;
            }
            stage[F.wave * 64 + lane] = myword;
        } else if (n <= 256) stage[F.wave * 64 + lane] = myword;
    }
    __syncthreads();
    { const int j = F.tid >> 3, tq = F.tid & 7; maskw[((size_t)b * 64 + j) * 4096 + t0 + tq] = stage[tq * 64 + j]; }
}
__device__ __forceinline__ void p_index(Frame& F, const bf16* QI, const bf16* KI, const float* WI, unsigned long long* maskw) {
    for (int L = F.vcu; L < 4096; L += F.G) {
        const int i = L >> 8, v = L & 255, b = i >> 1, tt = (i & 1) ? 511 - v : v;
        index_tile(F, b, tt * 8, QI, KI, WI, maskw);
    }
}

__device__ __forceinline__ float mask_sel(float p, unsigned bits, int c) {
    const unsigned m = (unsigned)__builtin_amdgcn_sbfe((int)bits, (unsigned)c, 1u);
    return __uint_as_float((m & __float_as_uint(p)) | (~m & 0xff800000u));
}
__device__ __forceinline__ void attnB_unit(Frame& F, int b, int kvh, int blkq, const bf16* Q, const bf16* K, const bf16* V, const bf16* G, const unsigned long long* maskw, bf16* Z) {
    const int lane = F.lane, q32 = lane & 31, hi = lane >> 5, w = F.wave;
    const int head = 4 * kvh + (w >> 1), tok = blkq * 64 + 32 * (w & 1) + q32;
    const size_t grow = (size_t)b * SEQ + tok;
    const int NT = blkq + 1;
    bf16x8 qf[4];
    { const bf16* qrow = Q + grow * 1024 + head * 64 + 8 * hi;
#pragma unroll
      for (int ks = 0; ks < 4; ++ks) qf[ks] = *(const bf16x8*)(qrow + 16 * ks); }
    LAS unsigned char* Kb = F.lds; LAS unsigned char* Vb = F.lds + 16384;
    const int srow = F.tid >> 3, sch = F.tid & 7;
    const bf16* ksrc = K + ((size_t)b * SEQ + srow) * 256 + kvh * 64 + 8 * sch;
    const bf16* vsrc = V + ((size_t)b * SEQ + srow) * 256 + kvh * 64 + 8 * sch;
    const unsigned long long* mp = maskw + (size_t)b * 64 * 4096 + tok;
    v4u kreg = *(const v4u*)ksrc, vreg = *(const v4u*)vsrc;
    unsigned long long mw_next = mp[0];
    *(LAS v4u*)(Kb + kimg(srow, sch)) = kreg; *(LAS v4u*)(Vb + vimg(srow, sch)) = vreg;
    __syncthreads();
    f32x16 o0 = {}, o1 = {}, ol = {}, negm = {};
    const short one = (q32 == 0) ? (short)0x3F80 : (short)0;
    const bf16x8 ones = (bf16x8){one, one, one, one, one, one, one, one};
    const int q4 = (lane & 15) >> 2, blk = (lane >> 4) & 1, p4 = lane & 3;
    const unsigned koff0 = kimg(q32, hi), voff0 = vimg(4 * hi + q4, 2 * blk + (p4 >> 1)) + 8 * (p4 & 1);
    for (int j = 0; j < NT; ++j) {
        const unsigned long long mw = mw_next;
        if (j + 1 < NT) { kreg = *(const v4u*)(ksrc + (size_t)(j + 1) * 64 * 256); vreg = *(const v4u*)(vsrc + (size_t)(j + 1) * 64 * 256); mw_next = mp[(size_t)(j + 1) * 4096]; }
        const LAS unsigned char* Kc = Kb + (j & 1) * 8192; const LAS unsigned char* Vc = Vb + (j & 1) * 8192;
        f32x16 p0 = negm, p1 = negm;
#pragma unroll
        for (int ks = 0; ks < 4; ++ks) {
            const bf16x8 ka = *(const LAS bf16x8*)(Kc + kimg(q32, 2 * ks + hi)), kb2 = *(const LAS bf16x8*)(Kc + kimg(32 + q32, 2 * ks + hi));
            p0 = MFMA32(ka, qf[ks], p0); p1 = MFMA32(kb2, qf[ks], p1);
        }
        const unsigned b0 = (unsigned)mw >> (4 * hi), b1 = (unsigned)(mw >> 32) >> (4 * hi);
#pragma unroll
        for (int r = 0; r < 16; ++r) { p0[r] = mask_sel(p0[r], b0, (r & 3) + 8 * (r >> 2)); p1[r] = mask_sel(p1[r], b1, (r & 3) + 8 * (r >> 2)); }
        float rm = fmaxf(p0[0], p1[0]);
#pragma unroll
        for (int r = 1; r < 16; ++r) rm = fmaxf(fmaxf(rm, p0[r]), p1[r]);
        rm = swap_max(rm);
        if (j == 0 || __any(rm > 8.0f)) {
            const float delta = (j == 0) ? ((rm > -INFINITY) ? rm : 0.f) : fmaxf(rm, 0.f);
#pragma unroll
            for (int r = 0; r < 16; ++r) { p0[r] -= delta; p1[r] -= delta; negm[r] -= delta; }
            if (j != 0) { const float alpha = __builtin_amdgcn_exp2f(-delta);
#pragma unroll
                for (int r = 0; r < 16; ++r) { o0[r] *= alpha; o1[r] *= alpha; ol[r] *= alpha; } }
        }
#pragma unroll
        for (int r = 0; r < 16; ++r) { p0[r] = __builtin_amdgcn_exp2f(p0[r]); p1[r] = __builtin_amdgcn_exp2f(p1[r]); }
        bf16x8 pf[4];
#pragma unroll
        for (int ks = 0; ks < 2; ++ks) {
            v4u wa, wb;
            wa.x = cvtpk(p0[8 * ks + 0], p0[8 * ks + 1]); wa.y = cvtpk(p0[8 * ks + 2], p0[8 * ks + 3]); wa.z = cvtpk(p0[8 * ks + 4], p0[8 * ks + 5]); wa.w = cvtpk(p0[8 * ks + 6], p0[8 * ks + 7]);
            wb.x = cvtpk(p1[8 * ks + 0], p1[8 * ks + 1]); wb.y = cvtpk(p1[8 * ks + 2], p1[8 * ks + 3]); wb.z = cvtpk(p1[8 * ks + 4], p1[8 * ks + 5]); wb.w = cvtpk(p1[8 * ks + 6], p1[8 * ks + 7]);
            pf[ks] = __builtin_bit_cast(bf16x8, wa); pf[2 + ks] = __builtin_bit_cast(bf16x8, wb);
        }
#pragma unroll
        for (int kq = 0; kq < 4; ++kq) {
#pragma unroll
            for (int d0 = 0; d0 < 2; ++d0) {
                const s16x4 lo = vtr(Vc + vimg(16 * kq + 4 * hi + q4, 4 * d0 + 2 * blk + (p4 >> 1)) + 8 * (p4 & 1));
                const s16x4 up = vtr(Vc + vimg(16 * kq + 8 + 4 * hi + q4, 4 * d0 + 2 * blk + (p4 >> 1)) + 8 * (p4 & 1));
                const bf16x8 vf = (bf16x8){lo[0], lo[1], lo[2], lo[3], up[0], up[1], up[2], up[3]};
                if (d0 == 0) o0 = MFMA32(vf, pf[kq], o0); else o1 = MFMA32(vf, pf[kq], o1);
            }
            ol = MFMA32(ones, pf[kq], ol);
        }
        if (j + 1 < NT) { *(LAS v4u*)(Kb + ((j + 1) & 1) * 8192 + kimg(srow, sch)) = kreg; *(LAS v4u*)(Vb + ((j + 1) & 1) * 8192 + vimg(srow, sch)) = vreg; }
        __syncthreads();
    }
    (void)koff0; (void)voff0;
    const float l_tot = swap_sum(ol[0]), inv = 1.0f / l_tot;
    const bf16* grow_p = G + grow * 1024 + head * 64;
    bf16* zrow = Z + grow * 1024 + head * 64;
#pragma unroll
    for (int g4 = 0; g4 < 4; ++g4) {
        const u32x2 ga = *(const u32x2*)(grow_p + 8 * g4 + 4 * hi), gb = *(const u32x2*)(grow_p + 32 + 8 * g4 + 4 * hi);
        *(u32x2*)(zrow + 8 * g4 + 4 * hi) = (u32x2){cvtpk(o0[4 * g4] * inv * bf_lo(ga.x), o0[4 * g4 + 1] * inv * bf_hi(ga.x)), cvtpk(o0[4 * g4 + 2] * inv * bf_lo(ga.y), o0[4 * g4 + 3] * inv * bf_hi(ga.y))};
        *(u32x2*)(zrow + 32 + 8 * g4 + 4 * hi) = (u32x2){cvtpk(o1[4 * g4] * inv * bf_lo(gb.x), o1[4 * g4 + 1] * inv * bf_hi(gb.x)), cvtpk(o1[4 * g4 + 2] * inv * bf_lo(gb.y), o1[4 * g4 + 3] * inv * bf_hi(gb.y))};
    }
}
__device__ __forceinline__ void p_attnB(Frame& F, const bf16* Q, const bf16* K, const bf16* V, const bf16* G, const unsigned long long* maskw, bf16* Z) {
    for (int L = F.vcu; L < 2048; L += F.G) {
        const int i = L >> 8, v = L & 255, bh = v >> 3, s = v & 7;
        const int blkq = 16 * (i >> 1) + ((i & 1) ? 15 - s : s);
        attnB_unit(F, bh >> 2, bh & 3, blkq, Q, K, V, G, maskw, Z);
    }
}

__device__ __forceinline__ cargs_t fresh_args() { cargs_t p = (cargs_t)__builtin_amdgcn_kernarg_segment_ptr(); asm volatile("" : "+s"(p)); return p; }
__global__ void __launch_bounds__(NWAVES * 64, 2) trunk_fwd(Args args_unused) {
    extern __shared__ __attribute__((aligned(16))) unsigned char lds[];
    Frame F;
    F.lds = (LAS unsigned char*)lds;
    F.MISC = (volatile LAS unsigned*)(F.lds + MISC_OFF);
    F.tid = threadIdx.x; F.lane = F.tid & 63; F.wave = __builtin_amdgcn_readfirstlane(F.tid >> 6);
    F.G = gridDim.x; F.bx = blockIdx.x; { const int bx = blockIdx.x; F.vcu = (F.G % 8 == 0) ? (bx % 8) * (F.G / 8) + bx / 8 : bx; }
    F.ctl = (gu32*)(fresh_args()->ws + WS_CTL);
    if (F.tid < 64) ((LAS unsigned*)(F.lds + MISC_OFF))[F.tid] = 0u;
    __syncthreads();
#if MK_ONE_LAUNCH
    XcdBarrier bar = xcd_barrier_post((unsigned*)(F.ctl + CW_BAR), F.MISC + 8);
#define SEAM() do { XcdBarrier b_ = bar; asm volatile("" : "+s"(b_.bar), "+s"(b_.x)); xcd_barrier(b_); } while (0)
#define RUN 1
#else
    int seam = 0; const int seg = fresh_args()->seg;
#define SEAM() (++seam)
#define RUN (seam == seg)
#endif
#define WSP(off) (A_->ws + (off))
#define FRESH_F() Frame Fp = F; { int t_ = threadIdx.x; asm volatile("" : "+v"(t_)); Fp.tid = t_; Fp.lane = t_ & 63; Fp.wave = __builtin_amdgcn_readfirstlane(t_ >> 6); asm volatile("" : "+s"(Fp.vcu), "+s"(Fp.G), "+s"(Fp.bx)); }
    if (DUP(0)) { { cargs_t A_ = fresh_args(); FRESH_F(); p_prologue(Fp, A_); } SEAM(); }
    if (P_ON(0) && RUN) { cargs_t A_ = fresh_args(); FRESH_F(); p_prologue(Fp, A_); }
    SEAM();
    for (int lp = 0; lp < 2; ++lp) {
        {
            const int layer = 2 * lp;
            for (int rep_ = 0; rep_ < 1 + DUP(1); ++rep_) { if (rep_) SEAM();
            if (P_ON(1) && RUN) { cargs_t A_ = fresh_args(); FRESH_F(); const float* hin = (layer == 0) ? A_->in[0] : A_->out;
                p_norm_mod(Fp, hin, A_->in[3] + (size_t)layer * 1024, (const float*)WSP(WS_MOD) + (size_t)layer * 8 * 3072, (bf16*)WSP(WS_U)); } }
            SEAM();
            for (int ch = 0; ch < NCHUNK; ++ch) {
                for (int rep_ = 0; rep_ < 1 + DUP(2); ++rep_) { if (rep_) SEAM();
                if (P_ON(2) && RUN) { cargs_t A_ = fresh_args();
                    pg8::Gemm g{(bf16*)WSP(WS_U) + (size_t)ch * MC * 1024, (bf16*)WSP(WS_WA) + (size_t)lp * A_N * 1024, MC, A_N, 1024};
                    pg8::StaticOrder S; { int g_ = F.G, b_ = F.bx; asm volatile("" : "+s"(g_), "+s"(b_)); S.init(MC, A_N, g_, b_); }
                    pg8::EpiA E{A_->ws, ch * MC};
                    pg8::gemm_phase<pg8::EpiA, pg8::StaticOrder, true, true>(F.lds, g, S, E);
                } }
                SEAM();
                if (DUP(3)) { { cargs_t A_ = fresh_args(); FRESH_F(); p_attnA(Fp, (bf16*)WSP(WS_ACT), (float*)WSP(WS_LSE), (bf16*)WSP(WS_END_A)); } SEAM(); }
                if (P_ON(3) && RUN) { cargs_t A_ = fresh_args(); FRESH_F(); p_attnA(Fp, (bf16*)WSP(WS_ACT), (float*)WSP(WS_LSE), nullptr); }
                SEAM();
                if (DUP(4)) { { cargs_t A_ = fresh_args(); FRESH_F(); p_mergeA(Fp, (const bf16*)WSP(WS_ACT), (const float*)WSP(WS_LSE), (bf16*)WSP(WS_U) + (size_t)ch * MC * 1024); } SEAM(); }
                if (P_ON(4) && RUN) { cargs_t A_ = fresh_args(); FRESH_F(); p_mergeA(Fp, (const bf16*)WSP(WS_ACT), (const float*)WSP(WS_LSE), (bf16*)WSP(WS_U) + (size_t)ch * MC * 1024); }
                SEAM();
            }
            for (int rep_ = 0; rep_ < 1 + ((DUP(5) && layer == 0) ? 1 : 0); ++rep_) { if (rep_) SEAM();
            if (P_ON(5) && RUN) { cargs_t A_ = fresh_args(); const float* hin = (layer == 0) ? A_->in[0] : A_->out;
                pg8::Gemm g{(bf16*)WSP(WS_U), (bf16*)WSP(WS_WO) + (size_t)layer * 1024 * 1024, MTOK, 1024, 1024};
                pg8::StaticOrder S; { int g_ = F.G, b_ = F.bx; asm volatile("" : "+s"(g_), "+s"(b_)); S.init(MTOK, 1024, g_, b_); }
                pg8::EpiOut E{hin, A_->out, (const float*)WSP(WS_MOD) + (size_t)layer * 8 * 3072 + 2048};
                pg8::gemm_phase<pg8::EpiOut, pg8::StaticOrder, true, true>(F.lds, g, S, E);
            } }
            SEAM();
        }
        {
            const int layer = 2 * lp + 1;
            if (P_ON(6) && RUN) { cargs_t A_ = fresh_args(); FRESH_F();
                p_norm_mod(Fp, A_->out, A_->in[3] + (size_t)layer * 1024, (const float*)WSP(WS_MOD) + (size_t)layer * 8 * 3072, (bf16*)WSP(WS_U)); }
            SEAM();
            for (int rep_ = 0; rep_ < 1 + DUP(7); ++rep_) { if (rep_) SEAM();
            if (P_ON(7) && RUN) { cargs_t A_ = fresh_args();
                pg8::Gemm g{(bf16*)WSP(WS_U), (bf16*)WSP(WS_WB) + (size_t)lp * B_NP * 1024, MTOK, B_NP, 1024};
                pg8::StaticOrder S; { int g_ = F.G, b_ = F.bx; asm volatile("" : "+s"(g_), "+s"(b_)); S.init(MTOK, B_NP, g_, b_); }
                pg8::EpiB E{A_->ws};
                pg8::gemm_phase<pg8::EpiB, pg8::StaticOrder, true, true>(F.lds, g, S, E);
            } }
            SEAM();
            if (DUP(8)) { { cargs_t A_ = fresh_args(); FRESH_F(); p_index(Fp, (const bf16*)WSP(WS_BQI), (const bf16*)WSP(WS_BKI), (const float*)WSP(WS_BWI), (unsigned long long*)WSP(WS_BMASK)); } SEAM(); }
            if (P_ON(8) && RUN) { cargs_t A_ = fresh_args(); FRESH_F(); p_index(Fp, (const bf16*)WSP(WS_BQI), (const bf16*)WSP(WS_BKI), (const float*)WSP(WS_BWI), (unsigned long long*)WSP(WS_BMASK)); }
            SEAM();
            if (DUP(9)) { { cargs_t A_ = fresh_args(); FRESH_F(); p_attnB(Fp, (const bf16*)WSP(WS_BQ), (const bf16*)WSP(WS_BK), (const bf16*)WSP(WS_BV), (const bf16*)WSP(WS_BG), (const unsigned long long*)WSP(WS_BMASK), (bf16*)WSP(WS_U)); } SEAM(); }
            if (P_ON(9) && RUN) { cargs_t A_ = fresh_args(); FRESH_F(); p_attnB(Fp, (const bf16*)WSP(WS_BQ), (const bf16*)WSP(WS_BK), (const bf16*)WSP(WS_BV), (const bf16*)WSP(WS_BG), (const unsigned long long*)WSP(WS_BMASK), (bf16*)WSP(WS_U)); }
            SEAM();
            if (P_ON(10) && RUN) { cargs_t A_ = fresh_args();
                pg8::Gemm g{(bf16*)WSP(WS_U), (bf16*)WSP(WS_WO) + (size_t)layer * 1024 * 1024, MTOK, 1024, 1024};
                pg8::StaticOrder S; { int g_ = F.G, b_ = F.bx; asm volatile("" : "+s"(g_), "+s"(b_)); S.init(MTOK, 1024, g_, b_); }
                pg8::EpiOut E{A_->out, A_->out, (const float*)WSP(WS_MOD) + (size_t)layer * 8 * 3072 + 2048};
                pg8::gemm_phase<pg8::EpiOut, pg8::StaticOrder, true, true>(F.lds, g, S, E);
            }
            SEAM();
        }
    }
    if (P_ON(11) && RUN) { cargs_t A_ = fresh_args(); FRESH_F(); p_final_norm(Fp, A_->out, A_->in[10], A_->out); }
}

extern "C" void kernel_launch(void* const* d_in, const int* in_sizes, int n_in, void* d_out, int out_size, void* d_ws, size_t ws_size, hipStream_t stream) {
    static int grid = 0;
    if (grid == 0) {
        if (n_in != 11 || in_sizes[0] != MTOK * DM || out_size != MTOK * DM || ws_size < WS_NEED) {
            fprintf(stderr, "kernel_launch: unexpected shapes / workspace (n_in %d, in0 %d, out %d, ws %zu, need %zu); nothing launched\n", n_in, n_in > 0 ? in_sizes[0] : -1, out_size, ws_size, (size_t)WS_NEED); grid = -1; return; }
        int dev = 0, cus = 0, per_cu = 0;
        if (hipGetDevice(&dev) != hipSuccess || hipDeviceGetAttribute(&cus, hipDeviceAttributeMultiprocessorCount, dev) != hipSuccess) { fprintf(stderr, "kernel_launch: device query failed\n"); grid = -1; return; }
        if (hipFuncSetAttribute((const void*)trunk_fwd, hipFuncAttributeMaxDynamicSharedMemorySize, LDS_BYTES) != hipSuccess) { fprintf(stderr, "kernel_launch: hipFuncSetAttribute failed\n"); grid = -1; return; }
        if (hipOccupancyMaxActiveBlocksPerMultiprocessor(&per_cu, (const void*)trunk_fwd, NWAVES * 64, LDS_BYTES) != hipSuccess || per_cu < 1)
            fprintf(stderr, "kernel_launch: note: occupancy query reports %d workgroups per CU\n", per_cu);
        (void)hipGetLastError();
        grid = cus;
    }
    if (grid < 0) return;
    if (hipMemsetAsync((char*)d_ws + WS_CTL, 0, CTL_ZERO_BYTES, stream) != hipSuccess) { fprintf(stderr, "kernel_launch: memset failed\n"); return; }
    Args a{};
    for (int i = 0; i < 11; ++i) a.in[i] = (const float*)d_in[i];
    a.pos = (const int*)d_in[2]; a.out = (float*)d_out; a.ws = (unsigned char*)d_ws; a.seg = 0; a.pad = 0;
#if MK_ONE_LAUNCH
    hipLaunchKernelGGL(trunk_fwd, dim3(grid), dim3(NWAVES * 64), LDS_BYTES, stream, a);
#else
    for (int s = 0; s <= N_SEAMS; ++s) { a.seg = s; hipLaunchKernelGGL(trunk_fwd, dim3(grid), dim3(NWAVES * 64), LDS_BYTES, stream, a); }
#endif
    const hipError_t le = hipPeekAtLastError();
    if (le != hipSuccess) fprintf(stderr, "kernel_launch: launch failed: %s\n", hipGetErrorName(le));
}
```

```cpp
#include <hip/hip_runtime.h>
#include <cstdio>
#include <cstdint>
#include <cmath>
constexpr int NWAVES = 8;
constexpr int NB = 8, SEQ = 4096, DM = 1024, MTOK = NB * SEQ;
constexpr int A_N = 10240, B_NL = 3144, B_NP = 3328;
constexpr int MC = 8192, NCHUNK = MTOK / MC;
constexpr float NORM_EPS = 1e-6f;
#ifndef PMASK
#define PMASK 0xffff
#endif
#define P_ON(k) ((PMASK >> (k)) & 1)
#ifndef DUPMASK
#define DUPMASK 0
#endif
#define DUP(k) ((DUPMASK >> (k)) & 1)
#ifndef MK_ONE_LAUNCH
#define MK_ONE_LAUNCH 1
#endif
constexpr int N_SEAMS = 1 + 2 * ((1 + 3 * NCHUNK + 1) + 5);

constexpr size_t MiB = 1u << 20;
constexpr size_t WS_CTL = 0, CTL_ZERO_BYTES = 1 * MiB;
constexpr size_t WS_MOD = 1 * MiB;
constexpr size_t WS_COS = 2 * MiB, WS_SIN = 6 * MiB;
constexpr size_t WS_WA = 10 * MiB;
constexpr size_t WS_WB = 50 * MiB;
constexpr size_t WS_WO = 63 * MiB;
constexpr size_t WS_U = 72 * MiB;
constexpr size_t WS_ACT = 136 * MiB;
constexpr size_t A_SUB = (size_t)MC * 1024 * 2;
constexpr size_t WS_LSE = WS_ACT + 10 * A_SUB;
constexpr size_t WS_END_A = WS_LSE + (size_t)3 * MC * 16 * 4;
constexpr size_t WS_BQ = WS_ACT, WS_BK = WS_BQ + 64 * MiB, WS_BV = WS_BK + 16 * MiB, WS_BQI = WS_BV + 16 * MiB, WS_BKI = WS_BQI + 32 * MiB,
                 WS_BWI = WS_BKI + 4 * MiB, WS_BG = WS_BWI + 2 * MiB, WS_BMASK = WS_BG + 64 * MiB, WS_END_B = WS_BMASK + 16 * MiB;
constexpr size_t WS_NEED = (WS_END_A > WS_END_B ? WS_END_A : WS_END_B);
static_assert(WS_WA + (size_t)2 * A_N * 1024 * 2 <= WS_WB && WS_WB + (size_t)2 * B_NP * 1024 * 2 <= WS_WO && WS_WO + (size_t)4 * 1024 * 1024 * 2 <= WS_U && WS_U + (size_t)MTOK * 1024 * 2 <= WS_ACT, "ws map");
constexpr int CW_BAR = 4096;

namespace pg8 {
#define PG8_LAS __attribute__((address_space(3)))
typedef unsigned short bf16_t;
typedef short bf16x8 __attribute__((ext_vector_type(8)));
typedef float f32x4 __attribute__((ext_vector_type(4)));
typedef unsigned u32x4 __attribute__((ext_vector_type(4)));
constexpr int BM = 256, BK = 64, HALF = 128, HTB = HALF * BK * 2  , STAGE_BYTES = 8 * HTB, NXCD = 8, WGM = 8;

__host__ __device__ __forceinline__ int lds_byte(int r, int c) { const int st = (r >> 4) * 2 + (c >> 5), rr = r & 15, cc = c & 31, ob = rr * 64 + cc * 2; return st * 1024 + (ob ^ (((ob >> 9) & 1) << 5)); }
__host__ __device__ __forceinline__ void stage_rc(int b, int& R, int& C) { const int st = b / 1024, sb = b % 1024, swz = sb ^ (((sb >> 9) & 1) << 5); R = (st >> 1) * 16 + swz / 64; C = (st & 1) * 32 + (swz % 64) / 2; }
__host__ __device__ __forceinline__ int perm32(int rho) { const int n = rho >> 4, i = rho & 15; return 8 * (i >> 2) + 4 * n + (i & 3); }

struct Unit { int pm, pn; };
struct Gemm { const bf16_t* A; const bf16_t* Bt; int M, N, K; };

struct StaticOrder {
    int nM, nN, nwg, G, c;
    __host__ __device__ void init(int M, int N, int G_, int c_) { nM = M / BM; nN = N / BM; nwg = nM * nN; G = G_; c = c_; }
    __host__ __device__ bool next(int i, Unit& u) const {
        const long L = (long)i * G + c; if (L >= nwg) return false;
        int wgid = (int)L; { const int q = nwg / NXCD, r = nwg % NXCD, xcd = wgid % NXCD, off = wgid / NXCD; wgid = (xcd < r ? xcd * (q + 1) : r * (q + 1) + (xcd - r) * q) + off; }
        const int nig = WGM * nN, gid = wgid / nig, fm = gid * WGM, gsz = (nM - fm) < WGM ? (nM - fm) : WGM;
        u.pm = fm + ((wgid % nig) % gsz); u.pn = (wgid % nig) / gsz; return true;
    }
    __device__ __forceinline__ void a_ready(const Unit&) const {}
    __device__ __forceinline__ void done(const Unit&) const {}
};

__device__ __forceinline__ unsigned cvt_pk_bf16(float lo, float hi) { unsigned r; asm volatile("v_cvt_pk_bf16_f32 %0, %1, %2" : "=v"(r) : "v"(lo), "v"(hi)); return r; }
typedef float f32x2 __attribute__((ext_vector_type(2)));
constexpr float C2F = 0.125f * 1.4426950408889634f;
constexpr float WSC = 0.35355339059327373f * 0.125f;
__device__ __forceinline__ float silu_f(float x) { return x * __builtin_amdgcn_rcpf(1.0f + __builtin_amdgcn_exp2f(-1.4426950408889634f * x)); }
__device__ __forceinline__ f32x4 silu4(f32x4 v) { return (f32x4){silu_f(v[0]), silu_f(v[1]), silu_f(v[2]), silu_f(v[3])}; }
__device__ __forceinline__ u32x4 pack8(f32x4 a, f32x4 b) { u32x4 w; w.x = cvt_pk_bf16(a[0], a[1]); w.y = cvt_pk_bf16(a[2], a[3]); w.z = cvt_pk_bf16(b[0], b[1]); w.w = cvt_pk_bf16(b[2], b[3]); return w; }

__device__ __forceinline__ void epi_store_rows(const f32x4 (&acc)[2][2][4][2], int kind, bf16_t* ob, int pitch, int row0, int col0, int j0, const float* cs, const float* sn) {
#pragma unroll
    for (int ai = 0; ai < 2; ++ai) {
        f32x4 c4[8], s4[8];
        if (kind < 2) {
#pragma unroll
            for (int i = 0; i < 4; ++i) { const int row = row0 + ai * HALF + i * 16;
                c4[ai * 4 + i] = *(const f32x4*)(cs + (size_t)row * 32 + j0); s4[ai * 4 + i] = *(const f32x4*)(sn + (size_t)row * 32 + j0); }
        }
#pragma unroll
        for (int m = 0; m < 4; ++m) {
            const int row = row0 + ai * HALF + m * 16;
            bf16_t* rowp = ob + (size_t)row * pitch + col0;
#pragma unroll
            for (int bj = 0; bj < 2; ++bj) {
                f32x4 v0 = acc[ai][bj][m][0], v1 = acc[ai][bj][m][1];
                if (kind < 2) { const f32x4 o0 = v0 * c4[ai * 4 + m] - v1 * s4[ai * 4 + m], o1 = v1 * c4[ai * 4 + m] + v0 * s4[ai * 4 + m]; v0 = o0; v1 = o1; if (kind == 0) { v0 = v0 * C2F; v1 = v1 * C2F; } }
                else if (kind == 3) { v0 = silu4(v0); v1 = silu4(v1); }
                *(u32x4*)(rowp + bj * HALF) = pack8(v0, v1);
            }
        }
    }
}
struct EpiA {
    static constexpr bool PERM = true, AFTER_DRAIN = false;
    unsigned char* ws; int row_off;
    __device__ __forceinline__ void operator()(const f32x4 (&acc)[2][2][4][2], const Unit& u, int wr, int wc, int fr, int fq) const {
        asm volatile("" : "+v"(fr), "+v"(fq));
        const int t = u.pn >> 2, kind = (t == 9) ? 3 : (t % 3);
        const float* cs = (const float*)(ws + WS_COS) + (size_t)row_off * 32; const float* sn = (const float*)(ws + WS_SIN) + (size_t)row_off * 32;
        epi_store_rows(acc, kind, (bf16_t*)(ws + WS_ACT) + (size_t)t * (A_SUB / 2), 1024, u.pm * BM + wr * 64 + fr, (u.pn & 3) * BM + wc * 32 + 8 * fq, 16 * (wc & 1) + 4 * fq, cs, sn);
    }
};
struct EpiB {
    static constexpr bool PERM = true, AFTER_DRAIN = false;
    unsigned char* ws;
    __device__ __forceinline__ void operator()(const f32x4 (&acc)[2][2][4][2], const Unit& u, int wr, int wc, int fr, int fq) const {
        asm volatile("" : "+v"(fr), "+v"(fq));
        bf16_t* Q = (bf16_t*)(ws + WS_BQ); bf16_t* K = (bf16_t*)(ws + WS_BK); bf16_t* V = (bf16_t*)(ws + WS_BV); bf16_t* QI = (bf16_t*)(ws + WS_BQI); bf16_t* KI = (bf16_t*)(ws + WS_BKI); bf16_t* G = (bf16_t*)(ws + WS_BG);
        float* WI = (float*)(ws + WS_BWI); const float* cs = (const float*)(ws + WS_COS); const float* sn = (const float*)(ws + WS_SIN);
        const int pn = u.pn, row0 = u.pm * BM + wr * 64 + fr, cw = wc * 32 + 8 * fq, j0 = 16 * (wc & 1) + 4 * fq;
        if (pn < 4)       epi_store_rows(acc, 0, Q, 1024, row0, pn * BM + cw, j0, cs, sn);
        else if (pn == 4) epi_store_rows(acc, 1, K, 256, row0, cw, j0, cs, sn);
        else if (pn == 5) epi_store_rows(acc, 2, V, 256, row0, cw, j0, cs, sn);
        else if (pn < 8)  epi_store_rows(acc, 1, QI, 512, row0, (pn - 6) * BM + cw, j0, cs, sn);
        else if (pn > 8)  epi_store_rows(acc, 3, G, 1024, row0, (pn - 9) * BM + cw, j0, cs, sn);
        else {
#pragma unroll
            for (int ai = 0; ai < 2; ++ai)
#pragma unroll
                for (int m = 0; m < 4; ++m) {
                    const int row = row0 + ai * HALF + m * 16;
                    const f32x4 v0 = acc[ai][0][m][0], v1 = acc[ai][0][m][1];
                    if (wc < 2) {
                        const f32x4 c4 = *(const f32x4*)(cs + (size_t)row * 32 + j0), s4 = *(const f32x4*)(sn + (size_t)row * 32 + j0);
                        *(u32x4*)(KI + (size_t)row * 64 + cw) = pack8(v0 * c4 - v1 * s4, v1 * c4 + v0 * s4);
                    } else if (wc == 2 && fq == 0) {
                        *(f32x4*)(WI + (size_t)row * 8) = v0 * WSC; *(f32x4*)(WI + (size_t)row * 8 + 4) = v1 * WSC;
                    }
                }
        }
    }
};
struct EpiOut {
    static constexpr bool PERM = false, AFTER_DRAIN = false;
    const float* hin; float* hout; const float* gate;
    __device__ __forceinline__ void operator()(const f32x4 (&acc)[2][2][4][2], const Unit& u, int wr, int wc, int fr, int fq) const {
        asm volatile("" : "+v"(fr), "+v"(fq));
        const int col0 = u.pn * BM + wc * 32 + 4 * fq;
        const int b = (u.pm * BM) >> 12;
        f32x4 g4[2][2];
#pragma unroll
        for (int bj = 0; bj < 2; ++bj)
#pragma unroll
            for (int n = 0; n < 2; ++n) g4[bj][n] = *(const f32x4*)(gate + (size_t)b * 3072 + col0 + bj * HALF + n * 16);
#pragma unroll
        for (int ai = 0; ai < 2; ++ai) {
#pragma unroll
          for (int mh = 0; mh < 2; ++mh) {
            f32x4 h4[4][2][2];
#pragma unroll
            for (int m = 2 * mh; m < 2 * mh + 2; ++m) { const int row = u.pm * BM + ai * HALF + wr * 64 + m * 16 + fr;
#pragma unroll
                for (int bj = 0; bj < 2; ++bj)
#pragma unroll
                    for (int n = 0; n < 2; ++n) h4[m][bj][n] = *(const f32x4*)(hin + (size_t)row * 1024 + col0 + bj * HALF + n * 16); }
#pragma unroll
            for (int m = 2 * mh; m < 2 * mh + 2; ++m) { const int row = u.pm * BM + ai * HALF + wr * 64 + m * 16 + fr;
#pragma unroll
                for (int bj = 0; bj < 2; ++bj)
#pragma unroll
                    for (int n = 0; n < 2; ++n) *(f32x4*)(hout + (size_t)row * 1024 + col0 + bj * HALF + n * 16) = h4[m][bj][n] + g4[bj][n] * acc[ai][bj][m][n]; }
          }
        }
    }
};

template <class Epi, class Sched, bool ALIGN_EPI = false, bool SP2 = false>
__device__ __forceinline__ void gemm_phase(PG8_LAS unsigned char* lds, const Gemm g, const Sched& S, const Epi& E) {
    int tid_ = threadIdx.x; asm volatile("" : "+v"(tid_));
    const int tid = tid_, wid = __builtin_amdgcn_readfirstlane(tid >> 6), lane = tid & 63, wr = wid >> 2, wc = wid & 3, fr = lane & 15, fq = lane >> 4;
    const int K = g.K, nt = K / BK;
    unsigned voffA[2], voffB[2];
#pragma unroll
    for (int i = 0; i < 2; ++i) { int R, C; stage_rc(tid * 16 + i * 8192, R, C); const int Rb = Epi::PERM ? ((R & ~31) + perm32(R & 31)) : R;
        voffA[i] = (unsigned)(R * K + C) * 2u; voffB[i] = (unsigned)(Rb * K + C) * 2u; }
    const size_t kstep = (size_t)(BK * 2);
    const size_t hstep = (size_t)HALF * K * 2;
    const size_t tstep = 2 * hstep;
    const unsigned ldsw = (unsigned)wid * 1024u;
    const int aoff = lds_byte(wr * 64 + fr, fq * 8), boff = lds_byte(wc * 32 + fr, fq * 8);
#define PG8_SA(b, h) (((b) * 2 + (h)) * HTB)
#define PG8_SB(b, h) ((4 + (b) * 2 + (h)) * HTB)
#define PG8_STAGE(bufoff, gbase, voff) do { _Pragma("unroll") for (int _i = 0; _i < 2; ++_i) \
        __builtin_amdgcn_global_load_lds((const unsigned*)((const char*)(gbase) + (voff)[_i]), (PG8_LAS unsigned*)(lds + (bufoff) + ldsw + _i * 8192), 16, 0, 0); } while (0)
#define PG8_LDA(dst, b, h) do { _Pragma("unroll") for (int m = 0; m < 4; ++m) _Pragma("unroll") for (int k = 0; k < 2; ++k) dst[m][k] = *(const PG8_LAS bf16x8*)(lds + PG8_SA(b, h) + aoff + m * 2048 + k * 1024); } while (0)
#define PG8_LDB(dst, b, h) do { _Pragma("unroll") for (int n = 0; n < 2; ++n) _Pragma("unroll") for (int k = 0; k < 2; ++k) dst[n][k] = *(const PG8_LAS bf16x8*)(lds + PG8_SB(b, h) + boff + n * 2048 + k * 1024); } while (0)
#define PG8_MMA(ai, bj, At, Bt) do { __builtin_amdgcn_s_setprio(1); _Pragma("unroll") for (int m = 0; m < 4; ++m) _Pragma("unroll") for (int n = 0; n < 2; ++n) _Pragma("unroll") for (int k = 0; k < 2; ++k) \
        acc[ai][bj][m][n] = __builtin_amdgcn_mfma_f32_16x16x32_bf16(Bt[n][k], At[m][k], acc[ai][bj][m][n], 0, 0, 0); __builtin_amdgcn_s_setprio(0); } while (0)
#define PG8_WAIT_V(n) asm volatile("s_waitcnt vmcnt(" #n ")" ::: "memory")
#define PG8_WAIT_L(n) asm volatile("s_waitcnt lgkmcnt(" #n ")" ::: "memory")
#define PG8_BAR __builtin_amdgcn_s_barrier()
#define PG8_SCHED __builtin_amdgcn_sched_barrier(0)
    Unit cur, nxt; int ui = 0;
    if (!S.next(0, cur)) return;
    f32x4 acc[2][2][4][2];
#pragma unroll
    for (int a = 0; a < 2; ++a)
#pragma unroll
        for (int b = 0; b < 2; ++b)
#pragma unroll
            for (int m = 0; m < 4; ++m)
#pragma unroll
                for (int n = 0; n < 2; ++n) acc[a][b][m][n] = (f32x4){0.f, 0.f, 0.f, 0.f};
    bf16x8 At[4][2], B0[2][2], B1[2][2];
    const char* cA = (const char*)g.A + (size_t)cur.pm * tstep; const char* cB = (const char*)g.Bt + (size_t)cur.pn * tstep;
    S.a_ready(cur);
    if constexpr (SP2) {
        PG8_STAGE(PG8_SB(0, 0), cB, voffB); PG8_STAGE(PG8_SB(0, 1), cB + hstep, voffB); PG8_STAGE(PG8_SA(0, 0), cA, voffA); PG8_STAGE(PG8_SA(0, 1), cA + hstep, voffA);
        if (wr == 1) PG8_BAR;
        PG8_WAIT_V(2); PG8_BAR;
        PG8_STAGE(PG8_SB(1, 0), cB + kstep, voffB); PG8_STAGE(PG8_SA(1, 0), cA + kstep, voffA); PG8_STAGE(PG8_SB(1, 1), cB + hstep + kstep, voffB);
        PG8_WAIT_V(6); PG8_BAR;
    } else {
        PG8_STAGE(PG8_SB(0, 0), cB, voffB); PG8_STAGE(PG8_SA(0, 0), cA, voffA); PG8_STAGE(PG8_SB(0, 1), cB + hstep, voffB); PG8_STAGE(PG8_SA(0, 1), cA + hstep, voffA);
        if (wr == 1) PG8_BAR;
        PG8_WAIT_V(4); PG8_BAR;
        PG8_STAGE(PG8_SB(1, 0), cB + kstep, voffB); PG8_STAGE(PG8_SA(1, 0), cA + kstep, voffA); PG8_STAGE(PG8_SB(1, 1), cB + hstep + kstep, voffB);
        PG8_WAIT_V(6); PG8_BAR;
    }
    for (;;) {
        const bool has_next = S.next(ui + 1, nxt);
        const char* nA = has_next ? (const char*)g.A + (size_t)nxt.pm * tstep : cA; const char* nB = has_next ? (const char*)g.Bt + (size_t)nxt.pn * tstep : cB;
        for (int t = 0; t < nt; t += 2) {
            const bool last = (t == nt - 2);
            const char* a1 = cA + (size_t)(t + 1) * kstep;
            const char* a2 = last ? nA : cA + (size_t)(t + 2) * kstep; const char* b2 = last ? nB : cB + (size_t)(t + 2) * kstep;
            const char* a3 = a2 + kstep; const char* b3 = b2 + kstep;
            if (last && has_next) S.a_ready(nxt);
            if constexpr (SP2) {
            PG8_LDB(B0, 0, 0); PG8_LDB(B1, 0, 1); PG8_SCHED; PG8_LDA(At, 0, 0); PG8_STAGE(PG8_SA(1, 1), a1 + hstep, voffA);
            PG8_WAIT_V(8); PG8_WAIT_L(0); PG8_BAR; PG8_MMA(0, 0, At, B0); PG8_MMA(0, 1, At, B1); PG8_BAR; PG8_SCHED;
            PG8_LDA(At, 0, 1); PG8_STAGE(PG8_SB(0, 0), b2, voffB); PG8_STAGE(PG8_SB(0, 1), b2 + hstep, voffB); PG8_STAGE(PG8_SA(0, 0), a2, voffA);
            PG8_WAIT_V(8); PG8_WAIT_L(0); PG8_BAR; PG8_MMA(1, 0, At, B0); PG8_MMA(1, 1, At, B1); PG8_BAR; PG8_SCHED;
            PG8_LDB(B0, 1, 0); PG8_LDB(B1, 1, 1); PG8_SCHED; PG8_LDA(At, 1, 0); PG8_STAGE(PG8_SA(0, 1), a2 + hstep, voffA);
            PG8_WAIT_V(8); PG8_WAIT_L(0); PG8_BAR; PG8_MMA(0, 0, At, B0); PG8_MMA(0, 1, At, B1); PG8_BAR; PG8_SCHED;
            PG8_LDA(At, 1, 1); PG8_STAGE(PG8_SB(1, 0), b3, voffB); PG8_STAGE(PG8_SB(1, 1), b3 + hstep, voffB); PG8_STAGE(PG8_SA(1, 0), a3, voffA);
            PG8_WAIT_V(8); PG8_WAIT_L(0); PG8_BAR; PG8_MMA(1, 0, At, B0); PG8_MMA(1, 1, At, B1); PG8_BAR; PG8_SCHED;
            } else {
            PG8_LDB(B0, 0, 0); PG8_SCHED; PG8_LDA(At, 0, 0); PG8_STAGE(PG8_SA(1, 1), a1 + hstep, voffA);
            PG8_WAIT_L(8); PG8_BAR; PG8_WAIT_L(0); PG8_MMA(0, 0, At, B0); PG8_BAR; PG8_SCHED;
            PG8_LDB(B1, 0, 1); PG8_STAGE(PG8_SB(0, 0), b2, voffB);
            PG8_BAR; PG8_WAIT_L(0); PG8_MMA(0, 1, At, B1); PG8_BAR;
            PG8_LDA(At, 0, 1); PG8_STAGE(PG8_SA(0, 0), a2, voffA);
            PG8_BAR; PG8_WAIT_L(0); PG8_MMA(1, 0, At, B0); PG8_BAR; PG8_SCHED;
            PG8_STAGE(PG8_SB(0, 1), b2 + hstep, voffB);
            PG8_WAIT_V(6); PG8_BAR; PG8_MMA(1, 1, At, B1); PG8_BAR;
            PG8_LDB(B0, 1, 0); PG8_SCHED; PG8_LDA(At, 1, 0); PG8_STAGE(PG8_SA(0, 1), a2 + hstep, voffA);
            PG8_WAIT_L(8); PG8_BAR; PG8_WAIT_L(0); PG8_MMA(0, 0, At, B0); PG8_BAR; PG8_SCHED;
            PG8_LDB(B1, 1, 1); PG8_STAGE(PG8_SB(1, 0), b3, voffB);
            PG8_BAR; PG8_WAIT_L(0); PG8_MMA(0, 1, At, B1); PG8_BAR;
            PG8_LDA(At, 1, 1); PG8_STAGE(PG8_SA(1, 0), a3, voffA);
            PG8_BAR; PG8_WAIT_L(0); PG8_MMA(1, 0, At, B0); PG8_BAR; PG8_SCHED;
            PG8_STAGE(PG8_SB(1, 1), b3 + hstep, voffB);
            PG8_WAIT_V(6); PG8_BAR; PG8_MMA(1, 1, At, B1); PG8_BAR;
            }
        }
        if constexpr (ALIGN_EPI) { if (wr == 0) PG8_BAR; }
        if constexpr (!Epi::AFTER_DRAIN) { E(acc, cur, wr, wc, fr, fq); S.done(cur); }
        if (!has_next) break;
#pragma unroll
        for (int a = 0; a < 2; ++a)
#pragma unroll
            for (int b = 0; b < 2; ++b)
#pragma unroll
                for (int m = 0; m < 4; ++m)
#pragma unroll
                    for (int n = 0; n < 2; ++n) acc[a][b][m][n] = (f32x4){0.f, 0.f, 0.f, 0.f};
        cur = nxt; cA = nA; cB = nB; ++ui;
        if constexpr (ALIGN_EPI) { if (wr == 1) PG8_BAR; }
    }
    PG8_WAIT_V(0);
    if constexpr (!ALIGN_EPI) { if (wr == 0) PG8_BAR; }
    PG8_BAR;
    if constexpr (Epi::AFTER_DRAIN) { E.fused(acc, cur, wr, wc, fr, fq, lds, wid, lane); S.done(cur); }
#undef PG8_SA
#undef PG8_SB
#undef PG8_STAGE
#undef PG8_LDA
#undef PG8_LDB
#undef PG8_MMA
#undef PG8_WAIT_V
#undef PG8_WAIT_L
#undef PG8_BAR
#undef PG8_SCHED
}
}
#define GAS __attribute__((address_space(1)))
#define LAS __attribute__((address_space(3)))
typedef unsigned short bf16;
typedef unsigned v4u __attribute__((ext_vector_type(4)));
typedef float f32x4 __attribute__((ext_vector_type(4)));
typedef short bf16x8 __attribute__((ext_vector_type(8)));
typedef GAS unsigned gu32;
typedef GAS unsigned long long gu64;
#define RLX_AGENT __ATOMIC_RELAXED, __HIP_MEMORY_SCOPE_AGENT
#define LDS_WAIT() asm volatile("s_waitcnt lgkmcnt(0)" ::: "memory")
#define VM_WAIT() asm volatile("s_waitcnt vmcnt(0)" ::: "memory")
__device__ __forceinline__ unsigned long long rt() { return __builtin_amdgcn_s_memrealtime(); }
__device__ __forceinline__ unsigned f2bf(float f) { unsigned u = __builtin_bit_cast(unsigned, f); return (u + 0x7fffu + ((u >> 16) & 1u)) >> 16; }
__device__ __forceinline__ unsigned pk2(float lo, float hi) { return f2bf(lo) | (f2bf(hi) << 16); }

#define XB_TMO      128
#define XB_XCNT(j)  (256  + 64 * (j))
#define XB_XSUB(j)  (1280 + 64 * (j))
#define XB_XGEN(j)  (2304 + 64 * (j))
#define XB_TOP      3328
#define XB_TOPGEN   3392
#define XCD_BAR_WORDS 3456
#define XB_SPIN_CAP (1u << 18)

__device__ __forceinline__ unsigned xb_ld(unsigned* p)              { return __hip_atomic_load(p, __ATOMIC_RELAXED, __HIP_MEMORY_SCOPE_AGENT); }
__device__ __forceinline__ unsigned xb_add(unsigned* p, unsigned v) { return __hip_atomic_fetch_add(p, v, __ATOMIC_RELAXED, __HIP_MEMORY_SCOPE_AGENT); }
__device__ __forceinline__ unsigned xb_xcc_id() { return (unsigned)__builtin_amdgcn_s_getreg((3 << 11) | 20) & 0xFu; }
#define XB_SPIN(cond, bar) do { unsigned _sp = 0; while (cond) { __builtin_amdgcn_s_sleep(1); \
    if ((++_sp & 255u) == 0u) { if (xb_ld(&(bar)[XB_TMO])) break; if (_sp > XB_SPIN_CAP) { atomicAdd(&(bar)[XB_TMO], 1u); break; } } } } while (0)

struct XcdBarrier {
    unsigned* bar; unsigned x;
    volatile LAS unsigned* st;
};

__device__ __forceinline__ XcdBarrier xcd_barrier_post(unsigned* bar, volatile LAS unsigned* st) {
    XcdBarrier b; b.bar = bar; b.x = xb_xcc_id(); b.st = st;
    if (threadIdx.x == 0) (void)xb_add(&bar[XB_XCNT(b.x)], 1u);
    return b;
}
__device__ __forceinline__ void xcd_barrier_complete(unsigned* bar, unsigned x, unsigned& nloc, unsigned& nx) {
    const unsigned G = gridDim.x * gridDim.y * gridDim.z;
    unsigned sum, cnt, mine, sp = 0u;
    for (;;) {
        sum = 0u; cnt = 0u; mine = 0u;
#pragma unroll
        for (unsigned j = 0; j < 16; ++j) { const unsigned c = xb_ld(&bar[XB_XCNT(j)]); sum += c; cnt += (c > 0u) ? 1u : 0u; mine = (j == x) ? c : mine; }
        if (sum == G) break;
        __builtin_amdgcn_s_sleep(1);
        if ((++sp & 255u) == 0u) { if (xb_ld(&bar[XB_TMO])) break; if (sp > XB_SPIN_CAP) { atomicAdd(&bar[XB_TMO], 1u); break; } }
    }
    nloc = mine > 0u ? mine : 1u; nx = cnt > 0u ? cnt : 1u;
}

__device__ __forceinline__ void xcd_barrier(const XcdBarrier& b) {
    asm volatile("s_waitcnt vmcnt(0)" ::: "memory");
    __syncthreads();
    if (threadIdx.x == 0) {
        unsigned* bar = b.bar;
        __builtin_amdgcn_s_waitcnt(0);
        unsigned nloc = b.st[0], nx = b.st[1];
        if (nloc == 0u) { xcd_barrier_complete(bar, b.x, nloc, nx); b.st[0] = nloc; b.st[1] = nx; }
        const unsigned old = xb_add(&bar[XB_XSUB(b.x)], 1u);
        const unsigned gen = old / nloc;
        if (old + 1u == (gen + 1u) * nloc) {
            __builtin_amdgcn_fence(__ATOMIC_RELEASE, "agent");
            asm volatile("s_waitcnt vmcnt(0)" ::: "memory");
            const unsigned og = xb_add(&bar[XB_TOP], 1u);
            const unsigned tg = og / nx;
            if (og + 1u == (tg + 1u) * nx) xb_add(&bar[XB_TOPGEN], 1u);
            else XB_SPIN(xb_ld(&bar[XB_TOPGEN]) == tg, bar);
            __builtin_amdgcn_fence(__ATOMIC_ACQUIRE, "agent");
            xb_add(&bar[XB_XGEN(b.x)], 1u);
            asm volatile("s_waitcnt vmcnt(0)" ::: "memory");
        } else {
            XB_SPIN(xb_ld(&bar[XB_XGEN(b.x)]) == gen, bar);
            __builtin_amdgcn_fence(__ATOMIC_ACQUIRE, "agent");
            asm volatile("s_waitcnt vmcnt(0)" ::: "memory");
        }
    }
    __syncthreads();
}

constexpr int RING_BYTES = 131072;
constexpr int SEL_HIST_OFF = 131072, SEL_CAND_OFF = SEL_HIST_OFF + 16384, SEL_STAGE_OFF = SEL_CAND_OFF + 4096, MISC_OFF = SEL_STAGE_OFF + 4096, LDS_BYTES = 159744;
static_assert(MISC_OFF + 256 <= LDS_BYTES, "LDS map");

typedef short s16x4 __attribute__((ext_vector_type(4)));
typedef short v4i16_t __attribute__((ext_vector_type(4)));
typedef float f32x16 __attribute__((ext_vector_type(16)));
typedef unsigned u32x2 __attribute__((ext_vector_type(2)));
__device__ __forceinline__ float wave_sum(float v) {
#pragma unroll
    for (int o = 1; o < 64; o <<= 1) v += __shfl_xor(v, o);
    return v;
}
__device__ __forceinline__ unsigned cvtpk(float lo, float hi) { unsigned r; asm volatile("v_cvt_pk_bf16_f32 %0, %1, %2" : "=v"(r) : "v"(lo), "v"(hi)); return r; }
__device__ __forceinline__ float bf_lo(unsigned w) { return __uint_as_float(w << 16); }
__device__ __forceinline__ float bf_hi(unsigned w) { return __uint_as_float(w & 0xffff0000u); }
__device__ __forceinline__ float swap_max(float m) { auto rr = __builtin_amdgcn_permlane32_swap(__float_as_uint(m), __float_as_uint(m), false, false); return fmaxf(__uint_as_float(rr[0]), __uint_as_float(rr[1])); }
__device__ __forceinline__ float swap_sum(float m) { auto rr = __builtin_amdgcn_permlane32_swap(__float_as_uint(m), __float_as_uint(m), false, false); return __uint_as_float(rr[0]) + __uint_as_float(rr[1]); }
__device__ __forceinline__ int crow(int r, int hi) { return (r & 3) + 8 * (r >> 2) + 4 * hi; }
__device__ __forceinline__ unsigned vimg(unsigned row, unsigned ch) { return row * 128u + 16u * (ch ^ ((row & 3u) | (((row >> 1) & 1u) << 2))); }
__device__ __forceinline__ unsigned kimg(unsigned row, unsigned ch) { return row * 128u + 16u * (ch ^ ((row >> 1) & 7u)); }
__device__ __forceinline__ s16x4 vtr(const LAS unsigned char* p) { return __builtin_bit_cast(s16x4, __builtin_amdgcn_ds_read_tr16_b64_v4i16((LAS v4i16_t*)p)); }
#define MFMA32(a, b, c) __builtin_amdgcn_mfma_f32_32x32x16_bf16((a), (b), (c), 0, 0, 0)

struct Frame {
    LAS unsigned char* lds; volatile LAS unsigned* MISC; gu32* ctl;
    int tid, lane, wave, vcu, G, bx;
};
struct Args { const float* in[11]; const int* pos; float* out; unsigned char* ws; int seg; int pad; };
typedef const Args __attribute__((address_space(4)))* cargs_t;

__device__ __forceinline__ int rope_perm64(int c) { return ((c & 31) >> 2) * 8 + (c & 3) + ((c >> 5) << 2); }
template <int KIND> __device__ __forceinline__ int phys_row(int n) {
    if (KIND == 0) { if (n < 9216 && ((n >> 10) % 3) < 2) return (n & ~63) + rope_perm64(n & 63); return n; }
    if (KIND == 1) { if (n < 1280 || (n >= 1536 && n < 2112)) return (n & ~63) + rope_perm64(n & 63); if (n >= 2120) return n + 184; return n; }
    return n;
}
template <int KIND> __device__ __forceinline__ void transpose_item(const float* W, int K, int N, bf16* WT, LAS float* scr, int item, int lane) {
    const int nblk = (N + 31) / 32, kb = item / nblk, nb = item % nblk, k0 = 64 * kb, n0 = 32 * nb;
    const bool nok = n0 + (lane & 31) < N;
#pragma unroll 8
    for (int i = 0; i < 32; ++i) { const int kk = 2 * i + (lane >> 5); scr[kk * 33 + (lane & 31)] = nok ? W[(size_t)(k0 + kk) * N + n0 + (lane & 31)] : 0.f; }
    LDS_WAIT(); asm volatile("" ::: "memory");
    const int c = lane & 7;
#pragma unroll
    for (int j = 0; j < 4; ++j) { const int n = (lane >> 3) + 8 * j; const LAS float* s = scr + (8 * c) * 33 + n;
        v4u o; o.x = pk2(s[0 * 33], s[1 * 33]); o.y = pk2(s[2 * 33], s[3 * 33]); o.z = pk2(s[4 * 33], s[5 * 33]); o.w = pk2(s[6 * 33], s[7 * 33]);
        if (n0 + n < N) *(GAS v4u*)(WT + (size_t)phys_row<KIND>(n0 + n) * K + k0 + 8 * c) = o; }
    LDS_WAIT(); asm volatile("" ::: "memory");
}
__constant__ float INVF[32] = {1.000000000e+00f, 7.498942614e-01f, 5.623413324e-01f, 4.216965139e-01f, 3.162277639e-01f, 2.371373773e-01f, 1.778279394e-01f, 1.333521307e-01f, 1.000000015e-01f, 7.498941571e-02f,
    5.623413250e-02f, 4.216965288e-02f, 3.162277490e-02f, 2.371373773e-02f, 1.778279431e-02f, 1.333521493e-02f, 9.999999776e-03f, 7.498941850e-03f, 5.623413250e-03f, 4.216964822e-03f, 3.162277630e-03f, 2.371373586e-03f,
    1.778279431e-03f, 1.333521446e-03f, 1.000000047e-03f, 7.498942432e-04f, 5.623413017e-04f, 4.216965172e-04f, 3.162277571e-04f, 2.371373703e-04f, 1.778279402e-04f, 1.333521504e-04f};

__device__ __forceinline__ void p_prologue(Frame& F, cargs_t ap) {
    const float* const* in_ = nullptr; (void)in_;
    struct { const float* in[11]; const int* pos; unsigned char* ws; } a;
#pragma unroll
    for (int i = 0; i < 11; ++i) a.in[i] = ap->in[i];
    a.pos = ap->pos; a.ws = ap->ws;
    unsigned char* ws = a.ws;
    LAS float* scr = (LAS float*)(F.lds + F.wave * 12288);
    const int gw = F.vcu * NWAVES + F.wave, NGW = F.G * NWAVES;
    constexpr int I_A = 16 * (A_N / 32), I_B = 16 * ((B_NL + 31) / 32), I_O = 16 * 32;
    constexpr int NITEMS = 2 * I_A + 2 * I_B + 4 * I_O;
    for (int it = gw; it < NITEMS; it += NGW) {
        int r = it;
        if (r < 2 * I_A) { const int l = r / I_A; transpose_item<0>(a.in[6] + (size_t)l * 1024 * A_N, 1024, A_N, (bf16*)(ws + WS_WA) + (size_t)l * A_N * 1024, scr, r % I_A, F.lane); continue; } r -= 2 * I_A;
        if (r < 2 * I_B) { const int l = r / I_B; transpose_item<1>(a.in[8] + (size_t)l * 1024 * B_NL, 1024, B_NL, (bf16*)(ws + WS_WB) + (size_t)l * B_NP * 1024, scr, r % I_B, F.lane); continue; } r -= 2 * I_B;
        { const int l = r / I_O;
          const float* W = ((l & 1) ? a.in[9] : a.in[7]) + (size_t)(l >> 1) * 1024 * 1024;
          transpose_item<2>(W, 1024, 1024, (bf16*)(ws + WS_WO) + (size_t)l * 1024 * 1024, scr, r % I_O, F.lane); }
    }
    { const int gt = (F.vcu * NWAVES + F.wave) * 64 + F.lane, NGT = NGW * 64;
      for (int i = gt; i < 2 * 184 * 128; i += NGT) { const int l = i / (184 * 128), rr = (i / 128) % 184, c = i % 128;
          *(GAS v4u*)((bf16*)(ws + WS_WB) + (size_t)l * B_NP * 1024 + (size_t)(2120 + rr) * 1024 + c * 8) = (v4u){0u, 0u, 0u, 0u}; }
      float* cs = (float*)(ws + WS_COS); float* sn = (float*)(ws + WS_SIN);
      for (int i = gt; i < MTOK * 32; i += NGT) { const int tok = i >> 5, j = i & 31;
          const float angf = (float)a.pos[tok] * INVF[j]; const double x = (double)angf;
          const double k = __builtin_rint(x * 0.15915494309189535); double r = __builtin_fma(-k, 6.283185307179586, x); r = __builtin_fma(-k, 2.4492935982947064e-16, r);
          const float rf = (float)r; cs[i] = __cosf(rf); sn[i] = __sinf(rf); }
    }
    { LAS float* cact = (LAS float*)(F.lds + 98304);
      for (int i = F.tid; i < 8 * 1024; i += NWAVES * 64) { const float v = a.in[1][i]; cact[i] = v / (1.f + __expf(-v)); }
      __syncthreads();
      const float* adaw = a.in[4]; const float* adab = a.in[5]; float* mod = (float*)(ws + WS_MOD);
      const int col = F.lane & 15, kq = F.lane >> 4;
      for (int it = gw; it < 4 * 192; it += NGW) { const int l = it / 192, n0 = (it % 192) * 16;
          float acc[8];
#pragma unroll
          for (int b = 0; b < 8; ++b) acc[b] = 0.f;
          const float* wp = adaw + (size_t)l * 1024 * 3072 + (size_t)(kq * 256) * 3072 + n0 + col;
#pragma unroll 32
          for (int k = 0; k < 256; ++k) { const float w = wp[(size_t)k * 3072];
#pragma unroll
              for (int b = 0; b < 8; ++b) acc[b] += cact[b * 1024 + kq * 256 + k] * w; }
#pragma unroll
          for (int b = 0; b < 8; ++b) { float v = acc[b]; v += __shfl_xor(v, 16); v += __shfl_xor(v, 32); acc[b] = v; }
          if (kq == 0) {
#pragma unroll
              for (int b = 0; b < 8; ++b) mod[((size_t)l * 8 + b) * 3072 + n0 + col] = acc[b] + adab[(size_t)l * 3072 + n0 + col]; }
      }
    }
}

__device__ __forceinline__ void p_norm_mod(Frame& F, const float* hin, const float* g, const float* mod_l, bf16* U) {
    const int gw = F.vcu * NWAVES + F.wave, NGW = F.G * NWAVES;
    for (int r0 = gw * 16; r0 < MTOK; r0 += NGW * 16) {
        const int b = r0 >> 12;
        f32x4 A[4], Bv[4];
#pragma unroll
        for (int j = 0; j < 4; ++j) { const int c = 4 * F.lane + 256 * j; const f32x4 gg = *(const f32x4*)(g + c), sc = *(const f32x4*)(mod_l + (size_t)b * 3072 + 1024 + c);
            A[j] = gg * (sc + 1.0f); Bv[j] = *(const f32x4*)(mod_l + (size_t)b * 3072 + c); }
        for (int rr = 0; rr < 16; ++rr) {
            const int row = r0 + rr; const GAS f32x4* xr = (const GAS f32x4*)(hin + (size_t)row * DM) + F.lane;
            f32x4 v[4]; float s = 0.f;
#pragma unroll
            for (int j = 0; j < 4; ++j) { v[j] = xr[64 * j]; s += (v[j].x * v[j].x + v[j].y * v[j].y) + (v[j].z * v[j].z + v[j].w * v[j].w); }
            const float rstd = 1.0f / sqrtf(wave_sum(s) * (1.f / DM) + NORM_EPS);
            GAS u32x2* o8 = (GAS u32x2*)(U + (size_t)row * DM) + F.lane;
#pragma unroll
            for (int j = 0; j < 4; ++j) { const f32x4 y = (v[j] * rstd) * A[j] + Bv[j]; o8[64 * j] = (u32x2){cvtpk(y.x, y.y), cvtpk(y.z, y.w)}; }
        }
    }
}
__device__ __forceinline__ void p_final_norm(Frame& F, const float* hin, const float* g, float* out) {
    const int gw = F.vcu * NWAVES + F.wave, NGW = F.G * NWAVES;
    f32x4 A[4];
#pragma unroll
    for (int j = 0; j < 4; ++j) A[j] = *(const f32x4*)(g + 4 * F.lane + 256 * j);
    for (int row = gw; row < MTOK; row += NGW) {
        const GAS f32x4* xr = (const GAS f32x4*)(hin + (size_t)row * DM) + F.lane;
        f32x4 v[4]; float s = 0.f;
#pragma unroll
        for (int j = 0; j < 4; ++j) { v[j] = xr[64 * j]; s += (v[j].x * v[j].x + v[j].y * v[j].y) + (v[j].z * v[j].z + v[j].w * v[j].w); }
        const float rstd = 1.0f / sqrtf(wave_sum(s) * (1.f / DM) + NORM_EPS);
        GAS f32x4* o = (GAS f32x4*)(out + (size_t)row * DM) + F.lane;
#pragma unroll
        for (int j = 0; j < 4; ++j) o[64 * j] = (v[j] * rstd) * A[j];
    }
}

__device__ __forceinline__ void attnA_tile(const bf16* Qp, bf16* Op, const bf16* Kp, const bf16* Vp, float* lsep, int lse_stride, int rstride, int i0, LAS unsigned char* vst, int lane) {
    const int q32 = lane & 31, hi = lane >> 5;
    bf16x8 qf[4];
    { const bf16* qrow = Qp + (size_t)(i0 + q32) * rstride + 8 * hi;
#pragma unroll
      for (int ks = 0; ks < 4; ++ks) qf[ks] = *(const bf16x8*)(qrow + 16 * ks); }
    f32x16 o0 = {}, o1 = {};
    float m_run = -INFINITY, l_run = 0.f;
    const int kt0 = (i0 >= 128) ? 0 : (128 - i0) / 32;
    bf16x8 kf[4]; v4u vr[4];
    const int vc = lane & 7, vrow = lane >> 3;
#define ATT_LOADKV(kb_) do { const bf16* kr_ = Kp + (size_t)((kb_) + q32) * rstride + 8 * hi; \
        _Pragma("unroll") for (int ks = 0; ks < 4; ++ks) kf[ks] = *(const bf16x8*)(kr_ + 16 * ks); \
        _Pragma("unroll") for (int i = 0; i < 4; ++i) vr[i] = *(const v4u*)(Vp + (size_t)((kb_) + vrow + 8 * i) * rstride + 8 * vc); } while (0)
    ATT_LOADKV(i0 - 128 + 32 * kt0);
    const int q4 = (lane & 15) >> 2, blk = (lane >> 4) & 1, p4 = lane & 3;
    for (int kt = kt0; kt < 5; ++kt) {
#pragma unroll
        for (int i = 0; i < 4; ++i) *(LAS v4u*)(vst + vimg(vrow + 8 * i, vc)) = vr[i];
        bf16x8 kc[4];
#pragma unroll
        for (int ks = 0; ks < 4; ++ks) kc[ks] = kf[ks];
        if (kt + 1 < 5) ATT_LOADKV(i0 - 128 + 32 * (kt + 1));
        f32x16 p = {};
#pragma unroll
        for (int ks = 0; ks < 4; ++ks) p = MFMA32(kc[ks], qf[ks], p);
        if (kt == 0) {
#pragma unroll
            for (int r = 0; r < 16; ++r) if (crow(r, hi) < q32) p[r] = -INFINITY;
        }
        if (kt == 4) {
#pragma unroll
            for (int r = 0; r < 16; ++r) if (crow(r, hi) > q32) p[r] = -INFINITY;
        }
        float mt = p[0];
#pragma unroll
        for (int r = 1; r < 16; ++r) mt = fmaxf(mt, p[r]);
        mt = swap_max(mt);
        const float m_new = fmaxf(m_run, mt);
        const float alpha = __builtin_amdgcn_exp2f(m_run - m_new);
        float s = 0.f;
#pragma unroll
        for (int r = 0; r < 16; ++r) { p[r] = __builtin_amdgcn_exp2f(p[r] - m_new); s += p[r]; }
        l_run = l_run * alpha + s; m_run = m_new;
#pragma unroll
        for (int r = 0; r < 16; ++r) { o0[r] *= alpha; o1[r] *= alpha; }
        bf16x8 pf[2];
#pragma unroll
        for (int ks = 0; ks < 2; ++ks) { v4u w; w.x = cvtpk(p[8 * ks + 0], p[8 * ks + 1]); w.y = cvtpk(p[8 * ks + 2], p[8 * ks + 3]); w.z = cvtpk(p[8 * ks + 4], p[8 * ks + 5]); w.w = cvtpk(p[8 * ks + 6], p[8 * ks + 7]); pf[ks] = __builtin_bit_cast(bf16x8, w); }
        LDS_WAIT(); asm volatile("" ::: "memory");
#pragma unroll
        for (int ks = 0; ks < 2; ++ks)
#pragma unroll
            for (int d0 = 0; d0 < 2; ++d0) {
                const s16x4 lo = vtr(vst + vimg(16 * ks + 4 * hi + q4, 4 * d0 + 2 * blk + (p4 >> 1)) + 8 * (p4 & 1));
                const s16x4 up = vtr(vst + vimg(16 * ks + 8 + 4 * hi + q4, 4 * d0 + 2 * blk + (p4 >> 1)) + 8 * (p4 & 1));
                const bf16x8 vf = (bf16x8){lo[0], lo[1], lo[2], lo[3], up[0], up[1], up[2], up[3]};
                if (d0 == 0) o0 = MFMA32(vf, pf[ks], o0); else o1 = MFMA32(vf, pf[ks], o1);
            }
        LDS_WAIT(); asm volatile("" ::: "memory");
    }
#undef ATT_LOADKV
    const float l_tot = swap_sum(l_run), inv = 1.0f / l_tot;
    bf16* orow = Op + (size_t)(i0 + q32) * rstride;
#pragma unroll
    for (int g4 = 0; g4 < 4; ++g4) {
        *(u32x2*)(orow + 8 * g4 + 4 * hi) = (u32x2){cvtpk(o0[4 * g4] * inv, o0[4 * g4 + 1] * inv), cvtpk(o0[4 * g4 + 2] * inv, o0[4 * g4 + 3] * inv)};
        *(u32x2*)(orow + 32 + 8 * g4 + 4 * hi) = (u32x2){cvtpk(o1[4 * g4] * inv, o1[4 * g4 + 1] * inv), cvtpk(o1[4 * g4 + 2] * inv, o1[4 * g4 + 3] * inv)};
    }
    if (hi == 0) lsep[(size_t)(i0 + q32) * lse_stride] = m_run + __builtin_amdgcn_logf(l_tot);
}
__device__ __forceinline__ void p_attnA(Frame& F, bf16* act, float* lse, bf16* dump) {
    LAS unsigned char* vst = F.lds + F.wave * 4096;
    constexpr int NBL = MC / SEQ, NUNITS = NBL * 3 * 16 * 16;
    for (int u = F.bx; u < NUNITS; u += F.G) {
        const int cb = u & 15, h = (u >> 4) & 15, g = (u >> 8) % 3, bl = u / 768;
        const int dl = (g == 0) ? 1 : (g == 1 ? 4 : 16), nbk = 16 / dl;
        const int r = cb / nbk, bk = cb % nbk;
        const size_t row_base = (size_t)bl * SEQ + r;
        bf16* Qp = act + (size_t)(3 * g + 0) * (A_SUB / 2) + row_base * 1024 + h * 64;
        const bf16* Kp = act + (size_t)(3 * g + 1) * (A_SUB / 2) + row_base * 1024 + h * 64;
        const bf16* Vp = act + (size_t)(3 * g + 2) * (A_SUB / 2) + row_base * 1024 + h * 64;
        float* lsep = lse + ((size_t)g * MC + row_base) * 16 + h;
        bf16* Op = dump ? dump + row_base * 1024 + h * 64 : Qp;
        attnA_tile(Qp, Op, Kp, Vp, lsep, 16 * dl, dl * 1024, bk * 256 + 32 * F.wave, vst, F.lane);
    }
}
__device__ __forceinline__ void p_mergeA(Frame& F, const bf16* act, const float* lse, bf16* Z  ) {
    const int gw = F.vcu * NWAVES + F.wave, NGW = F.G * NWAVES;
    const int head = F.lane >> 2;
    for (int row = gw; row < MC; row += NGW) {
        float l0 = lse[((size_t)0 * MC + row) * 16 + head], l1 = lse[((size_t)1 * MC + row) * 16 + head], l2 = lse[((size_t)2 * MC + row) * 16 + head];
        const float mx = fmaxf(l0, fmaxf(l1, l2));
        float e0 = __builtin_amdgcn_exp2f(l0 - mx), e1 = __builtin_amdgcn_exp2f(l1 - mx), e2 = __builtin_amdgcn_exp2f(l2 - mx);
        const float inv = 1.0f / (e0 + e1 + e2); e0 *= inv; e1 *= inv; e2 *= inv;
#pragma unroll
        for (int hf = 0; hf < 2; ++hf) {
            const size_t off = (size_t)row * 1024 + 16 * F.lane + 8 * hf;
            const v4u a0 = *(const v4u*)(act + (size_t)0 * (A_SUB / 2) + off), a1 = *(const v4u*)(act + (size_t)3 * (A_SUB / 2) + off), a2 = *(const v4u*)(act + (size_t)6 * (A_SUB / 2) + off),
                      gg = *(const v4u*)(act + (size_t)9 * (A_SUB / 2) + off);
            v4u o;
#pragma unroll
            for (int k = 0; k < 4; ++k) {
                const float ylo = (e0 * bf_lo(a0[k]) + e1 * bf_lo(a1[k]) + e2 * bf_lo(a2[k])) * bf_lo(gg[k]);
                const float yhi = (e0 * bf_hi(a0[k]) + e1 * bf_hi(a1[k]) + e2 * bf_hi(a2[k])) * bf_hi(gg[k]);
                o[k] = cvtpk(ylo, yhi);
            }
            *(v4u*)(Z + off) = o;
        }
    }
}

__device__ __forceinline__ unsigned ordkey(float f) { unsigned u = __float_as_uint(f); if ((u << 1) == 0u) u = 0u; return (u & 0x80000000u) ? ~u : (u | 0x80000000u); }
#define IDX_LOAD_QW(qf_, wv_, b_, t0_) do { const size_t tk_ = (size_t)(b_) * SEQ + (t0_); const int c32_ = F.lane & 31, hi_ = F.lane >> 5; \
        const int tl_ = 2 * ((c32_ >> 2) & 1) + (c32_ >> 4), hd_ = ((c32_ >> 3) & 1) * 4 + (c32_ & 3); \
        _Pragma("unroll") for (int R = 0; R < 2; ++R) { const bf16* qp_ = QI + (tk_ + 4 * R + tl_) * 512 + hd_ * 64 + 8 * hi_; \
            _Pragma("unroll") for (int ks = 0; ks < 4; ++ks) qf_[R][ks] = *(const bf16x8*)(qp_ + 16 * ks); \
            _Pragma("unroll") for (int tt = 0; tt < 2; ++tt) { const float* wp_ = WI + (tk_ + 4 * R + 2 * hi_ + tt) * 8; wv_[R][tt][0] = *(const f32x4*)wp_; wv_[R][tt][1] = *(const f32x4*)(wp_ + 4); } } } while (0)
__device__ __forceinline__ void index_tile(Frame& F, int b, int t0, const bf16* QI, const bf16* KI, const float* WI, unsigned long long* maskw,
                                           bf16x8 (&qf)[2][4], f32x4 (&wv)[2][2][2], bf16x8 (&qn)[2][4], f32x4 (&wn)[2][2][2], bool has_next, int bn, int t0n) {
    LAS float* sc = (LAS float*)F.lds;
    LAS unsigned* hist = (LAS unsigned*)(F.lds + SEL_HIST_OFF) + F.wave * 512;
    LAS unsigned* cand = (LAS unsigned*)(F.lds + SEL_CAND_OFF);
    LAS unsigned long long* stage = (LAS unsigned long long*)(F.lds + SEL_STAGE_OFF);
    const int lane = F.lane, c32 = lane & 31, hi = lane >> 5;
    const size_t tok0 = (size_t)b * SEQ + t0;
#ifndef IDX_REP_SCORE
#define IDX_REP_SCORE 1
#endif
#ifndef IDX_REP_SEL
#define IDX_REP_SEL 1
#endif
    for (int rep_ = 0; rep_ < IDX_REP_SCORE; ++rep_) {
        const int nkt = (t0 + 8 + 31) >> 5;
        bf16x8 kf[4], kg[4];
        const bf16* kbase = KI + ((size_t)b * SEQ + c32) * 64 + 8 * hi;
        int kt = F.wave;
        if (kt < nkt) {
#pragma unroll
            for (int ks = 0; ks < 4; ++ks) kf[ks] = *(const bf16x8*)(kbase + (size_t)kt * 32 * 64 + 16 * ks);
        }
        if (kt + NWAVES < nkt) {
#pragma unroll
            for (int ks = 0; ks < 4; ++ks) kg[ks] = *(const bf16x8*)(kbase + (size_t)(kt + NWAVES) * 32 * 64 + 16 * ks);
        }
        for (; kt < nkt; kt += NWAVES) {
            bf16x8 kc[4];
#pragma unroll
            for (int ks = 0; ks < 4; ++ks) { kc[ks] = kf[ks]; kf[ks] = kg[ks]; }
            if (kt + 2 * NWAVES < nkt) {
#pragma unroll
                for (int ks = 0; ks < 4; ++ks) kg[ks] = *(const bf16x8*)(kbase + (size_t)(kt + 2 * NWAVES) * 32 * 64 + 16 * ks);
            }
#pragma unroll
            for (int R = 0; R < 2; ++R) {
                f32x16 acc = {};
#pragma unroll
                for (int ks = 0; ks < 4; ++ks) acc = MFMA32(qf[R][ks], kc[ks], acc);
#pragma unroll
                for (int tt = 0; tt < 2; ++tt) {
                    float s = 0.f;
#pragma unroll
                    for (int i = 0; i < 8; ++i) s += wv[R][tt][i >> 2][i & 3] * fmaxf(acc[8 * tt + i], 0.f);
                    sc[(4 * R + 2 * hi + tt) * 4096 + kt * 32 + c32] = s;
                }
            }
        }
    }
    __syncthreads();
    if (has_next) IDX_LOAD_QW(qn, wn, bn, t0n);
    for (int rep_ = 0; rep_ < IDX_REP_SEL; ++rep_) {
        const int t = t0 + F.wave, n = t + 1;
        const LAS float* scq = sc + F.wave * 4096;
        unsigned long long myword = 0ull;
        bool done = false;
        if (n <= 256) {
            const int j = lane; const int rem = n - 64 * j;
            myword = rem >= 64 ? ~0ull : (rem > 0 ? ((1ull << rem) - 1ull) : 0ull);
            done = true;
        } else {
            float lo = INFINITY, hi = -INFINITY;
            for (int i = 0; i * 256 < n; ++i) { const int idx = 4 * (lane + 64 * i); const f32x4 v = *(const LAS f32x4*)(scq + idx);
#pragma unroll
                for (int e = 0; e < 4; ++e) if (idx + e < n) { lo = fminf(lo, v[e]); hi = fmaxf(hi, v[e]); } }
#pragma unroll
            for (int o = 1; o < 64; o <<= 1) { lo = fminf(lo, __shfl_xor(lo, o)); hi = fmaxf(hi, __shfl_xor(hi, o)); }
            if (hi > lo) {
                const float scale = 512.0f / (hi - lo);
                *(LAS v4u*)(hist + 8 * lane) = (v4u){0u, 0u, 0u, 0u}; *(LAS v4u*)(hist + 8 * lane + 4) = (v4u){0u, 0u, 0u, 0u};
                LDS_WAIT(); asm volatile("" ::: "memory");
                for (int i = 0; i * 256 < n; ++i) { const int idx = 4 * (lane + 64 * i); const f32x4 v = *(const LAS f32x4*)(scq + idx);
#pragma unroll
                    for (int e = 0; e < 4; ++e) if (idx + e < n) { const int bn = min(511, (int)((v[e] - lo) * scale));
                        __hip_atomic_fetch_add(hist + bn, 1u, __ATOMIC_RELAXED, __HIP_MEMORY_SCOPE_WORKGROUP); } }
                LDS_WAIT(); asm volatile("" ::: "memory");
                const v4u c0 = *(const LAS v4u*)(hist + 8 * lane), c1 = *(const LAS v4u*)(hist + 8 * lane + 4);
                unsigned cc[8] = {c0.x, c0.y, c0.z, c0.w, c1.x, c1.y, c1.z, c1.w};
                const unsigned ls = ((c0.x + c0.y) + (c0.z + c0.w)) + ((c1.x + c1.y) + (c1.z + c1.w));
                unsigned inc = ls;
#pragma unroll
                for (int o = 1; o < 64; o <<= 1) { const unsigned v = __shfl_up(inc, o); if (lane >= o) inc += v; }
                const unsigned total = __shfl(inc, 63);
                const unsigned S = total - inc;
                const bool found = (S < 256u) && (256u <= S + ls);
                unsigned acc = S; int bin = 0; unsigned above = S; bool got = false;
#pragma unroll
                for (int q = 7; q >= 0; --q) { if (!got) { if (acc + cc[q] >= 256u) { bin = q; above = acc; got = true; } else acc += cc[q]; } }
                const unsigned long long fm = __ballot(found);
                const int src = fm ? (__ffsll((long long)fm) - 1) : 0;
                const int B = __shfl(8 * lane + bin, src); const unsigned aboveb = __shfl(above, src);
                const unsigned mB = __shfl(cc[0] * 0u + ((bin == 0) ? cc[0] : (bin == 1) ? cc[1] : (bin == 2) ? cc[2] : (bin == 3) ? cc[3] : (bin == 4) ? cc[4] : (bin == 5) ? cc[5] : (bin == 6) ? cc[6] : cc[7]), src);
                const unsigned kk2 = 256u - aboveb;
                if (mB <= 64u) {
                    LAS unsigned* ckey = cand + F.wave * 128; LAS unsigned* cidx = ckey + 64;
                    unsigned base = 0u;
                    for (int j4 = 0; 256 * j4 < n; ++j4) {
                        float xs[4];
#pragma unroll
                        for (int c = 0; c < 4; ++c) xs[c] = scq[64 * (4 * j4 + c) + lane];
#pragma unroll
                        for (int c = 0; c < 4; ++c) {
                            const int j = 4 * j4 + c, sidx = 64 * j + lane; const bool v = sidx < n; const float x = xs[c];
                            const int bq = min(511, (int)((x - lo) * scale));
                            const bool gt = v && bq > B, eq = v && bq == B;
                            const unsigned long long wj = __ballot(gt), em = __ballot(eq);
                            if (eq) { const unsigned pos = base + (unsigned)__popcll(em & ((1ull << lane) - 1ull)); ckey[pos] = ordkey(x); cidx[pos] = (unsigned)sidx; }
                            base += (unsigned)__popcll(em);
                            if (lane == j) myword = wj;
                        }
                    }
                    stage[F.wave * 64 + lane] = myword;
                    LDS_WAIT(); asm volatile("" ::: "memory");
                    const unsigned m = base;
                    const unsigned mykey = (unsigned)lane < m ? ckey[lane] : 0u, myidx = (unsigned)lane < m ? cidx[lane] : 0u;
                    unsigned rank = 0u;
                    for (unsigned f = 0; f < m; ++f) { const unsigned kf = ckey[f]; rank += (kf > mykey || (kf == mykey && f < (unsigned)lane)) ? 1u : 0u; }
                    if ((unsigned)lane < m && rank < kk2)
                        __hip_atomic_fetch_or((LAS unsigned*)stage + F.wave * 128 + (myidx >> 5), 1u << (myidx & 31u), __ATOMIC_RELAXED, __HIP_MEMORY_SCOPE_WORKGROUP);
                    done = true;
                }
            }
        }
        if (!done) {
            unsigned T = 0u; int kk = 256; unsigned prefix = 0u;
#pragma unroll
            for (int pass = 0; pass < 4; ++pass) {
                const int shift = 24 - 8 * pass;
                *(LAS v4u*)(hist + 4 * lane) = (v4u){0u, 0u, 0u, 0u};
                LDS_WAIT(); asm volatile("" ::: "memory");
                for (int s2 = lane; s2 < n; s2 += 64) {
                    const unsigned key = ordkey(scq[s2]);
                    const bool in = (pass == 0) ? true : ((key >> ((shift + 8) & 31)) == prefix);
                    if (in) __hip_atomic_fetch_add(hist + ((key >> shift) & 255u), 1u, __ATOMIC_RELAXED, __HIP_MEMORY_SCOPE_WORKGROUP);
                }
                LDS_WAIT(); asm volatile("" ::: "memory");
                const v4u c = *(const LAS v4u*)(hist + 4 * lane);
                const unsigned ls = c.x + c.y + c.z + c.w;
                unsigned inc = ls;
#pragma unroll
                for (int o = 1; o < 64; o <<= 1) { const unsigned v = __shfl_up(inc, o); if (lane >= o) inc += v; }
                const unsigned total = __shfl(inc, 63);
                const unsigned S = total - inc;
                const bool found = (S < (unsigned)kk) && ((unsigned)kk <= S + ls);
                unsigned acc = S; int bin; unsigned above;
                if (acc + c.w >= (unsigned)kk) { bin = 3; above = acc; }
                else { acc += c.w; if (acc + c.z >= (unsigned)kk) { bin = 2; above = acc; }
                else { acc += c.z; if (acc + c.y >= (unsigned)kk) { bin = 1; above = acc; }
                else { acc += c.y; bin = 0; above = acc; } } }
                const unsigned long long fm = __ballot(found);
                const int src = fm ? (__ffsll((long long)fm) - 1) : 0;
                const int binb = __shfl(4 * lane + bin, src); const unsigned aboveb = __shfl(above, src);
                prefix = (prefix << 8) | (unsigned)binb; kk -= (int)aboveb;
            }
            T = prefix;
            unsigned taken = 0u; myword = 0ull;
            for (int j = 0; 64 * j < n; ++j) {
                const int s2 = 64 * j + lane; const bool v = s2 < n;
                const unsigned key = v ? ordkey(scq[s2]) : 0u;
                const bool gt = v && key > T, eq = v && key == T;
                const unsigned long long em = __ballot(eq);
                const unsigned rank = taken + (unsigned)__popcll(em & ((1ull << lane) - 1ull));
                const bool sel = gt || (eq && rank < (unsigned)kk);
                taken += (unsigned)__popcll(em);
                const unsigned long long w = __ballot(sel);
                if (lane == j) myword = w;
            }
            stage[F.wave * 64 + lane] = myword;
        } else if (n <= 256) stage[F.wave * 64 + lane] = myword;
    }
    __syncthreads();
    { const int j = F.tid >> 3, tq = F.tid & 7; maskw[((size_t)b * 64 + j) * 4096 + t0 + tq] = stage[tq * 64 + j]; }
}
__device__ __forceinline__ void p_index(Frame& F, const bf16* QI, const bf16* KI, const float* WI, unsigned long long* maskw) {
    bf16x8 qf[2][4], qn[2][4]; f32x4 wv[2][2][2], wn[2][2][2];
    int L = F.vcu; if (L >= 4096) return;
    int b, t0; { const int i = L >> 8, v = L & 255; b = i >> 1; t0 = 8 * ((i & 1) ? 511 - v : v); }
    IDX_LOAD_QW(qf, wv, b, t0);
    for (;;) {
        const int Ln = L + F.G; const bool has_next = Ln < 4096;
        int bn = b, t0n = t0; if (has_next) { const int i = Ln >> 8, v = Ln & 255; bn = i >> 1; t0n = 8 * ((i & 1) ? 511 - v : v); }
        index_tile(F, b, t0, QI, KI, WI, maskw, qf, wv, qn, wn, has_next, bn, t0n);
        if (!has_next) break;
#pragma unroll
        for (int R = 0; R < 2; ++R) {
#pragma unroll
            for (int ks = 0; ks < 4; ++ks) qf[R][ks] = qn[R][ks];
#pragma unroll
            for (int tt = 0; tt < 2; ++tt) { wv[R][tt][0] = wn[R][tt][0]; wv[R][tt][1] = wn[R][tt][1]; } }
        L = Ln; b = bn; t0 = t0n;
    }
}

__device__ __forceinline__ float mask_sel(float p, unsigned bits, int c) {
    const unsigned m = (unsigned)__builtin_amdgcn_sbfe((int)bits, (unsigned)c, 1u);
    return __uint_as_float((m & __float_as_uint(p)) | (~m & 0xff800000u));
}
__device__ __forceinline__ void attnB_unit(Frame& F, int b, int kvh, int blkq, const bf16* Q, const bf16* K, const bf16* V, const bf16* G, const unsigned long long* maskw, bf16* Z) {
    const int lane = F.lane, q32 = lane & 31, hi = lane >> 5, w = F.wave;
    const int head = 4 * kvh + (w >> 1), tok = blkq * 64 + 32 * (w & 1) + q32;
    const size_t grow = (size_t)b * SEQ + tok;
    const int NT = blkq + 1;
    bf16x8 qf[4];
    { const bf16* qrow = Q + grow * 1024 + head * 64 + 8 * hi;
#pragma unroll
      for (int ks = 0; ks < 4; ++ks) qf[ks] = *(const bf16x8*)(qrow + 16 * ks); }
    LAS unsigned char* Kb = F.lds; LAS unsigned char* Vb = F.lds + 16384;
    const int srow = F.tid >> 3, sch = F.tid & 7;
    const bf16* ksrc = K + ((size_t)b * SEQ + srow) * 256 + kvh * 64 + 8 * sch;
    const bf16* vsrc = V + ((size_t)b * SEQ + srow) * 256 + kvh * 64 + 8 * sch;
    const unsigned long long* mp = maskw + (size_t)b * 64 * 4096 + tok;
    v4u kreg = *(const v4u*)ksrc, vreg = *(const v4u*)vsrc;
    unsigned long long mw_next = mp[0];
    *(LAS v4u*)(Kb + kimg(srow, sch)) = kreg; *(LAS v4u*)(Vb + vimg(srow, sch)) = vreg;
    __syncthreads();
    f32x16 o0 = {}, o1 = {}, ol = {}, negm = {};
    const short one = (q32 == 0) ? (short)0x3F80 : (short)0;
    const bf16x8 ones = (bf16x8){one, one, one, one, one, one, one, one};
    const int q4 = (lane & 15) >> 2, blk = (lane >> 4) & 1, p4 = lane & 3;
    const unsigned koff0 = kimg(q32, hi), voff0 = vimg(4 * hi + q4, 2 * blk + (p4 >> 1)) + 8 * (p4 & 1);
    for (int j = 0; j < NT; ++j) {
        const unsigned long long mw = mw_next;
        if (j + 1 < NT) { kreg = *(const v4u*)(ksrc + (size_t)(j + 1) * 64 * 256); vreg = *(const v4u*)(vsrc + (size_t)(j + 1) * 64 * 256); mw_next = mp[(size_t)(j + 1) * 4096]; }
        const LAS unsigned char* Kc = Kb + (j & 1) * 8192; const LAS unsigned char* Vc = Vb + (j & 1) * 8192;
        f32x16 p0 = negm, p1 = negm;
#pragma unroll
        for (int ks = 0; ks < 4; ++ks) {
            const bf16x8 ka = *(const LAS bf16x8*)(Kc + kimg(q32, 2 * ks + hi)), kb2 = *(const LAS bf16x8*)(Kc + kimg(32 + q32, 2 * ks + hi));
            p0 = MFMA32(ka, qf[ks], p0); p1 = MFMA32(kb2, qf[ks], p1);
        }
        const unsigned b0 = (unsigned)mw >> (4 * hi), b1 = (unsigned)(mw >> 32) >> (4 * hi);
#pragma unroll
        for (int r = 0; r < 16; ++r) { p0[r] = mask_sel(p0[r], b0, (r & 3) + 8 * (r >> 2)); p1[r] = mask_sel(p1[r], b1, (r & 3) + 8 * (r >> 2)); }
        float rm = fmaxf(p0[0], p1[0]);
#pragma unroll
        for (int r = 1; r < 16; ++r) rm = fmaxf(fmaxf(rm, p0[r]), p1[r]);
        rm = swap_max(rm);
        if (j == 0 || __any(rm > 8.0f)) {
            const float delta = (j == 0) ? ((rm > -INFINITY) ? rm : 0.f) : fmaxf(rm, 0.f);
#pragma unroll
            for (int r = 0; r < 16; ++r) { p0[r] -= delta; p1[r] -= delta; negm[r] -= delta; }
            if (j != 0) { const float alpha = __builtin_amdgcn_exp2f(-delta);
#pragma unroll
                for (int r = 0; r < 16; ++r) { o0[r] *= alpha; o1[r] *= alpha; ol[r] *= alpha; } }
        }
#pragma unroll
        for (int r = 0; r < 16; ++r) { p0[r] = __builtin_amdgcn_exp2f(p0[r]); p1[r] = __builtin_amdgcn_exp2f(p1[r]); }
        bf16x8 pf[4];
#pragma unroll
        for (int ks = 0; ks < 2; ++ks) {
            v4u wa, wb;
            wa.x = cvtpk(p0[8 * ks + 0], p0[8 * ks + 1]); wa.y = cvtpk(p0[8 * ks + 2], p0[8 * ks + 3]); wa.z = cvtpk(p0[8 * ks + 4], p0[8 * ks + 5]); wa.w = cvtpk(p0[8 * ks + 6], p0[8 * ks + 7]);
            wb.x = cvtpk(p1[8 * ks + 0], p1[8 * ks + 1]); wb.y = cvtpk(p1[8 * ks + 2], p1[8 * ks + 3]); wb.z = cvtpk(p1[8 * ks + 4], p1[8 * ks + 5]); wb.w = cvtpk(p1[8 * ks + 6], p1[8 * ks + 7]);
            pf[ks] = __builtin_bit_cast(bf16x8, wa); pf[2 + ks] = __builtin_bit_cast(bf16x8, wb);
        }
#pragma unroll
        for (int kq = 0; kq < 4; ++kq) {
#pragma unroll
            for (int d0 = 0; d0 < 2; ++d0) {
                const s16x4 lo = vtr(Vc + vimg(16 * kq + 4 * hi + q4, 4 * d0 + 2 * blk + (p4 >> 1)) + 8 * (p4 & 1));
                const s16x4 up = vtr(Vc + vimg(16 * kq + 8 + 4 * hi + q4, 4 * d0 + 2 * blk + (p4 >> 1)) + 8 * (p4 & 1));
                const bf16x8 vf = (bf16x8){lo[0], lo[1], lo[2], lo[3], up[0], up[1], up[2], up[3]};
                if (d0 == 0) o0 = MFMA32(vf, pf[kq], o0); else o1 = MFMA32(vf, pf[kq], o1);
            }
            ol = MFMA32(ones, pf[kq], ol);
        }
        if (j + 1 < NT) { *(LAS v4u*)(Kb + ((j + 1) & 1) * 8192 + kimg(srow, sch)) = kreg; *(LAS v4u*)(Vb + ((j + 1) & 1) * 8192 + vimg(srow, sch)) = vreg; }
        __syncthreads();
    }
    (void)koff0; (void)voff0;
    const float l_tot = swap_sum(ol[0]), inv = 1.0f / l_tot;
    const bf16* grow_p = G + grow * 1024 + head * 64;
    bf16* zrow = Z + grow * 1024 + head * 64;
#pragma unroll
    for (int g4 = 0; g4 < 4; ++g4) {
        const u32x2 ga = *(const u32x2*)(grow_p + 8 * g4 + 4 * hi), gb = *(const u32x2*)(grow_p + 32 + 8 * g4 + 4 * hi);
        *(u32x2*)(zrow + 8 * g4 + 4 * hi) = (u32x2){cvtpk(o0[4 * g4] * inv * bf_lo(ga.x), o0[4 * g4 + 1] * inv * bf_hi(ga.x)), cvtpk(o0[4 * g4 + 2] * inv * bf_lo(ga.y), o0[4 * g4 + 3] * inv * bf_hi(ga.y))};
        *(u32x2*)(zrow + 32 + 8 * g4 + 4 * hi) = (u32x2){cvtpk(o1[4 * g4] * inv * bf_lo(gb.x), o1[4 * g4 + 1] * inv * bf_hi(gb.x)), cvtpk(o1[4 * g4 + 2] * inv * bf_lo(gb.y), o1[4 * g4 + 3] * inv * bf_hi(gb.y))};
    }
}
__device__ __forceinline__ void p_attnB(Frame& F, const bf16* Q, const bf16* K, const bf16* V, const bf16* G, const unsigned long long* maskw, bf16* Z) {
    for (int L = F.vcu; L < 2048; L += F.G) {
        const int i = L >> 8, v = L & 255, bh = v >> 3, s = v & 7;
        const int blkq = 16 * (i >> 1) + ((i & 1) ? 15 - s : s);
        attnB_unit(F, bh >> 2, bh & 3, blkq, Q, K, V, G, maskw, Z);
    }
}

__device__ __forceinline__ cargs_t fresh_args() { cargs_t p = (cargs_t)__builtin_amdgcn_kernarg_segment_ptr(); asm volatile("" : "+s"(p)); return p; }
__global__ void __launch_bounds__(NWAVES * 64, 2) trunk_fwd(Args args_unused) {
    extern __shared__ __attribute__((aligned(16))) unsigned char lds[];
    Frame F;
    F.lds = (LAS unsigned char*)lds;
    F.MISC = (volatile LAS unsigned*)(F.lds + MISC_OFF);
    F.tid = threadIdx.x; F.lane = F.tid & 63; F.wave = __builtin_amdgcn_readfirstlane(F.tid >> 6);
    F.G = gridDim.x; F.bx = blockIdx.x; { const int bx = blockIdx.x; F.vcu = (F.G % 8 == 0) ? (bx % 8) * (F.G / 8) + bx / 8 : bx; }
    F.ctl = (gu32*)(fresh_args()->ws + WS_CTL);
    if (F.tid < 64) ((LAS unsigned*)(F.lds + MISC_OFF))[F.tid] = 0u;
    __syncthreads();
#if MK_ONE_LAUNCH
    XcdBarrier bar = xcd_barrier_post((unsigned*)(F.ctl + CW_BAR), F.MISC + 8);
#define SEAM() do { XcdBarrier b_ = bar; asm volatile("" : "+s"(b_.bar), "+s"(b_.x)); xcd_barrier(b_); } while (0)
#define RUN 1
#else
    int seam = 0; const int seg = fresh_args()->seg;
#define SEAM() (++seam)
#define RUN (seam == seg)
#endif
#define WSP(off) (A_->ws + (off))
#define FRESH_F() Frame Fp = F; { int t_ = threadIdx.x; asm volatile("" : "+v"(t_)); Fp.tid = t_; Fp.lane = t_ & 63; Fp.wave = __builtin_amdgcn_readfirstlane(t_ >> 6); asm volatile("" : "+s"(Fp.vcu), "+s"(Fp.G), "+s"(Fp.bx)); }
    if (DUP(0)) { { cargs_t A_ = fresh_args(); FRESH_F(); p_prologue(Fp, A_); } SEAM(); }
    if (P_ON(0) && RUN) { cargs_t A_ = fresh_args(); FRESH_F(); p_prologue(Fp, A_); }
    SEAM();
    for (int lp = 0; lp < 2; ++lp) {
        {
            const int layer = 2 * lp;
            for (int rep_ = 0; rep_ < 1 + DUP(1); ++rep_) { if (rep_) SEAM();
            if (P_ON(1) && RUN) { cargs_t A_ = fresh_args(); FRESH_F(); const float* hin = (layer == 0) ? A_->in[0] : A_->out;
                p_norm_mod(Fp, hin, A_->in[3] + (size_t)layer * 1024, (const float*)WSP(WS_MOD) + (size_t)layer * 8 * 3072, (bf16*)WSP(WS_U)); } }
            SEAM();
            for (int ch = 0; ch < NCHUNK; ++ch) {
                for (int rep_ = 0; rep_ < 1 + DUP(2); ++rep_) { if (rep_) SEAM();
                if (P_ON(2) && RUN) { cargs_t A_ = fresh_args();
                    pg8::Gemm g{(bf16*)WSP(WS_U) + (size_t)ch * MC * 1024, (bf16*)WSP(WS_WA) + (size_t)lp * A_N * 1024, MC, A_N, 1024};
                    pg8::StaticOrder S; { int g_ = F.G, b_ = F.bx; asm volatile("" : "+s"(g_), "+s"(b_)); S.init(MC, A_N, g_, b_); }
                    pg8::EpiA E{A_->ws, ch * MC};
                    pg8::gemm_phase<pg8::EpiA, pg8::StaticOrder, true, true>(F.lds, g, S, E);
                } }
                SEAM();
                if (DUP(3)) { { cargs_t A_ = fresh_args(); FRESH_F(); p_attnA(Fp, (bf16*)WSP(WS_ACT), (float*)WSP(WS_LSE), (bf16*)WSP(WS_END_A)); } SEAM(); }
                if (P_ON(3) && RUN) { cargs_t A_ = fresh_args(); FRESH_F(); p_attnA(Fp, (bf16*)WSP(WS_ACT), (float*)WSP(WS_LSE), nullptr); }
                SEAM();
                if (DUP(4)) { { cargs_t A_ = fresh_args(); FRESH_F(); p_mergeA(Fp, (const bf16*)WSP(WS_ACT), (const float*)WSP(WS_LSE), (bf16*)WSP(WS_U) + (size_t)ch * MC * 1024); } SEAM(); }
                if (P_ON(4) && RUN) { cargs_t A_ = fresh_args(); FRESH_F(); p_mergeA(Fp, (const bf16*)WSP(WS_ACT), (const float*)WSP(WS_LSE), (bf16*)WSP(WS_U) + (size_t)ch * MC * 1024); }
                SEAM();
            }
            for (int rep_ = 0; rep_ < 1 + ((DUP(5) && layer == 0) ? 1 : 0); ++rep_) { if (rep_) SEAM();
            if (P_ON(5) && RUN) { cargs_t A_ = fresh_args(); const float* hin = (layer == 0) ? A_->in[0] : A_->out;
                pg8::Gemm g{(bf16*)WSP(WS_U), (bf16*)WSP(WS_WO) + (size_t)layer * 1024 * 1024, MTOK, 1024, 1024};
                pg8::StaticOrder S; { int g_ = F.G, b_ = F.bx; asm volatile("" : "+s"(g_), "+s"(b_)); S.init(MTOK, 1024, g_, b_); }
                pg8::EpiOut E{hin, A_->out, (const float*)WSP(WS_MOD) + (size_t)layer * 8 * 3072 + 2048};
                pg8::gemm_phase<pg8::EpiOut, pg8::StaticOrder, true, true>(F.lds, g, S, E);
            } }
            SEAM();
        }
        {
            const int layer = 2 * lp + 1;
            if (P_ON(6) && RUN) { cargs_t A_ = fresh_args(); FRESH_F();
                p_norm_mod(Fp, A_->out, A_->in[3] + (size_t)layer * 1024, (const float*)WSP(WS_MOD) + (size_t)layer * 8 * 3072, (bf16*)WSP(WS_U)); }
            SEAM();
            for (int rep_ = 0; rep_ < 1 + DUP(7); ++rep_) { if (rep_) SEAM();
            if (P_ON(7) && RUN) { cargs_t A_ = fresh_args();
                pg8::Gemm g{(bf16*)WSP(WS_U), (bf16*)WSP(WS_WB) + (size_t)lp * B_NP * 1024, MTOK, B_NP, 1024};
                pg8::StaticOrder S; { int g_ = F.G, b_ = F.bx; asm volatile("" : "+s"(g_), "+s"(b_)); S.init(MTOK, B_NP, g_, b_); }
                pg8::EpiB E{A_->ws};
                pg8::gemm_phase<pg8::EpiB, pg8::StaticOrder, true, true>(F.lds, g, S, E);
            } }
            SEAM();
            if (DUP(8)) { { cargs_t A_ = fresh_args(); FRESH_F(); p_index(Fp, (const bf16*)WSP(WS_BQI), (const bf16*)WSP(WS_BKI), (const float*)WSP(WS_BWI), (unsigned long long*)WSP(WS_BMASK)); } SEAM(); }
            if (P_ON(8) && RUN) { cargs_t A_ = fresh_args(); FRESH_F(); p_index(Fp, (const bf16*)WSP(WS_BQI), (const bf16*)WSP(WS_BKI), (const float*)WSP(WS_BWI), (unsigned long long*)WSP(WS_BMASK)); }
            SEAM();
            if (DUP(9)) { { cargs_t A_ = fresh_args(); FRESH_F(); p_attnB(Fp, (const bf16*)WSP(WS_BQ), (const bf16*)WSP(WS_BK), (const bf16*)WSP(WS_BV), (const bf16*)WSP(WS_BG), (const unsigned long long*)WSP(WS_BMASK), (bf16*)WSP(WS_U)); } SEAM(); }
            if (P_ON(9) && RUN) { cargs_t A_ = fresh_args(); FRESH_F(); p_attnB(Fp, (const bf16*)WSP(WS_BQ), (const bf16*)WSP(WS_BK), (const bf16*)WSP(WS_BV), (const bf16*)WSP(WS_BG), (const unsigned long long*)WSP(WS_BMASK), (bf16*)WSP(WS_U)); }
            SEAM();
            if (P_ON(10) && RUN) { cargs_t A_ = fresh_args();
                pg8::Gemm g{(bf16*)WSP(WS_U), (bf16*)WSP(WS_WO) + (size_t)layer * 1024 * 1024, MTOK, 1024, 1024};
                pg8::StaticOrder S; { int g_ = F.G, b_ = F.bx; asm volatile("" : "+s"(g_), "+s"(b_)); S.init(MTOK, 1024, g_, b_); }
                pg8::EpiOut E{A_->out, A_->out, (const float*)WSP(WS_MOD) + (size_t)layer * 8 * 3072 + 2048};
                pg8::gemm_phase<pg8::EpiOut, pg8::StaticOrder, true, true>(F.lds, g, S, E);
            }
            SEAM();
        }
    }
#ifdef EXTRA_SEAMS
    for (int e_ = 0; e_ < EXTRA_SEAMS; ++e_) SEAM();
#endif
    if (P_ON(11) && RUN) { cargs_t A_ = fresh_args(); FRESH_F(); p_final_norm(Fp, A_->out, A_->in[10], A_->out); }
}

extern "C" void kernel_launch(void* const* d_in, const int* in_sizes, int n_in, void* d_out, int out_size, void* d_ws, size_t ws_size, hipStream_t stream) {
    static int grid = 0;
    if (grid == 0) {
        if (n_in != 11 || in_sizes[0] != MTOK * DM || out_size != MTOK * DM || ws_size < WS_NEED) {
            fprintf(stderr, "kernel_launch: unexpected shapes / workspace (n_in %d, in0 %d, out %d, ws %zu, need %zu); nothing launched\n", n_in, n_in > 0 ? in_sizes[0] : -1, out_size, ws_size, (size_t)WS_NEED); grid = -1; return; }
        int dev = 0, cus = 0, per_cu = 0;
        if (hipGetDevice(&dev) != hipSuccess || hipDeviceGetAttribute(&cus, hipDeviceAttributeMultiprocessorCount, dev) != hipSuccess) { fprintf(stderr, "kernel_launch: device query failed\n"); grid = -1; return; }
        if (hipFuncSetAttribute((const void*)trunk_fwd, hipFuncAttributeMaxDynamicSharedMemorySize, LDS_BYTES) != hipSuccess) { fprintf(stderr, "kernel_launch: hipFuncSetAttribute failed\n"); grid = -1; return; }
        if (hipOccupancyMaxActiveBlocksPerMultiprocessor(&per_cu, (const void*)trunk_fwd, NWAVES * 64, LDS_BYTES) != hipSuccess || per_cu < 1)
            fprintf(stderr, "kernel_launch: note: occupancy query reports %d workgroups per CU\n", per_cu);
        (void)hipGetLastError();
        grid = cus;
    }
    if (grid < 0) return;
    if (hipMemsetAsync((char*)d_ws + WS_CTL, 0, CTL_ZERO_BYTES, stream) != hipSuccess) { fprintf(stderr, "kernel_launch: memset failed\n"); return; }
    Args a{};
    for (int i = 0; i < 11; ++i) a.in[i] = (const float*)d_in[i];
    a.pos = (const int*)d_in[2]; a.out = (float*)d_out; a.ws = (unsigned char*)d_ws; a.seg = 0; a.pad = 0;
#if MK_ONE_LAUNCH
    hipLaunchKernelGGL(trunk_fwd, dim3(grid), dim3(NWAVES * 64), LDS_BYTES, stream, a);
#else
    for (int s = 0; s <= N_SEAMS; ++s) { a.seg = s; hipLaunchKernelGGL(trunk_fwd, dim3(grid), dim3(NWAVES * 64), LDS_BYTES, stream, a); }
#endif
    const hipError_t le = hipPeekAtLastError();
    if (le != hipSuccess) fprintf(stderr, "kernel_launch: launch failed: %s\n", hipGetErrorName(le));
}
```

```cpp
#include <hip/hip_runtime.h>
#include <cstdio>
#include <cstdint>
#include <cmath>
constexpr int NWAVES = 8;
constexpr int NB = 8, SEQ = 4096, DM = 1024, MTOK = NB * SEQ;
constexpr int A_N = 10240, B_NL = 3144, B_NP = 3328;
constexpr int MC = 8192, NCHUNK = MTOK / MC;
constexpr float NORM_EPS = 1e-6f;
#ifndef PMASK
#define PMASK 0xffff
#endif
#define P_ON(k) ((PMASK >> (k)) & 1)
#ifndef DUPMASK
#define DUPMASK 0
#endif
#define DUP(k) ((DUPMASK >> (k)) & 1)
#ifndef MK_ONE_LAUNCH
#define MK_ONE_LAUNCH 1
#endif
constexpr int N_SEAMS = 1 + 2 * ((1 + 3 * NCHUNK + 1) + 5);

constexpr size_t MiB = 1u << 20;
constexpr size_t WS_CTL = 0, CTL_ZERO_BYTES = 1 * MiB;
constexpr size_t WS_MOD = 1 * MiB;
constexpr size_t WS_COS = 2 * MiB, WS_SIN = 6 * MiB;
constexpr size_t WS_WA = 10 * MiB;
constexpr size_t WS_WB = 50 * MiB;
constexpr size_t WS_WO = 63 * MiB;
constexpr size_t WS_U = 72 * MiB;
constexpr size_t WS_ACT = 136 * MiB;
constexpr size_t A_SUB = (size_t)MC * 1024 * 2;
constexpr size_t WS_LSE = WS_ACT + 10 * A_SUB;
constexpr size_t WS_END_A = WS_LSE + (size_t)3 * MC * 16 * 4;
constexpr size_t WS_BQ = WS_ACT, WS_BK = WS_BQ + 64 * MiB, WS_BV = WS_BK + 16 * MiB, WS_BQI = WS_BV + 16 * MiB, WS_BKI = WS_BQI + 32 * MiB,
                 WS_BWI = WS_BKI + 4 * MiB, WS_BG = WS_BWI + 2 * MiB, WS_BMASK = WS_BG + 64 * MiB, WS_END_B = WS_BMASK + 16 * MiB;
constexpr size_t WS_NEED = (WS_END_A > WS_END_B ? WS_END_A : WS_END_B);
static_assert(WS_WA + (size_t)2 * A_N * 1024 * 2 <= WS_WB && WS_WB + (size_t)2 * B_NP * 1024 * 2 <= WS_WO && WS_WO + (size_t)4 * 1024 * 1024 * 2 <= WS_U && WS_U + (size_t)MTOK * 1024 * 2 <= WS_ACT, "ws map");
constexpr int CW_BAR = 4096;

namespace pg8 {
#define PG8_LAS __attribute__((address_space(3)))
typedef unsigned short bf16_t;
typedef short bf16x8 __attribute__((ext_vector_type(8)));
typedef float f32x4 __attribute__((ext_vector_type(4)));
typedef unsigned u32x4 __attribute__((ext_vector_type(4)));
constexpr int BM = 256, BK = 64, HALF = 128, HTB = HALF * BK * 2  , STAGE_BYTES = 8 * HTB, NXCD = 8, WGM = 8;

__host__ __device__ __forceinline__ int lds_byte(int r, int c) { const int st = (r >> 4) * 2 + (c >> 5), rr = r & 15, cc = c & 31, ob = rr * 64 + cc * 2; return st * 1024 + (ob ^ (((ob >> 9) & 1) << 5)); }
__host__ __device__ __forceinline__ void stage_rc(int b, int& R, int& C) { const int st = b / 1024, sb = b % 1024, swz = sb ^ (((sb >> 9) & 1) << 5); R = (st >> 1) * 16 + swz / 64; C = (st & 1) * 32 + (swz % 64) / 2; }
__host__ __device__ __forceinline__ int perm32(int rho) { const int n = rho >> 4, i = rho & 15; return 8 * (i >> 2) + 4 * n + (i & 3); }

struct Unit { int pm, pn; };
struct Gemm { const bf16_t* A; const bf16_t* Bt; int M, N, K; };

struct StaticOrder {
    int nM, nN, nwg, G, c;
    __host__ __device__ void init(int M, int N, int G_, int c_) { nM = M / BM; nN = N / BM; nwg = nM * nN; G = G_; c = c_; }
    __host__ __device__ bool next(int i, Unit& u) const {
        const long L = (long)i * G + c; if (L >= nwg) return false;
        int wgid = (int)L; { const int q = nwg / NXCD, r = nwg % NXCD, xcd = wgid % NXCD, off = wgid / NXCD; wgid = (xcd < r ? xcd * (q + 1) : r * (q + 1) + (xcd - r) * q) + off; }
        const int nig = WGM * nN, gid = wgid / nig, fm = gid * WGM, gsz = (nM - fm) < WGM ? (nM - fm) : WGM;
        u.pm = fm + ((wgid % nig) % gsz); u.pn = (wgid % nig) / gsz; return true;
    }
    __device__ __forceinline__ void a_ready(const Unit&) const {}
    __device__ __forceinline__ void done(const Unit&) const {}
};

__device__ __forceinline__ unsigned cvt_pk_bf16(float lo, float hi) { unsigned r; asm volatile("v_cvt_pk_bf16_f32 %0, %1, %2" : "=v"(r) : "v"(lo), "v"(hi)); return r; }
typedef float f32x2 __attribute__((ext_vector_type(2)));
constexpr float C2F = 0.125f * 1.4426950408889634f;
constexpr float WSC = 0.35355339059327373f * 0.125f;
__device__ __forceinline__ float silu_f(float x) { return x * __builtin_amdgcn_rcpf(1.0f + __builtin_amdgcn_exp2f(-1.4426950408889634f * x)); }
__device__ __forceinline__ f32x4 silu4(f32x4 v) { return (f32x4){silu_f(v[0]), silu_f(v[1]), silu_f(v[2]), silu_f(v[3])}; }
__device__ __forceinline__ u32x4 pack8(f32x4 a, f32x4 b) { u32x4 w; w.x = cvt_pk_bf16(a[0], a[1]); w.y = cvt_pk_bf16(a[2], a[3]); w.z = cvt_pk_bf16(b[0], b[1]); w.w = cvt_pk_bf16(b[2], b[3]); return w; }

__device__ __forceinline__ void epi_store_rows(const f32x4 (&acc)[2][2][4][2], int kind, bf16_t* ob, int pitch, int row0, int col0, int j0, const float* cs, const float* sn) {
#pragma unroll
    for (int ai = 0; ai < 2; ++ai) {
        f32x4 c4[8], s4[8];
        if (kind < 2) {
#pragma unroll
            for (int i = 0; i < 4; ++i) { const int row = row0 + ai * HALF + i * 16;
                c4[ai * 4 + i] = *(const f32x4*)(cs + (size_t)row * 32 + j0); s4[ai * 4 + i] = *(const f32x4*)(sn + (size_t)row * 32 + j0); }
        }
#pragma unroll
        for (int m = 0; m < 4; ++m) {
            const int row = row0 + ai * HALF + m * 16;
            bf16_t* rowp = ob + (size_t)row * pitch + col0;
#pragma unroll
            for (int bj = 0; bj < 2; ++bj) {
                f32x4 v0 = acc[ai][bj][m][0], v1 = acc[ai][bj][m][1];
                if (kind < 2) { const f32x4 o0 = v0 * c4[ai * 4 + m] - v1 * s4[ai * 4 + m], o1 = v1 * c4[ai * 4 + m] + v0 * s4[ai * 4 + m]; v0 = o0; v1 = o1; if (kind == 0) { v0 = v0 * C2F; v1 = v1 * C2F; } }
                else if (kind == 3) { v0 = silu4(v0); v1 = silu4(v1); }
                *(u32x4*)(rowp + bj * HALF) = pack8(v0, v1);
            }
        }
    }
}
struct EpiA {
    static constexpr bool PERM = true, AFTER_DRAIN = false;
    unsigned char* ws; int row_off;
    __device__ __forceinline__ void operator()(const f32x4 (&acc)[2][2][4][2], const Unit& u, int wr, int wc, int fr, int fq) const {
        asm volatile("" : "+v"(fr), "+v"(fq));
        const int t = u.pn >> 2, kind = (t == 9) ? 3 : (t % 3);
        const float* cs = (const float*)(ws + WS_COS) + (size_t)row_off * 32; const float* sn = (const float*)(ws + WS_SIN) + (size_t)row_off * 32;
        epi_store_rows(acc, kind, (bf16_t*)(ws + WS_ACT) + (size_t)t * (A_SUB / 2), 1024, u.pm * BM + wr * 64 + fr, (u.pn & 3) * BM + wc * 32 + 8 * fq, 16 * (wc & 1) + 4 * fq, cs, sn);
    }
};
struct EpiB {
    static constexpr bool PERM = true, AFTER_DRAIN = false;
    unsigned char* ws;
    __device__ __forceinline__ void operator()(const f32x4 (&acc)[2][2][4][2], const Unit& u, int wr, int wc, int fr, int fq) const {
        asm volatile("" : "+v"(fr), "+v"(fq));
        bf16_t* Q = (bf16_t*)(ws + WS_BQ); bf16_t* K = (bf16_t*)(ws + WS_BK); bf16_t* V = (bf16_t*)(ws + WS_BV); bf16_t* QI = (bf16_t*)(ws + WS_BQI); bf16_t* KI = (bf16_t*)(ws + WS_BKI); bf16_t* G = (bf16_t*)(ws + WS_BG);
        float* WI = (float*)(ws + WS_BWI); const float* cs = (const float*)(ws + WS_COS); const float* sn = (const float*)(ws + WS_SIN);
        const int pn = u.pn, row0 = u.pm * BM + wr * 64 + fr, cw = wc * 32 + 8 * fq, j0 = 16 * (wc & 1) + 4 * fq;
        if (pn < 4)       epi_store_rows(acc, 0, Q, 1024, row0, pn * BM + cw, j0, cs, sn);
        else if (pn == 4) epi_store_rows(acc, 1, K, 256, row0, cw, j0, cs, sn);
        else if (pn == 5) epi_store_rows(acc, 2, V, 256, row0, cw, j0, cs, sn);
        else if (pn < 8)  epi_store_rows(acc, 1, QI, 512, row0, (pn - 6) * BM + cw, j0, cs, sn);
        else if (pn > 8)  epi_store_rows(acc, 3, G, 1024, row0, (pn - 9) * BM + cw, j0, cs, sn);
        else {
#pragma unroll
            for (int ai = 0; ai < 2; ++ai)
#pragma unroll
                for (int m = 0; m < 4; ++m) {
                    const int row = row0 + ai * HALF + m * 16;
                    const f32x4 v0 = acc[ai][0][m][0], v1 = acc[ai][0][m][1];
                    if (wc < 2) {
                        const f32x4 c4 = *(const f32x4*)(cs + (size_t)row * 32 + j0), s4 = *(const f32x4*)(sn + (size_t)row * 32 + j0);
                        *(u32x4*)(KI + (size_t)row * 64 + cw) = pack8(v0 * c4 - v1 * s4, v1 * c4 + v0 * s4);
                    } else if (wc == 2 && fq == 0) {
                        *(f32x4*)(WI + (size_t)row * 8) = v0 * WSC; *(f32x4*)(WI + (size_t)row * 8 + 4) = v1 * WSC;
                    }
                }
        }
    }
};
struct EpiOut {
    static constexpr bool PERM = false, AFTER_DRAIN = false;
    const float* hin; float* hout; const float* gate;
    __device__ __forceinline__ void operator()(const f32x4 (&acc)[2][2][4][2], const Unit& u, int wr, int wc, int fr, int fq) const {
        asm volatile("" : "+v"(fr), "+v"(fq));
        const int col0 = u.pn * BM + wc * 32 + 4 * fq;
        const int b = (u.pm * BM) >> 12;
        f32x4 g4[2][2];
#pragma unroll
        for (int bj = 0; bj < 2; ++bj)
#pragma unroll
            for (int n = 0; n < 2; ++n) g4[bj][n] = *(const f32x4*)(gate + (size_t)b * 3072 + col0 + bj * HALF + n * 16);
#pragma unroll
        for (int ai = 0; ai < 2; ++ai) {
#pragma unroll
          for (int mh = 0; mh < 2; ++mh) {
            f32x4 h4[4][2][2];
#pragma unroll
            for (int m = 2 * mh; m < 2 * mh + 2; ++m) { const int row = u.pm * BM + ai * HALF + wr * 64 + m * 16 + fr;
#pragma unroll
                for (int bj = 0; bj < 2; ++bj)
#pragma unroll
                    for (int n = 0; n < 2; ++n) h4[m][bj][n] = *(const f32x4*)(hin + (size_t)row * 1024 + col0 + bj * HALF + n * 16); }
#pragma unroll
            for (int m = 2 * mh; m < 2 * mh + 2; ++m) { const int row = u.pm * BM + ai * HALF + wr * 64 + m * 16 + fr;
#pragma unroll
                for (int bj = 0; bj < 2; ++bj)
#pragma unroll
                    for (int n = 0; n < 2; ++n) *(f32x4*)(hout + (size_t)row * 1024 + col0 + bj * HALF + n * 16) = h4[m][bj][n] + g4[bj][n] * acc[ai][bj][m][n]; }
          }
        }
    }
};

template <class Epi, class Sched, bool ALIGN_EPI = false, bool SP2 = false>
__device__ __forceinline__ void gemm_phase(PG8_LAS unsigned char* lds, const Gemm g, const Sched& S, const Epi& E) {
    int tid_ = threadIdx.x; asm volatile("" : "+v"(tid_));
    const int tid = tid_, wid = __builtin_amdgcn_readfirstlane(tid >> 6), lane = tid & 63, wr = wid >> 2, wc = wid & 3, fr = lane & 15, fq = lane >> 4;
    const int K = g.K, nt = K / BK;
    unsigned voffA[2], voffB[2];
#pragma unroll
    for (int i = 0; i < 2; ++i) { int R, C; stage_rc(tid * 16 + i * 8192, R, C); const int Rb = Epi::PERM ? ((R & ~31) + perm32(R & 31)) : R;
        voffA[i] = (unsigned)(R * K + C) * 2u; voffB[i] = (unsigned)(Rb * K + C) * 2u; }
    const size_t kstep = (size_t)(BK * 2);
    const size_t hstep = (size_t)HALF * K * 2;
    const size_t tstep = 2 * hstep;
    const unsigned ldsw = (unsigned)wid * 1024u;
    const int aoff = lds_byte(wr * 64 + fr, fq * 8), boff = lds_byte(wc * 32 + fr, fq * 8);
#define PG8_SA(b, h) (((b) * 2 + (h)) * HTB)
#define PG8_SB(b, h) ((4 + (b) * 2 + (h)) * HTB)
#define PG8_STAGE(bufoff, gbase, voff) do { _Pragma("unroll") for (int _i = 0; _i < 2; ++_i) \
        __builtin_amdgcn_global_load_lds((const unsigned*)((const char*)(gbase) + (voff)[_i]), (PG8_LAS unsigned*)(lds + (bufoff) + ldsw + _i * 8192), 16, 0, 0); } while (0)
#define PG8_LDA(dst, b, h) do { _Pragma("unroll") for (int m = 0; m < 4; ++m) _Pragma("unroll") for (int k = 0; k < 2; ++k) dst[m][k] = *(const PG8_LAS bf16x8*)(lds + PG8_SA(b, h) + aoff + m * 2048 + k * 1024); } while (0)
#define PG8_LDB(dst, b, h) do { _Pragma("unroll") for (int n = 0; n < 2; ++n) _Pragma("unroll") for (int k = 0; k < 2; ++k) dst[n][k] = *(const PG8_LAS bf16x8*)(lds + PG8_SB(b, h) + boff + n * 2048 + k * 1024); } while (0)
#define PG8_MMA(ai, bj, At, Bt) do { __builtin_amdgcn_s_setprio(1); _Pragma("unroll") for (int m = 0; m < 4; ++m) _Pragma("unroll") for (int n = 0; n < 2; ++n) _Pragma("unroll") for (int k = 0; k < 2; ++k) \
        acc[ai][bj][m][n] = __builtin_amdgcn_mfma_f32_16x16x32_bf16(Bt[n][k], At[m][k], acc[ai][bj][m][n], 0, 0, 0); __builtin_amdgcn_s_setprio(0); } while (0)
#define PG8_WAIT_V(n) asm volatile("s_waitcnt vmcnt(" #n ")" ::: "memory")
#define PG8_WAIT_L(n) asm volatile("s_waitcnt lgkmcnt(" #n ")" ::: "memory")
#define PG8_BAR __builtin_amdgcn_s_barrier()
#define PG8_SCHED __builtin_amdgcn_sched_barrier(0)
    Unit cur, nxt; int ui = 0;
    if (!S.next(0, cur)) return;
    f32x4 acc[2][2][4][2];
#pragma unroll
    for (int a = 0; a < 2; ++a)
#pragma unroll
        for (int b = 0; b < 2; ++b)
#pragma unroll
            for (int m = 0; m < 4; ++m)
#pragma unroll
                for (int n = 0; n < 2; ++n) acc[a][b][m][n] = (f32x4){0.f, 0.f, 0.f, 0.f};
    bf16x8 At[4][2], B0[2][2], B1[2][2];
    const char* cA = (const char*)g.A + (size_t)cur.pm * tstep; const char* cB = (const char*)g.Bt + (size_t)cur.pn * tstep;
    S.a_ready(cur);
    if constexpr (SP2) {
        PG8_STAGE(PG8_SB(0, 0), cB, voffB); PG8_STAGE(PG8_SB(0, 1), cB + hstep, voffB); PG8_STAGE(PG8_SA(0, 0), cA, voffA); PG8_STAGE(PG8_SA(0, 1), cA + hstep, voffA);
        if (wr == 1) PG8_BAR;
        PG8_WAIT_V(2); PG8_BAR;
        PG8_STAGE(PG8_SB(1, 0), cB + kstep, voffB); PG8_STAGE(PG8_SA(1, 0), cA + kstep, voffA); PG8_STAGE(PG8_SB(1, 1), cB + hstep + kstep, voffB);
        PG8_WAIT_V(6); PG8_BAR;
    } else {
        PG8_STAGE(PG8_SB(0, 0), cB, voffB); PG8_STAGE(PG8_SA(0, 0), cA, voffA); PG8_STAGE(PG8_SB(0, 1), cB + hstep, voffB); PG8_STAGE(PG8_SA(0, 1), cA + hstep, voffA);
        if (wr == 1) PG8_BAR;
        PG8_WAIT_V(4); PG8_BAR;
        PG8_STAGE(PG8_SB(1, 0), cB + kstep, voffB); PG8_STAGE(PG8_SA(1, 0), cA + kstep, voffA); PG8_STAGE(PG8_SB(1, 1), cB + hstep + kstep, voffB);
        PG8_WAIT_V(6); PG8_BAR;
    }
    for (;;) {
        const bool has_next = S.next(ui + 1, nxt);
        const char* nA = has_next ? (const char*)g.A + (size_t)nxt.pm * tstep : cA; const char* nB = has_next ? (const char*)g.Bt + (size_t)nxt.pn * tstep : cB;
        for (int t = 0; t < nt; t += 2) {
            const bool last = (t == nt - 2);
            const char* a1 = cA + (size_t)(t + 1) * kstep;
            const char* a2 = last ? nA : cA + (size_t)(t + 2) * kstep; const char* b2 = last ? nB : cB + (size_t)(t + 2) * kstep;
            const char* a3 = a2 + kstep; const char* b3 = b2 + kstep;
            if (last && has_next) S.a_ready(nxt);
            if constexpr (SP2) {
            PG8_LDB(B0, 0, 0); PG8_LDB(B1, 0, 1); PG8_SCHED; PG8_LDA(At, 0, 0); PG8_STAGE(PG8_SA(1, 1), a1 + hstep, voffA);
            PG8_WAIT_V(8); PG8_WAIT_L(0); PG8_BAR; PG8_MMA(0, 0, At, B0); PG8_MMA(0, 1, At, B1); PG8_BAR; PG8_SCHED;
            PG8_LDA(At, 0, 1); PG8_STAGE(PG8_SB(0, 0), b2, voffB); PG8_STAGE(PG8_SB(0, 1), b2 + hstep, voffB); PG8_STAGE(PG8_SA(0, 0), a2, voffA);
            PG8_WAIT_V(8); PG8_WAIT_L(0); PG8_BAR; PG8_MMA(1, 0, At, B0); PG8_MMA(1, 1, At, B1); PG8_BAR; PG8_SCHED;
            PG8_LDB(B0, 1, 0); PG8_LDB(B1, 1, 1); PG8_SCHED; PG8_LDA(At, 1, 0); PG8_STAGE(PG8_SA(0, 1), a2 + hstep, voffA);
            PG8_WAIT_V(8); PG8_WAIT_L(0); PG8_BAR; PG8_MMA(0, 0, At, B0); PG8_MMA(0, 1, At, B1); PG8_BAR; PG8_SCHED;
            PG8_LDA(At, 1, 1); PG8_STAGE(PG8_SB(1, 0), b3, voffB); PG8_STAGE(PG8_SB(1, 1), b3 + hstep, voffB); PG8_STAGE(PG8_SA(1, 0), a3, voffA);
            PG8_WAIT_V(8); PG8_WAIT_L(0); PG8_BAR; PG8_MMA(1, 0, At, B0); PG8_MMA(1, 1, At, B1); PG8_BAR; PG8_SCHED;
            } else {
            PG8_LDB(B0, 0, 0); PG8_SCHED; PG8_LDA(At, 0, 0); PG8_STAGE(PG8_SA(1, 1), a1 + hstep, voffA);
            PG8_WAIT_L(8); PG8_BAR; PG8_WAIT_L(0); PG8_MMA(0, 0, At, B0); PG8_BAR; PG8_SCHED;
            PG8_LDB(B1, 0, 1); PG8_STAGE(PG8_SB(0, 0), b2, voffB);
            PG8_BAR; PG8_WAIT_L(0); PG8_MMA(0, 1, At, B1); PG8_BAR;
            PG8_LDA(At, 0, 1); PG8_STAGE(PG8_SA(0, 0), a2, voffA);
            PG8_BAR; PG8_WAIT_L(0); PG8_MMA(1, 0, At, B0); PG8_BAR; PG8_SCHED;
            PG8_STAGE(PG8_SB(0, 1), b2 + hstep, voffB);
            PG8_WAIT_V(6); PG8_BAR; PG8_MMA(1, 1, At, B1); PG8_BAR;
            PG8_LDB(B0, 1, 0); PG8_SCHED; PG8_LDA(At, 1, 0); PG8_STAGE(PG8_SA(0, 1), a2 + hstep, voffA);
            PG8_WAIT_L(8); PG8_BAR; PG8_WAIT_L(0); PG8_MMA(0, 0, At, B0); PG8_BAR; PG8_SCHED;
            PG8_LDB(B1, 1, 1); PG8_STAGE(PG8_SB(1, 0), b3, voffB);
            PG8_BAR; PG8_WAIT_L(0); PG8_MMA(0, 1, At, B1); PG8_BAR;
            PG8_LDA(At, 1, 1); PG8_STAGE(PG8_SA(1, 0), a3, voffA);
            PG8_BAR; PG8_WAIT_L(0); PG8_MMA(1, 0, At, B0); PG8_BAR; PG8_SCHED;
            PG8_STAGE(PG8_SB(1, 1), b3 + hstep, voffB);
            PG8_WAIT_V(6); PG8_BAR; PG8_MMA(1, 1, At, B1); PG8_BAR;
            }
        }
        if constexpr (ALIGN_EPI) { if (wr == 0) PG8_BAR; }
        if constexpr (!Epi::AFTER_DRAIN) { E(acc, cur, wr, wc, fr, fq); S.done(cur); }
        if (!has_next) break;
#pragma unroll
        for (int a = 0; a < 2; ++a)
#pragma unroll
            for (int b = 0; b < 2; ++b)
#pragma unroll
                for (int m = 0; m < 4; ++m)
#pragma unroll
                    for (int n = 0; n < 2; ++n) acc[a][b][m][n] = (f32x4){0.f, 0.f, 0.f, 0.f};
        cur = nxt; cA = nA; cB = nB; ++ui;
        if constexpr (ALIGN_EPI) { if (wr == 1) PG8_BAR; }
    }
    PG8_WAIT_V(0);
    if constexpr (!ALIGN_EPI) { if (wr == 0) PG8_BAR; }
    PG8_BAR;
    if constexpr (Epi::AFTER_DRAIN) { E.fused(acc, cur, wr, wc, fr, fq, lds, wid, lane); S.done(cur); }
#undef PG8_SA
#undef PG8_SB
#undef PG8_STAGE
#undef PG8_LDA
#undef PG8_LDB
#undef PG8_MMA
#undef PG8_WAIT_V
#undef PG8_WAIT_L
#undef PG8_BAR
#undef PG8_SCHED
}
}
#define GAS __attribute__((address_space(1)))
#define LAS __attribute__((address_space(3)))
typedef unsigned short bf16;
typedef unsigned v4u __attribute__((ext_vector_type(4)));
typedef float f32x4 __attribute__((ext_vector_type(4)));
typedef short bf16x8 __attribute__((ext_vector_type(8)));
typedef GAS unsigned gu32;
typedef GAS unsigned long long gu64;
#define RLX_AGENT __ATOMIC_RELAXED, __HIP_MEMORY_SCOPE_AGENT
#define LDS_WAIT() asm volatile("s_waitcnt lgkmcnt(0)" ::: "memory")
#define VM_WAIT() asm volatile("s_waitcnt vmcnt(0)" ::: "memory")
__device__ __forceinline__ unsigned long long rt() { return __builtin_amdgcn_s_memrealtime(); }
__device__ __forceinline__ unsigned f2bf(float f) { unsigned u = __builtin_bit_cast(unsigned, f); return (u + 0x7fffu + ((u >> 16) & 1u)) >> 16; }
__device__ __forceinline__ unsigned pk2(float lo, float hi) { return f2bf(lo) | (f2bf(hi) << 16); }

#define XB_TMO      128
#define XB_XCNT(j)  (256  + 64 * (j))
#define XB_XSUB(j)  (1280 + 64 * (j))
#define XB_XGEN(j)  (2304 + 64 * (j))
#define XB_TOP      3328
#define XB_TOPGEN   3392
#define XCD_BAR_WORDS 3456
#define XB_SPIN_CAP (1u << 18)

__device__ __forceinline__ unsigned xb_ld(unsigned* p)              { return __hip_atomic_load(p, __ATOMIC_RELAXED, __HIP_MEMORY_SCOPE_AGENT); }
__device__ __forceinline__ unsigned xb_add(unsigned* p, unsigned v) { return __hip_atomic_fetch_add(p, v, __ATOMIC_RELAXED, __HIP_MEMORY_SCOPE_AGENT); }
__device__ __forceinline__ unsigned xb_xcc_id() { return (unsigned)__builtin_amdgcn_s_getreg((3 << 11) | 20) & 0xFu; }
#define XB_SPIN(cond, bar) do { unsigned _sp = 0; while (cond) { __builtin_amdgcn_s_sleep(1); \
    if ((++_sp & 255u) == 0u) { if (xb_ld(&(bar)[XB_TMO])) break; if (_sp > XB_SPIN_CAP) { atomicAdd(&(bar)[XB_TMO], 1u); break; } } } } while (0)

struct XcdBarrier {
    unsigned* bar; unsigned x;
    volatile LAS unsigned* st;
};

__device__ __forceinline__ XcdBarrier xcd_barrier_post(unsigned* bar, volatile LAS unsigned* st) {
    XcdBarrier b; b.bar = bar; b.x = xb_xcc_id(); b.st = st;
    if (threadIdx.x == 0) (void)xb_add(&bar[XB_XCNT(b.x)], 1u);
    return b;
}
__device__ __forceinline__ void xcd_barrier_complete(unsigned* bar, unsigned x, unsigned& nloc, unsigned& nx) {
    const unsigned G = gridDim.x * gridDim.y * gridDim.z;
    unsigned sum, cnt, mine, sp = 0u;
    for (;;) {
        sum = 0u; cnt = 0u; mine = 0u;
#pragma unroll
        for (unsigned j = 0; j < 16; ++j) { const unsigned c = xb_ld(&bar[XB_XCNT(j)]); sum += c; cnt += (c > 0u) ? 1u : 0u; mine = (j == x) ? c : mine; }
        if (sum == G) break;
        __builtin_amdgcn_s_sleep(1);
        if ((++sp & 255u) == 0u) { if (xb_ld(&bar[XB_TMO])) break; if (sp > XB_SPIN_CAP) { atomicAdd(&bar[XB_TMO], 1u); break; } }
    }
    nloc = mine > 0u ? mine : 1u; nx = cnt > 0u ? cnt : 1u;
}

__device__ __forceinline__ void xcd_barrier(const XcdBarrier& b) {
    asm volatile("s_waitcnt vmcnt(0)" ::: "memory");
    __syncthreads();
    if (threadIdx.x == 0) {
        unsigned* bar = b.bar;
        __builtin_amdgcn_s_waitcnt(0);
        unsigned nloc = b.st[0], nx = b.st[1];
        if (nloc == 0u) { xcd_barrier_complete(bar, b.x, nloc, nx); b.st[0] = nloc; b.st[1] = nx; }
        const unsigned old = xb_add(&bar[XB_XSUB(b.x)], 1u);
        const unsigned gen = old / nloc;
        if (old + 1u == (gen + 1u) * nloc) {
            __builtin_amdgcn_fence(__ATOMIC_RELEASE, "agent");
            asm volatile("s_waitcnt vmcnt(0)" ::: "memory");
            const unsigned og = xb_add(&bar[XB_TOP], 1u);
            const unsigned tg = og / nx;
            if (og + 1u == (tg + 1u) * nx) xb_add(&bar[XB_TOPGEN], 1u);
            else XB_SPIN(xb_ld(&bar[XB_TOPGEN]) == tg, bar);
            __builtin_amdgcn_fence(__ATOMIC_ACQUIRE, "agent");
            xb_add(&bar[XB_XGEN(b.x)], 1u);
            asm volatile("s_waitcnt vmcnt(0)" ::: "memory");
        } else {
            XB_SPIN(xb_ld(&bar[XB_XGEN(b.x)]) == gen, bar);
            __builtin_amdgcn_fence(__ATOMIC_ACQUIRE, "agent");
            asm volatile("s_waitcnt vmcnt(0)" ::: "memory");
        }
    }
    __syncthreads();
}

constexpr int RING_BYTES = 131072;
constexpr int SEL_HIST_OFF = 131072, SEL_CAND_OFF = SEL_HIST_OFF + 16384, SEL_STAGE_OFF = SEL_CAND_OFF + 4096, MISC_OFF = SEL_STAGE_OFF + 4096, LDS_BYTES = 159744;
static_assert(MISC_OFF + 256 <= LDS_BYTES, "LDS map");

typedef short s16x4 __attribute__((ext_vector_type(4)));
typedef short v4i16_t __attribute__((ext_vector_type(4)));
typedef float f32x16 __attribute__((ext_vector_type(16)));
typedef unsigned u32x2 __attribute__((ext_vector_type(2)));
__device__ __forceinline__ float wave_sum(float v) {
#pragma unroll
    for (int o = 1; o < 64; o <<= 1) v += __shfl_xor(v, o);
    return v;
}
__device__ __forceinline__ unsigned cvtpk(float lo, float hi) { unsigned r; asm volatile("v_cvt_pk_bf16_f32 %0, %1, %2" : "=v"(r) : "v"(lo), "v"(hi)); return r; }
__device__ __forceinline__ float bf_lo(unsigned w) { return __uint_as_float(w << 16); }
__device__ __forceinline__ float bf_hi(unsigned w) { return __uint_as_float(w & 0xffff0000u); }
__device__ __forceinline__ float swap_max(float m) { auto rr = __builtin_amdgcn_permlane32_swap(__float_as_uint(m), __float_as_uint(m), false, false); return fmaxf(__uint_as_float(rr[0]), __uint_as_float(rr[1])); }
__device__ __forceinline__ float swap_sum(float m) { auto rr = __builtin_amdgcn_permlane32_swap(__float_as_uint(m), __float_as_uint(m), false, false); return __uint_as_float(rr[0]) + __uint_as_float(rr[1]); }
__device__ __forceinline__ int crow(int r, int hi) { return (r & 3) + 8 * (r >> 2) + 4 * hi; }
__device__ __forceinline__ unsigned vimg(unsigned row, unsigned ch) { return row * 128u + 16u * (ch ^ ((row & 3u) | (((row >> 1) & 1u) << 2))); }
__device__ __forceinline__ unsigned kimg(unsigned row, unsigned ch) { return row * 128u + 16u * (ch ^ ((row >> 1) & 7u)); }
__device__ __forceinline__ s16x4 vtr(const LAS unsigned char* p) { return __builtin_bit_cast(s16x4, __builtin_amdgcn_ds_read_tr16_b64_v4i16((LAS v4i16_t*)p)); }
#define MFMA32(a, b, c) __builtin_amdgcn_mfma_f32_32x32x16_bf16((a), (b), (c), 0, 0, 0)

struct Frame {
    LAS unsigned char* lds; volatile LAS unsigned* MISC; gu32* ctl;
    int tid, lane, wave, vcu, G, bx;
};
struct Args { const float* in[11]; const int* pos; float* out; unsigned char* ws; int seg; int pad; };
typedef const Args __attribute__((address_space(4)))* cargs_t;

__device__ __forceinline__ int rope_perm64(int c) { return ((c & 31) >> 2) * 8 + (c & 3) + ((c >> 5) << 2); }
template <int KIND> __device__ __forceinline__ int phys_row(int n) {
    if (KIND == 0) { if (n < 9216 && ((n >> 10) % 3) < 2) return (n & ~63) + rope_perm64(n & 63); return n; }
    if (KIND == 1) { if (n < 1280 || (n >= 1536 && n < 2112)) return (n & ~63) + rope_perm64(n & 63); if (n >= 2120) return n + 184; return n; }
    return n;
}
template <int KIND> __device__ __forceinline__ void transpose_item(const float* W, int K, int N, bf16* WT, LAS float* scr, int item, int lane) {
    const int nblk = (N + 31) / 32, kb = item / nblk, nb = item % nblk, k0 = 64 * kb, n0 = 32 * nb;
    const bool nok = n0 + (lane & 31) < N;
#pragma unroll 8
    for (int i = 0; i < 32; ++i) { const int kk = 2 * i + (lane >> 5); scr[kk * 33 + (lane & 31)] = nok ? W[(size_t)(k0 + kk) * N + n0 + (lane & 31)] : 0.f; }
    LDS_WAIT(); asm volatile("" ::: "memory");
    const int c = lane & 7;
#pragma unroll
    for (int j = 0; j < 4; ++j) { const int n = (lane >> 3) + 8 * j; const LAS float* s = scr + (8 * c) * 33 + n;
        v4u o; o.x = pk2(s[0 * 33], s[1 * 33]); o.y = pk2(s[2 * 33], s[3 * 33]); o.z = pk2(s[4 * 33], s[5 * 33]); o.w = pk2(s[6 * 33], s[7 * 33]);
        if (n0 + n < N) *(GAS v4u*)(WT + (size_t)phys_row<KIND>(n0 + n) * K + k0 + 8 * c) = o; }
    LDS_WAIT(); asm volatile("" ::: "memory");
}
__constant__ float INVF[32] = {1.000000000e+00f, 7.498942614e-01f, 5.623413324e-01f, 4.216965139e-01f, 3.162277639e-01f, 2.371373773e-01f, 1.778279394e-01f, 1.333521307e-01f, 1.000000015e-01f, 7.498941571e-02f,
    5.623413250e-02f, 4.216965288e-02f, 3.162277490e-02f, 2.371373773e-02f, 1.778279431e-02f, 1.333521493e-02f, 9.999999776e-03f, 7.498941850e-03f, 5.623413250e-03f, 4.216964822e-03f, 3.162277630e-03f, 2.371373586e-03f,
    1.778279431e-03f, 1.333521446e-03f, 1.000000047e-03f, 7.498942432e-04f, 5.623413017e-04f, 4.216965172e-04f, 3.162277571e-04f, 2.371373703e-04f, 1.778279402e-04f, 1.333521504e-04f};

__device__ __forceinline__ void p_prologue(Frame& F, cargs_t ap) {
    const float* const* in_ = nullptr; (void)in_;
    struct { const float* in[11]; const int* pos; unsigned char* ws; } a;
#pragma unroll
    for (int i = 0; i < 11; ++i) a.in[i] = ap->in[i];
    a.pos = ap->pos; a.ws = ap->ws;
    unsigned char* ws = a.ws;
    LAS float* scr = (LAS float*)(F.lds + F.wave * 12288);
    const int gw = F.vcu * NWAVES + F.wave, NGW = F.G * NWAVES;
    constexpr int I_A = 16 * (A_N / 32), I_B = 16 * ((B_NL + 31) / 32), I_O = 16 * 32;
    constexpr int NITEMS = 2 * I_A + 2 * I_B + 4 * I_O;
    for (int it = gw; it < NITEMS; it += NGW) {
        int r = it;
        if (r < 2 * I_A) { const int l = r / I_A; transpose_item<0>(a.in[6] + (size_t)l * 1024 * A_N, 1024, A_N, (bf16*)(ws + WS_WA) + (size_t)l * A_N * 1024, scr, r % I_A, F.lane); continue; } r -= 2 * I_A;
        if (r < 2 * I_B) { const int l = r / I_B; transpose_item<1>(a.in[8] + (size_t)l * 1024 * B_NL, 1024, B_NL, (bf16*)(ws + WS_WB) + (size_t)l * B_NP * 1024, scr, r % I_B, F.lane); continue; } r -= 2 * I_B;
        { const int l = r / I_O;
          const float* W = ((l & 1) ? a.in[9] : a.in[7]) + (size_t)(l >> 1) * 1024 * 1024;
          transpose_item<2>(W, 1024, 1024, (bf16*)(ws + WS_WO) + (size_t)l * 1024 * 1024, scr, r % I_O, F.lane); }
    }
    { const int gt = (F.vcu * NWAVES + F.wave) * 64 + F.lane, NGT = NGW * 64;
      for (int i = gt; i < 2 * 184 * 128; i += NGT) { const int l = i / (184 * 128), rr = (i / 128) % 184, c = i % 128;
          *(GAS v4u*)((bf16*)(ws + WS_WB) + (size_t)l * B_NP * 1024 + (size_t)(2120 + rr) * 1024 + c * 8) = (v4u){0u, 0u, 0u, 0u}; }
      float* cs = (float*)(ws + WS_COS); float* sn = (float*)(ws + WS_SIN);
      for (int i = gt; i < MTOK * 32; i += NGT) { const int tok = i >> 5, j = i & 31;
          const float angf = (float)a.pos[tok] * INVF[j]; const double x = (double)angf;
          const double k = __builtin_rint(x * 0.15915494309189535); double r = __builtin_fma(-k, 6.283185307179586, x); r = __builtin_fma(-k, 2.4492935982947064e-16, r);
          const float rf = (float)r; cs[i] = __cosf(rf); sn[i] = __sinf(rf); }
    }
    { LAS float* cact = (LAS float*)(F.lds + 98304);
      for (int i = F.tid; i < 8 * 1024; i += NWAVES * 64) { const float v = a.in[1][i]; cact[i] = v / (1.f + __expf(-v)); }
      __syncthreads();
      const float* adaw = a.in[4]; const float* adab = a.in[5]; float* mod = (float*)(ws + WS_MOD);
      const int col = F.lane & 15, kq = F.lane >> 4;
      for (int it = gw; it < 4 * 192; it += NGW) { const int l = it / 192, n0 = (it % 192) * 16;
          float acc[8];
#pragma unroll
          for (int b = 0; b < 8; ++b) acc[b] = 0.f;
          const float* wp = adaw + (size_t)l * 1024 * 3072 + (size_t)(kq * 256) * 3072 + n0 + col;
#pragma unroll 32
          for (int k = 0; k < 256; ++k) { const float w = wp[(size_t)k * 3072];
#pragma unroll
              for (int b = 0; b < 8; ++b) acc[b] += cact[b * 1024 + kq * 256 + k] * w; }
#pragma unroll
          for (int b = 0; b < 8; ++b) { float v = acc[b]; v += __shfl_xor(v, 16); v += __shfl_xor(v, 32); acc[b] = v; }
          if (kq == 0) {
#pragma unroll
              for (int b = 0; b < 8; ++b) mod[((size_t)l * 8 + b) * 3072 + n0 + col] = acc[b] + adab[(size_t)l * 3072 + n0 + col]; }
      }
    }
}

__device__ __forceinline__ void p_norm_mod(Frame& F, const float* hin, const float* g, const float* mod_l, bf16* U) {
    const int gw = F.vcu * NWAVES + F.wave, NGW = F.G * NWAVES;
    for (int r0 = gw * 16; r0 < MTOK; r0 += NGW * 16) {
        const int b = r0 >> 12;
        f32x4 A[4], Bv[4];
#pragma unroll
        for (int j = 0; j < 4; ++j) { const int c = 4 * F.lane + 256 * j; const f32x4 gg = *(const f32x4*)(g + c), sc = *(const f32x4*)(mod_l + (size_t)b * 3072 + 1024 + c);
            A[j] = gg * (sc + 1.0f); Bv[j] = *(const f32x4*)(mod_l + (size_t)b * 3072 + c); }
        for (int rr = 0; rr < 16; ++rr) {
            const int row = r0 + rr; const GAS f32x4* xr = (const GAS f32x4*)(hin + (size_t)row * DM) + F.lane;
            f32x4 v[4]; float s = 0.f;
#pragma unroll
            for (int j = 0; j < 4; ++j) { v[j] = xr[64 * j]; s += (v[j].x * v[j].x + v[j].y * v[j].y) + (v[j].z * v[j].z + v[j].w * v[j].w); }
            const float rstd = 1.0f / sqrtf(wave_sum(s) * (1.f / DM) + NORM_EPS);
            GAS u32x2* o8 = (GAS u32x2*)(U + (size_t)row * DM) + F.lane;
#pragma unroll
            for (int j = 0; j < 4; ++j) { const f32x4 y = (v[j] * rstd) * A[j] + Bv[j]; o8[64 * j] = (u32x2){cvtpk(y.x, y.y), cvtpk(y.z, y.w)}; }
        }
    }
}
__device__ __forceinline__ void p_final_norm(Frame& F, const float* hin, const float* g, float* out) {
    const int gw = F.vcu * NWAVES + F.wave, NGW = F.G * NWAVES;
    f32x4 A[4];
#pragma unroll
    for (int j = 0; j < 4; ++j) A[j] = *(const f32x4*)(g + 4 * F.lane + 256 * j);
    for (int row = gw; row < MTOK; row += NGW) {
        const GAS f32x4* xr = (const GAS f32x4*)(hin + (size_t)row * DM) + F.lane;
        f32x4 v[4]; float s = 0.f;
#pragma unroll
        for (int j = 0; j < 4; ++j) { v[j] = xr[64 * j]; s += (v[j].x * v[j].x + v[j].y * v[j].y) + (v[j].z * v[j].z + v[j].w * v[j].w); }
        const float rstd = 1.0f / sqrtf(wave_sum(s) * (1.f / DM) + NORM_EPS);
        GAS f32x4* o = (GAS f32x4*)(out + (size_t)row * DM) + F.lane;
#pragma unroll
        for (int j = 0; j < 4; ++j) o[64 * j] = (v[j] * rstd) * A[j];
    }
}

__device__ __forceinline__ void attnA_tile(const bf16* Qp, bf16* Op, const bf16* Kp, const bf16* Vp, float* lsep, int lse_stride, int rstride, int i0, LAS unsigned char* vst, int lane) {
    const int q32 = lane & 31, hi = lane >> 5;
    bf16x8 qf[4];
    { const bf16* qrow = Qp + (size_t)(i0 + q32) * rstride + 8 * hi;
#pragma unroll
      for (int ks = 0; ks < 4; ++ks) qf[ks] = *(const bf16x8*)(qrow + 16 * ks); }
    f32x16 o0 = {}, o1 = {};
    float m_run = -INFINITY, l_run = 0.f;
    const int kt0 = (i0 >= 128) ? 0 : (128 - i0) / 32;
    const int vc = lane & 7, vrow = lane >> 3;
    bf16x8 kall[5][4]; v4u vb[2][4];
#pragma unroll
    for (int kt = 0; kt < 5; ++kt) if (kt >= kt0) { const bf16* kr_ = Kp + (size_t)(i0 - 128 + 32 * kt + q32) * rstride + 8 * hi;
#pragma unroll
        for (int ks = 0; ks < 4; ++ks) kall[kt][ks] = *(const bf16x8*)(kr_ + 16 * ks); }
#define ATT_LOADV(kt_, buf_) do { _Pragma("unroll") for (int i = 0; i < 4; ++i) vb[buf_][i] = *(const v4u*)(Vp + (size_t)(i0 - 128 + 32 * (kt_) + vrow + 8 * i) * rstride + 8 * vc); } while (0)
#pragma unroll
    for (int kt = 0; kt < 5; ++kt) if (kt == kt0 || kt == kt0 + 1) ATT_LOADV(kt, kt & 1);
    const int q4 = (lane & 15) >> 2, blk = (lane >> 4) & 1, p4 = lane & 3;
#pragma unroll
    for (int kt = 0; kt < 5; ++kt) if (kt >= kt0) {
#pragma unroll
        for (int i = 0; i < 4; ++i) *(LAS v4u*)(vst + vimg(vrow + 8 * i, vc)) = vb[kt & 1][i];
        if (kt + 2 < 5) ATT_LOADV(kt + 2, kt & 1);
        bf16x8 kc[4];
#pragma unroll
        for (int ks = 0; ks < 4; ++ks) kc[ks] = kall[kt][ks];
        f32x16 p = {};
#pragma unroll
        for (int ks = 0; ks < 4; ++ks) p = MFMA32(kc[ks], qf[ks], p);
        if (kt == 0) {
#pragma unroll
            for (int r = 0; r < 16; ++r) if (crow(r, hi) < q32) p[r] = -INFINITY;
        }
        if (kt == 4) {
#pragma unroll
            for (int r = 0; r < 16; ++r) if (crow(r, hi) > q32) p[r] = -INFINITY;
        }
        float mt = p[0];
#pragma unroll
        for (int r = 1; r < 16; ++r) mt = fmaxf(mt, p[r]);
        mt = swap_max(mt);
        const float m_new = fmaxf(m_run, mt);
        const float alpha = __builtin_amdgcn_exp2f(m_run - m_new);
        float s = 0.f;
#pragma unroll
        for (int r = 0; r < 16; ++r) { p[r] = __builtin_amdgcn_exp2f(p[r] - m_new); s += p[r]; }
        l_run = l_run * alpha + s; m_run = m_new;
#pragma unroll
        for (int r = 0; r < 16; ++r) { o0[r] *= alpha; o1[r] *= alpha; }
        bf16x8 pf[2];
#pragma unroll
        for (int ks = 0; ks < 2; ++ks) { v4u w; w.x = cvtpk(p[8 * ks + 0], p[8 * ks + 1]); w.y = cvtpk(p[8 * ks + 2], p[8 * ks + 3]); w.z = cvtpk(p[8 * ks + 4], p[8 * ks + 5]); w.w = cvtpk(p[8 * ks + 6], p[8 * ks + 7]); pf[ks] = __builtin_bit_cast(bf16x8, w); }
        LDS_WAIT(); asm volatile("" ::: "memory");
#pragma unroll
        for (int ks = 0; ks < 2; ++ks)
#pragma unroll
            for (int d0 = 0; d0 < 2; ++d0) {
                const s16x4 lo = vtr(vst + vimg(16 * ks + 4 * hi + q4, 4 * d0 + 2 * blk + (p4 >> 1)) + 8 * (p4 & 1));
                const s16x4 up = vtr(vst + vimg(16 * ks + 8 + 4 * hi + q4, 4 * d0 + 2 * blk + (p4 >> 1)) + 8 * (p4 & 1));
                const bf16x8 vf = (bf16x8){lo[0], lo[1], lo[2], lo[3], up[0], up[1], up[2], up[3]};
                if (d0 == 0) o0 = MFMA32(vf, pf[ks], o0); else o1 = MFMA32(vf, pf[ks], o1);
            }
        LDS_WAIT(); asm volatile("" ::: "memory");
    }
#undef ATT_LOADV
    const float l_tot = swap_sum(l_run), inv = 1.0f / l_tot;
    bf16* orow = Op + (size_t)(i0 + q32) * rstride;
#pragma unroll
    for (int g4 = 0; g4 < 4; ++g4) {
        *(u32x2*)(orow + 8 * g4 + 4 * hi) = (u32x2){cvtpk(o0[4 * g4] * inv, o0[4 * g4 + 1] * inv), cvtpk(o0[4 * g4 + 2] * inv, o0[4 * g4 + 3] * inv)};
        *(u32x2*)(orow + 32 + 8 * g4 + 4 * hi) = (u32x2){cvtpk(o1[4 * g4] * inv, o1[4 * g4 + 1] * inv), cvtpk(o1[4 * g4 + 2] * inv, o1[4 * g4 + 3] * inv)};
    }
    if (hi == 0) lsep[(size_t)(i0 + q32) * lse_stride] = m_run + __builtin_amdgcn_logf(l_tot);
}
__device__ __forceinline__ void p_attnA(Frame& F, bf16* act, float* lse, bf16* dump) {
    LAS unsigned char* vst = F.lds + F.wave * 4096;
    constexpr int NBL = MC / SEQ, NUNITS = NBL * 3 * 16 * 16;
    for (int u = F.bx; u < NUNITS; u += F.G) {
        const int cb = u & 15, h = (u >> 4) & 15, g = (u >> 8) % 3, bl = u / 768;
        const int dl = (g == 0) ? 1 : (g == 1 ? 4 : 16), nbk = 16 / dl;
        const int r = cb / nbk, bk = cb % nbk;
        const size_t row_base = (size_t)bl * SEQ + r;
        bf16* Qp = act + (size_t)(3 * g + 0) * (A_SUB / 2) + row_base * 1024 + h * 64;
        const bf16* Kp = act + (size_t)(3 * g + 1) * (A_SUB / 2) + row_base * 1024 + h * 64;
        const bf16* Vp = act + (size_t)(3 * g + 2) * (A_SUB / 2) + row_base * 1024 + h * 64;
        float* lsep = lse + ((size_t)g * MC + row_base) * 16 + h;
        bf16* Op = dump ? dump + row_base * 1024 + h * 64 : Qp;
        attnA_tile(Qp, Op, Kp, Vp, lsep, 16 * dl, dl * 1024, bk * 256 + 32 * F.wave, vst, F.lane);
    }
}
__device__ __forceinline__ void p_mergeA(Frame& F, const bf16* act, const float* lse, bf16* Z  ) {
    const int gw = F.vcu * NWAVES + F.wave, NGW = F.G * NWAVES;
    const int head = F.lane >> 2;
    for (int row = gw; row < MC; row += NGW) {
        float l0 = lse[((size_t)0 * MC + row) * 16 + head], l1 = lse[((size_t)1 * MC + row) * 16 + head], l2 = lse[((size_t)2 * MC + row) * 16 + head];
        const float mx = fmaxf(l0, fmaxf(l1, l2));
        float e0 = __builtin_amdgcn_exp2f(l0 - mx), e1 = __builtin_amdgcn_exp2f(l1 - mx), e2 = __builtin_amdgcn_exp2f(l2 - mx);
        const float inv = 1.0f / (e0 + e1 + e2); e0 *= inv; e1 *= inv; e2 *= inv;
#pragma unroll
        for (int hf = 0; hf < 2; ++hf) {
            const size_t off = (size_t)row * 1024 + 16 * F.lane + 8 * hf;
            const v4u a0 = *(const v4u*)(act + (size_t)0 * (A_SUB / 2) + off), a1 = *(const v4u*)(act + (size_t)3 * (A_SUB / 2) + off), a2 = *(const v4u*)(act + (size_t)6 * (A_SUB / 2) + off),
                      gg = *(const v4u*)(act + (size_t)9 * (A_SUB / 2) + off);
            v4u o;
#pragma unroll
            for (int k = 0; k < 4; ++k) {
                const float ylo = (e0 * bf_lo(a0[k]) + e1 * bf_lo(a1[k]) + e2 * bf_lo(a2[k])) * bf_lo(gg[k]);
                const float yhi = (e0 * bf_hi(a0[k]) + e1 * bf_hi(a1[k]) + e2 * bf_hi(a2[k])) * bf_hi(gg[k]);
                o[k] = cvtpk(ylo, yhi);
            }
            *(v4u*)(Z + off) = o;
        }
    }
}

__device__ __forceinline__ unsigned ordkey(float f) { unsigned u = __float_as_uint(f); if ((u << 1) == 0u) u = 0u; return (u & 0x80000000u) ? ~u : (u | 0x80000000u); }
#define IDX_LOAD_QW(qf_, wv_, b_, t0_) do { const size_t tk_ = (size_t)(b_) * SEQ + (t0_); const int c32_ = F.lane & 31, hi_ = F.lane >> 5; \
        const int tl_ = 2 * ((c32_ >> 2) & 1) + (c32_ >> 4), hd_ = ((c32_ >> 3) & 1) * 4 + (c32_ & 3); \
        _Pragma("unroll") for (int R = 0; R < 2; ++R) { const bf16* qp_ = QI + (tk_ + 4 * R + tl_) * 512 + hd_ * 64 + 8 * hi_; \
            _Pragma("unroll") for (int ks = 0; ks < 4; ++ks) qf_[R][ks] = *(const bf16x8*)(qp_ + 16 * ks); \
            _Pragma("unroll") for (int tt = 0; tt < 2; ++tt) { const float* wp_ = WI + (tk_ + 4 * R + 2 * hi_ + tt) * 8; wv_[R][tt][0] = *(const f32x4*)wp_; wv_[R][tt][1] = *(const f32x4*)(wp_ + 4); } } } while (0)
__device__ __forceinline__ void index_tile(Frame& F, int b, int t0, const bf16* QI, const bf16* KI, const float* WI, unsigned long long* maskw,
                                           bf16x8 (&qf)[2][4], f32x4 (&wv)[2][2][2], bf16x8 (&qn)[2][4], f32x4 (&wn)[2][2][2], bool has_next, int bn, int t0n) {
    LAS float* sc = (LAS float*)F.lds;
    LAS unsigned* hist = (LAS unsigned*)(F.lds + SEL_HIST_OFF) + F.wave * 512;
    LAS unsigned* cand = (LAS unsigned*)(F.lds + SEL_CAND_OFF);
    LAS unsigned long long* stage = (LAS unsigned long long*)(F.lds + SEL_STAGE_OFF);
    const int lane = F.lane, c32 = lane & 31, hi = lane >> 5;
    const size_t tok0 = (size_t)b * SEQ + t0;
#ifndef IDX_REP_SCORE
#define IDX_REP_SCORE 1
#endif
#ifndef IDX_REP_SEL
#define IDX_REP_SEL 1
#endif
    for (int rep_ = 0; rep_ < IDX_REP_SCORE; ++rep_) {
        const int nkt = (t0 + 8 + 31) >> 5;
        bf16x8 kf[4], kg[4];
        const bf16* kbase = KI + ((size_t)b * SEQ + c32) * 64 + 8 * hi;
        int kt = F.wave;
        if (kt < nkt) {
#pragma unroll
            for (int ks = 0; ks < 4; ++ks) kf[ks] = *(const bf16x8*)(kbase + (size_t)kt * 32 * 64 + 16 * ks);
        }
        if (kt + NWAVES < nkt) {
#pragma unroll
            for (int ks = 0; ks < 4; ++ks) kg[ks] = *(const bf16x8*)(kbase + (size_t)(kt + NWAVES) * 32 * 64 + 16 * ks);
        }
        for (; kt < nkt; kt += NWAVES) {
            bf16x8 kc[4];
#pragma unroll
            for (int ks = 0; ks < 4; ++ks) { kc[ks] = kf[ks]; kf[ks] = kg[ks]; }
            if (kt + 2 * NWAVES < nkt) {
#pragma unroll
                for (int ks = 0; ks < 4; ++ks) kg[ks] = *(const bf16x8*)(kbase + (size_t)(kt + 2 * NWAVES) * 32 * 64 + 16 * ks);
            }
#pragma unroll
            for (int R = 0; R < 2; ++R) {
                f32x16 acc = {};
#pragma unroll
                for (int ks = 0; ks < 4; ++ks) acc = MFMA32(qf[R][ks], kc[ks], acc);
#pragma unroll
                for (int tt = 0; tt < 2; ++tt) {
                    float s = 0.f;
#pragma unroll
                    for (int i = 0; i < 8; ++i) s += wv[R][tt][i >> 2][i & 3] * fmaxf(acc[8 * tt + i], 0.f);
                    sc[(4 * R + 2 * hi + tt) * 4096 + kt * 32 + c32] = s;
                }
            }
        }
    }
    __syncthreads();
    if (has_next) IDX_LOAD_QW(qn, wn, bn, t0n);
    for (int rep_ = 0; rep_ < IDX_REP_SEL; ++rep_) {
        const int t = t0 + F.wave, n = t + 1;
        const LAS float* scq = sc + F.wave * 4096;
        unsigned long long myword = 0ull;
        bool done = false;
        if (n <= 256) {
            const int j = lane; const int rem = n - 64 * j;
            myword = rem >= 64 ? ~0ull : (rem > 0 ? ((1ull << rem) - 1ull) : 0ull);
            done = true;
        } else {
            float lo = INFINITY, hi = -INFINITY;
            for (int i = 0; i * 256 < n; ++i) { const int idx = 4 * (lane + 64 * i); const f32x4 v = *(const LAS f32x4*)(scq + idx);
#pragma unroll
                for (int e = 0; e < 4; ++e) if (idx + e < n) { lo = fminf(lo, v[e]); hi = fmaxf(hi, v[e]); } }
#pragma unroll
            for (int o = 1; o < 64; o <<= 1) { lo = fminf(lo, __shfl_xor(lo, o)); hi = fmaxf(hi, __shfl_xor(hi, o)); }
            if (hi > lo) {
                const float scale = 512.0f / (hi - lo);
                *(LAS v4u*)(hist + 8 * lane) = (v4u){0u, 0u, 0u, 0u}; *(LAS v4u*)(hist + 8 * lane + 4) = (v4u){0u, 0u, 0u, 0u};
                LDS_WAIT(); asm volatile("" ::: "memory");
                for (int i = 0; i * 256 < n; ++i) { const int idx = 4 * (lane + 64 * i); const f32x4 v = *(const LAS f32x4*)(scq + idx);
#pragma unroll
                    for (int e = 0; e < 4; ++e) if (idx + e < n) { const int bn = min(511, (int)((v[e] - lo) * scale));
                        __hip_atomic_fetch_add(hist + bn, 1u, __ATOMIC_RELAXED, __HIP_MEMORY_SCOPE_WORKGROUP); } }
                LDS_WAIT(); asm volatile("" ::: "memory");
                const v4u c0 = *(const LAS v4u*)(hist + 8 * lane), c1 = *(const LAS v4u*)(hist + 8 * lane + 4);
                unsigned cc[8] = {c0.x, c0.y, c0.z, c0.w, c1.x, c1.y, c1.z, c1.w};
                const unsigned ls = ((c0.x + c0.y) + (c0.z + c0.w)) + ((c1.x + c1.y) + (c1.z + c1.w));
                unsigned inc = ls;
#pragma unroll
                for (int o = 1; o < 64; o <<= 1) { const unsigned v = __shfl_up(inc, o); if (lane >= o) inc += v; }
                const unsigned total = __shfl(inc, 63);
                const unsigned S = total - inc;
                const bool found = (S < 256u) && (256u <= S + ls);
                unsigned acc = S; int bin = 0; unsigned above = S; bool got = false;
#pragma unroll
                for (int q = 7; q >= 0; --q) { if (!got) { if (acc + cc[q] >= 256u) { bin = q; above = acc; got = true; } else acc += cc[q]; } }
                const unsigned long long fm = __ballot(found);
                const int src = fm ? (__ffsll((long long)fm) - 1) : 0;
                const int B = __shfl(8 * lane + bin, src); const unsigned aboveb = __shfl(above, src);
                const unsigned mB = __shfl(cc[0] * 0u + ((bin == 0) ? cc[0] : (bin == 1) ? cc[1] : (bin == 2) ? cc[2] : (bin == 3) ? cc[3] : (bin == 4) ? cc[4] : (bin == 5) ? cc[5] : (bin == 6) ? cc[6] : cc[7]), src);
                const unsigned kk2 = 256u - aboveb;
                if (mB <= 64u) {
                    LAS unsigned* ckey = cand + F.wave * 128; LAS unsigned* cidx = ckey + 64;
                    unsigned base = 0u;
                    for (int j4 = 0; 256 * j4 < n; ++j4) {
                        float xs[4];
#pragma unroll
                        for (int c = 0; c < 4; ++c) xs[c] = scq[64 * (4 * j4 + c) + lane];
#pragma unroll
                        for (int c = 0; c < 4; ++c) {
                            const int j = 4 * j4 + c, sidx = 64 * j + lane; const bool v = sidx < n; const float x = xs[c];
                            const int bq = min(511, (int)((x - lo) * scale));
                            const bool gt = v && bq > B, eq = v && bq == B;
                            const unsigned long long wj = __ballot(gt), em = __ballot(eq);
                            if (eq) { const unsigned pos = base + (unsigned)__popcll(em & ((1ull << lane) - 1ull)); ckey[pos] = ordkey(x); cidx[pos] = (unsigned)sidx; }
                            base += (unsigned)__popcll(em);
                            if (lane == j) myword = wj;
                        }
                    }
                    stage[F.wave * 64 + lane] = myword;
                    LDS_WAIT(); asm volatile("" ::: "memory");
                    const unsigned m = base;
                    const unsigned mykey = (unsigned)lane < m ? ckey[lane] : 0u, myidx = (unsigned)lane < m ? cidx[lane] : 0u;
                    unsigned rank = 0u;
                    for (unsigned f = 0; f < m; ++f) { const unsigned kf = ckey[f]; rank += (kf > mykey || (kf == mykey && f < (unsigned)lane)) ? 1u : 0u; }
                    if ((unsigned)lane < m && rank < kk2)
                        __hip_atomic_fetch_or((LAS unsigned*)stage + F.wave * 128 + (myidx >> 5), 1u << (myidx & 31u), __ATOMIC_RELAXED, __HIP_MEMORY_SCOPE_WORKGROUP);
                    done = true;
                }
            }
        }
        if (!done) {
            unsigned T = 0u; int kk = 256; unsigned prefix = 0u;
#pragma unroll
            for (int pass = 0; pass < 4; ++pass) {
                const int shift = 24 - 8 * pass;
                *(LAS v4u*)(hist + 4 * lane) = (v4u){0u, 0u, 0u, 0u};
                LDS_WAIT(); asm volatile("" ::: "memory");
                for (int s2 = lane; s2 < n; s2 += 64) {
                    const unsigned key = ordkey(scq[s2]);
                    const bool in = (pass == 0) ? true : ((key >> ((shift + 8) & 31)) == prefix);
                    if (in) __hip_atomic_fetch_add(hist + ((key >> shift) & 255u), 1u, __ATOMIC_RELAXED, __HIP_MEMORY_SCOPE_WORKGROUP);
                }
                LDS_WAIT(); asm volatile("" ::: "memory");
                const v4u c = *(const LAS v4u*)(hist + 4 * lane);
                const unsigned ls = c.x + c.y + c.z + c.w;
                unsigned inc = ls;
#pragma unroll
                for (int o = 1; o < 64; o <<= 1) { const unsigned v = __shfl_up(inc, o); if (lane >= o) inc += v; }
                const unsigned total = __shfl(inc, 63);
                const unsigned S = total - inc;
                const bool found = (S < (unsigned)kk) && ((unsigned)kk <= S + ls);
                unsigned acc = S; int bin; unsigned above;
                if (acc + c.w >= (unsigned)kk) { bin = 3; above = acc; }
                else { acc += c.w; if (acc + c.z >= (unsigned)kk) { bin = 2; above = acc; }
                else { acc += c.z; if (acc + c.y >= (unsigned)kk) { bin = 1; above = acc; }
                else { acc += c.y; bin = 0; above = acc; } } }
                const unsigned long long fm = __ballot(found);
                const int src = fm ? (__ffsll((long long)fm) - 1) : 0;
                const int binb = __shfl(4 * lane + bin, src); const unsigned aboveb = __shfl(above, src);
                prefix = (prefix << 8) | (unsigned)binb; kk -= (int)aboveb;
            }
            T = prefix;
            unsigned taken = 0u; myword = 0ull;
            for (int j = 0; 64 * j < n; ++j) {
                const int s2 = 64 * j + lane; const bool v = s2 < n;
                const unsigned key = v ? ordkey(scq[s2]) : 0u;
                const bool gt = v && key > T, eq = v && key == T;
                const unsigned long long em = __ballot(eq);
                const unsigned rank = taken + (unsigned)__popcll(em & ((1ull << lane) - 1ull));
                const bool sel = gt || (eq && rank < (unsigned)kk);
                taken += (unsigned)__popcll(em);
                const unsigned long long w = __ballot(sel);
                if (lane == j) myword = w;
            }
            stage[F.wave * 64 + lane] = myword;
        } else if (n <= 256) stage[F.wave * 64 + lane] = myword;
    }
    __syncthreads();
    { const int j = F.tid >> 3, tq = F.tid & 7; maskw[((size_t)b * 64 + j) * 4096 + t0 + tq] = stage[tq * 64 + j]; }
}
__device__ __forceinline__ void p_index(Frame& F, const bf16* QI, const bf16* KI, const float* WI, unsigned long long* maskw) {
    bf16x8 qf[2][4], qn[2][4]; f32x4 wv[2][2][2], wn[2][2][2];
    int L = F.vcu; if (L >= 4096) return;
    int b, t0; { const int i = L >> 8, v = L & 255; b = i >> 1; t0 = 8 * ((i & 1) ? 511 - v : v); }
    IDX_LOAD_QW(qf, wv, b, t0);
    for (;;) {
        const int Ln = L + F.G; const bool has_next = Ln < 4096;
        int bn = b, t0n = t0; if (has_next) { const int i = Ln >> 8, v = Ln & 255; bn = i >> 1; t0n = 8 * ((i & 1) ? 511 - v : v); }
        index_tile(F, b, t0, QI, KI, WI, maskw, qf, wv, qn, wn, has_next, bn, t0n);
        if (!has_next) break;
#pragma unroll
        for (int R = 0; R < 2; ++R) {
#pragma unroll
            for (int ks = 0; ks < 4; ++ks) qf[R][ks] = qn[R][ks];
#pragma unroll
            for (int tt = 0; tt < 2; ++tt) { wv[R][tt][0] = wn[R][tt][0]; wv[R][tt][1] = wn[R][tt][1]; } }
        L = Ln; b = bn; t0 = t0n;
    }
}

__device__ __forceinline__ float mask_sel(float p, unsigned bits, int c) {
    const unsigned m = (unsigned)__builtin_amdgcn_sbfe((int)bits, (unsigned)c, 1u);
    return __uint_as_float((m & __float_as_uint(p)) | (~m & 0xff800000u));
}
__device__ __forceinline__ void attnB_unit(Frame& F, int b, int kvh, int blkq, const bf16* Q, const bf16* K, const bf16* V, const bf16* G, const unsigned long long* maskw, bf16* Z) {
    const int lane = F.lane, q32 = lane & 31, hi = lane >> 5, w = F.wave;
    const int head = 4 * kvh + (w >> 1), tok = blkq * 64 + 32 * (w & 1) + q32;
    const size_t grow = (size_t)b * SEQ + tok;
    const int NT = blkq + 1;
    bf16x8 qf[4];
    { const bf16* qrow = Q + grow * 1024 + head * 64 + 8 * hi;
#pragma unroll
      for (int ks = 0; ks < 4; ++ks) qf[ks] = *(const bf16x8*)(qrow + 16 * ks); }
    LAS unsigned char* Kb = F.lds; LAS unsigned char* Vb = F.lds + 16384;
    const int srow = F.tid >> 3, sch = F.tid & 7;
    const bf16* ksrc = K + ((size_t)b * SEQ + srow) * 256 + kvh * 64 + 8 * sch;
    const bf16* vsrc = V + ((size_t)b * SEQ + srow) * 256 + kvh * 64 + 8 * sch;
    const unsigned long long* mp = maskw + (size_t)b * 64 * 4096 + tok;
    v4u kreg = *(const v4u*)ksrc, vreg = *(const v4u*)vsrc;
    unsigned long long mw_next = mp[0];
    *(LAS v4u*)(Kb + kimg(srow, sch)) = kreg; *(LAS v4u*)(Vb + vimg(srow, sch)) = vreg;
    __syncthreads();
    f32x16 o0 = {}, o1 = {}, ol = {}, negm = {};
    const short one = (q32 == 0) ? (short)0x3F80 : (short)0;
    const bf16x8 ones = (bf16x8){one, one, one, one, one, one, one, one};
    const int q4 = (lane & 15) >> 2, blk = (lane >> 4) & 1, p4 = lane & 3;
    const unsigned koff0 = kimg(q32, hi), voff0 = vimg(4 * hi + q4, 2 * blk + (p4 >> 1)) + 8 * (p4 & 1);
    for (int j = 0; j < NT; ++j) {
        const unsigned long long mw = mw_next;
        if (j + 1 < NT) { kreg = *(const v4u*)(ksrc + (size_t)(j + 1) * 64 * 256); vreg = *(const v4u*)(vsrc + (size_t)(j + 1) * 64 * 256); mw_next = mp[(size_t)(j + 1) * 4096]; }
        const LAS unsigned char* Kc = Kb + (j & 1) * 8192; const LAS unsigned char* Vc = Vb + (j & 1) * 8192;
        f32x16 p0 = negm, p1 = negm;
        bf16x8 kfr[8];
#pragma unroll
        for (int ks = 0; ks < 4; ++ks) { kfr[2 * ks] = *(const LAS bf16x8*)(Kc + kimg(q32, 2 * ks + hi)); kfr[2 * ks + 1] = *(const LAS bf16x8*)(Kc + kimg(32 + q32, 2 * ks + hi)); }
#pragma unroll
        for (int ks = 0; ks < 4; ++ks) { p0 = MFMA32(kfr[2 * ks], qf[ks], p0); p1 = MFMA32(kfr[2 * ks + 1], qf[ks], p1); }
        s16x4 vlo[8], vup[8];
#pragma unroll
        for (int kq = 0; kq < 4; ++kq)
#pragma unroll
            for (int d0 = 0; d0 < 2; ++d0) {
                vlo[2 * kq + d0] = vtr(Vc + vimg(16 * kq + 4 * hi + q4, 4 * d0 + 2 * blk + (p4 >> 1)) + 8 * (p4 & 1));
                vup[2 * kq + d0] = vtr(Vc + vimg(16 * kq + 8 + 4 * hi + q4, 4 * d0 + 2 * blk + (p4 >> 1)) + 8 * (p4 & 1));
            }
        const unsigned b0 = (unsigned)mw >> (4 * hi), b1 = (unsigned)(mw >> 32) >> (4 * hi);
#pragma unroll
        for (int r = 0; r < 16; ++r) { p0[r] = mask_sel(p0[r], b0, (r & 3) + 8 * (r >> 2)); p1[r] = mask_sel(p1[r], b1, (r & 3) + 8 * (r >> 2)); }
        float rm = fmaxf(p0[0], p1[0]);
#pragma unroll
        for (int r = 1; r < 16; ++r) rm = fmaxf(fmaxf(rm, p0[r]), p1[r]);
        rm = swap_max(rm);
        if (j == 0 || __any(rm > 8.0f)) {
            const float delta = (j == 0) ? ((rm > -INFINITY) ? rm : 0.f) : fmaxf(rm, 0.f);
#pragma unroll
            for (int r = 0; r < 16; ++r) { p0[r] -= delta; p1[r] -= delta; negm[r] -= delta; }
            if (j != 0) { const float alpha = __builtin_amdgcn_exp2f(-delta);
#pragma unroll
                for (int r = 0; r < 16; ++r) { o0[r] *= alpha; o1[r] *= alpha; ol[r] *= alpha; } }
        }
#pragma unroll
        for (int r = 0; r < 16; ++r) { p0[r] = __builtin_amdgcn_exp2f(p0[r]); p1[r] = __builtin_amdgcn_exp2f(p1[r]); }
        bf16x8 pf[4];
#pragma unroll
        for (int ks = 0; ks < 2; ++ks) {
            v4u wa, wb;
            wa.x = cvtpk(p0[8 * ks + 0], p0[8 * ks + 1]); wa.y = cvtpk(p0[8 * ks + 2], p0[8 * ks + 3]); wa.z = cvtpk(p0[8 * ks + 4], p0[8 * ks + 5]); wa.w = cvtpk(p0[8 * ks + 6], p0[8 * ks + 7]);
            wb.x = cvtpk(p1[8 * ks + 0], p1[8 * ks + 1]); wb.y = cvtpk(p1[8 * ks + 2], p1[8 * ks + 3]); wb.z = cvtpk(p1[8 * ks + 4], p1[8 * ks + 5]); wb.w = cvtpk(p1[8 * ks + 6], p1[8 * ks + 7]);
            pf[ks] = __builtin_bit_cast(bf16x8, wa); pf[2 + ks] = __builtin_bit_cast(bf16x8, wb);
        }
#pragma unroll
        for (int kq = 0; kq < 4; ++kq) {
#pragma unroll
            for (int d0 = 0; d0 < 2; ++d0) {
                const s16x4 lo = vlo[2 * kq + d0], up = vup[2 * kq + d0];
                const bf16x8 vf = (bf16x8){lo[0], lo[1], lo[2], lo[3], up[0], up[1], up[2], up[3]};
                if (d0 == 0) o0 = MFMA32(vf, pf[kq], o0); else o1 = MFMA32(vf, pf[kq], o1);
            }
            ol = MFMA32(ones, pf[kq], ol);
        }
        if (j + 1 < NT) { *(LAS v4u*)(Kb + ((j + 1) & 1) * 8192 + kimg(srow, sch)) = kreg; *(LAS v4u*)(Vb + ((j + 1) & 1) * 8192 + vimg(srow, sch)) = vreg; }
        __syncthreads();
    }
    (void)koff0; (void)voff0;
    const float l_tot = swap_sum(ol[0]), inv = 1.0f / l_tot;
    const bf16* grow_p = G + grow * 1024 + head * 64;
    bf16* zrow = Z + grow * 1024 + head * 64;
#pragma unroll
    for (int g4 = 0; g4 < 4; ++g4) {
        const u32x2 ga = *(const u32x2*)(grow_p + 8 * g4 + 4 * hi), gb = *(const u32x2*)(grow_p + 32 + 8 * g4 + 4 * hi);
        *(u32x2*)(zrow + 8 * g4 + 4 * hi) = (u32x2){cvtpk(o0[4 * g4] * inv * bf_lo(ga.x), o0[4 * g4 + 1] * inv * bf_hi(ga.x)), cvtpk(o0[4 * g4 + 2] * inv * bf_lo(ga.y), o0[4 * g4 + 3] * inv * bf_hi(ga.y))};
        *(u32x2*)(zrow + 32 + 8 * g4 + 4 * hi) = (u32x2){cvtpk(o1[4 * g4] * inv * bf_lo(gb.x), o1[4 * g4 + 1] * inv * bf_hi(gb.x)), cvtpk(o1[4 * g4 + 2] * inv * bf_lo(gb.y), o1[4 * g4 + 3] * inv * bf_hi(gb.y))};
    }
}
__device__ __forceinline__ void p_attnB(Frame& F, const bf16* Q, const bf16* K, const bf16* V, const bf16* G, const unsigned long long* maskw, bf16* Z) {
    for (int L = F.vcu; L < 2048; L += F.G) {
        const int i = L >> 8, v = L & 255, bh = v >> 3, s = v & 7;
        const int blkq = 16 * (i >> 1) + ((i & 1) ? 15 - s : s);
        attnB_unit(F, bh >> 2, bh & 3, blkq, Q, K, V, G, maskw, Z);
    }
}

__device__ __forceinline__ cargs_t fresh_args() { cargs_t p = (cargs_t)__builtin_amdgcn_kernarg_segment_ptr(); asm volatile("" : "+s"(p)); return p; }
__global__ void __launch_bounds__(NWAVES * 64, 2) trunk_fwd(Args args_unused) {
    extern __shared__ __attribute__((aligned(16))) unsigned char lds[];
    Frame F;
    F.lds = (LAS unsigned char*)lds;
    F.MISC = (volatile LAS unsigned*)(F.lds + MISC_OFF);
    F.tid = threadIdx.x; F.lane = F.tid & 63; F.wave = __builtin_amdgcn_readfirstlane(F.tid >> 6);
    F.G = gridDim.x; F.bx = blockIdx.x; { const int bx = blockIdx.x; F.vcu = (F.G % 8 == 0) ? (bx % 8) * (F.G / 8) + bx / 8 : bx; }
    F.ctl = (gu32*)(fresh_args()->ws + WS_CTL);
    if (F.tid < 64) ((LAS unsigned*)(F.lds + MISC_OFF))[F.tid] = 0u;
    __syncthreads();
#if MK_ONE_LAUNCH
    XcdBarrier bar = xcd_barrier_post((unsigned*)(F.ctl + CW_BAR), F.MISC + 8);
#define SEAM() do { XcdBarrier b_ = bar; asm volatile("" : "+s"(b_.bar), "+s"(b_.x)); xcd_barrier(b_); } while (0)
#define RUN 1
#else
    int seam = 0; const int seg = fresh_args()->seg;
#define SEAM() (++seam)
#define RUN (seam == seg)
#endif
#define WSP(off) (A_->ws + (off))
#define FRESH_F() Frame Fp = F; { int t_ = threadIdx.x; asm volatile("" : "+v"(t_)); Fp.tid = t_; Fp.lane = t_ & 63; Fp.wave = __builtin_amdgcn_readfirstlane(t_ >> 6); asm volatile("" : "+s"(Fp.vcu), "+s"(Fp.G), "+s"(Fp.bx)); }
    if (DUP(0)) { { cargs_t A_ = fresh_args(); FRESH_F(); p_prologue(Fp, A_); } SEAM(); }
    if (P_ON(0) && RUN) { cargs_t A_ = fresh_args(); FRESH_F(); p_prologue(Fp, A_); }
    SEAM();
    for (int lp = 0; lp < 2; ++lp) {
        {
            const int layer = 2 * lp;
            for (int rep_ = 0; rep_ < 1 + DUP(1); ++rep_) { if (rep_) SEAM();
            if (P_ON(1) && RUN) { cargs_t A_ = fresh_args(); FRESH_F(); const float* hin = (layer == 0) ? A_->in[0] : A_->out;
                p_norm_mod(Fp, hin, A_->in[3] + (size_t)layer * 1024, (const float*)WSP(WS_MOD) + (size_t)layer * 8 * 3072, (bf16*)WSP(WS_U)); } }
            SEAM();
            for (int ch = 0; ch < NCHUNK; ++ch) {
                for (int rep_ = 0; rep_ < 1 + DUP(2); ++rep_) { if (rep_) SEAM();
                if (P_ON(2) && RUN) { cargs_t A_ = fresh_args();
                    pg8::Gemm g{(bf16*)WSP(WS_U) + (size_t)ch * MC * 1024, (bf16*)WSP(WS_WA) + (size_t)lp * A_N * 1024, MC, A_N, 1024};
                    pg8::StaticOrder S; { int g_ = F.G, b_ = F.bx; asm volatile("" : "+s"(g_), "+s"(b_)); S.init(MC, A_N, g_, b_); }
                    pg8::EpiA E{A_->ws, ch * MC};
                    pg8::gemm_phase<pg8::EpiA, pg8::StaticOrder, true, true>(F.lds, g, S, E);
                } }
                SEAM();
                if (DUP(3)) { { cargs_t A_ = fresh_args(); FRESH_F(); p_attnA(Fp, (bf16*)WSP(WS_ACT), (float*)WSP(WS_LSE), (bf16*)WSP(WS_END_A)); } SEAM(); }
                if (P_ON(3) && RUN) { cargs_t A_ = fresh_args(); FRESH_F(); p_attnA(Fp, (bf16*)WSP(WS_ACT), (float*)WSP(WS_LSE), nullptr); }
                SEAM();
                if (DUP(4)) { { cargs_t A_ = fresh_args(); FRESH_F(); p_mergeA(Fp, (const bf16*)WSP(WS_ACT), (const float*)WSP(WS_LSE), (bf16*)WSP(WS_U) + (size_t)ch * MC * 1024); } SEAM(); }
                if (P_ON(4) && RUN) { cargs_t A_ = fresh_args(); FRESH_F(); p_mergeA(Fp, (const bf16*)WSP(WS_ACT), (const float*)WSP(WS_LSE), (bf16*)WSP(WS_U) + (size_t)ch * MC * 1024); }
                SEAM();
            }
            for (int rep_ = 0; rep_ < 1 + ((DUP(5) && layer == 0) ? 1 : 0); ++rep_) { if (rep_) SEAM();
            if (P_ON(5) && RUN) { cargs_t A_ = fresh_args(); const float* hin = (layer == 0) ? A_->in[0] : A_->out;
                pg8::Gemm g{(bf16*)WSP(WS_U), (bf16*)WSP(WS_WO) + (size_t)layer * 1024 * 1024, MTOK, 1024, 1024};
                pg8::StaticOrder S; { int g_ = F.G, b_ = F.bx; asm volatile("" : "+s"(g_), "+s"(b_)); S.init(MTOK, 1024, g_, b_); }
                pg8::EpiOut E{hin, A_->out, (const float*)WSP(WS_MOD) + (size_t)layer * 8 * 3072 + 2048};
                pg8::gemm_phase<pg8::EpiOut, pg8::StaticOrder, true, true>(F.lds, g, S, E);
            } }
            SEAM();
        }
        {
            const int layer = 2 * lp + 1;
            if (P_ON(6) && RUN) { cargs_t A_ = fresh_args(); FRESH_F();
                p_norm_mod(Fp, A_->out, A_->in[3] + (size_t)layer * 1024, (const float*)WSP(WS_MOD) + (size_t)layer * 8 * 3072, (bf16*)WSP(WS_U)); }
            SEAM();
            for (int rep_ = 0; rep_ < 1 + DUP(7); ++rep_) { if (rep_) SEAM();
            if (P_ON(7) && RUN) { cargs_t A_ = fresh_args();
                pg8::Gemm g{(bf16*)WSP(WS_U), (bf16*)WSP(WS_WB) + (size_t)lp * B_NP * 1024, MTOK, B_NP, 1024};
                pg8::StaticOrder S; { int g_ = F.G, b_ = F.bx; asm volatile("" : "+s"(g_), "+s"(b_)); S.init(MTOK, B_NP, g_, b_); }
                pg8::EpiB E{A_->ws};
                pg8::gemm_phase<pg8::EpiB, pg8::StaticOrder, true, true>(F.lds, g, S, E);
            } }
            SEAM();
            if (DUP(8)) { { cargs_t A_ = fresh_args(); FRESH_F(); p_index(Fp, (const bf16*)WSP(WS_BQI), (const bf16*)WSP(WS_BKI), (const float*)WSP(WS_BWI), (unsigned long long*)WSP(WS_BMASK)); } SEAM(); }
            if (P_ON(8) && RUN) { cargs_t A_ = fresh_args(); FRESH_F(); p_index(Fp, (const bf16*)WSP(WS_BQI), (const bf16*)WSP(WS_BKI), (const float*)WSP(WS_BWI), (unsigned long long*)WSP(WS_BMASK)); }
            SEAM();
            if (DUP(9)) { { cargs_t A_ = fresh_args(); FRESH_F(); p_attnB(Fp, (const bf16*)WSP(WS_BQ), (const bf16*)WSP(WS_BK), (const bf16*)WSP(WS_BV), (const bf16*)WSP(WS_BG), (const unsigned long long*)WSP(WS_BMASK), (bf16*)WSP(WS_U)); } SEAM(); }
            if (P_ON(9) && RUN) { cargs_t A_ = fresh_args(); FRESH_F(); p_attnB(Fp, (const bf16*)WSP(WS_BQ), (const bf16*)WSP(WS_BK), (const bf16*)WSP(WS_BV), (const bf16*)WSP(WS_BG), (const unsigned long long*)WSP(WS_BMASK), (bf16*)WSP(WS_U)); }
            SEAM();
            if (P_ON(10) && RUN) { cargs_t A_ = fresh_args();
                pg8::Gemm g{(bf16*)WSP(WS_U), (bf16*)WSP(WS_WO) + (size_t)layer * 1024 * 1024, MTOK, 1024, 1024};
                pg8::StaticOrder S; { int g_ = F.G, b_ = F.bx; asm volatile("" : "+s"(g_), "+s"(b_)); S.init(MTOK, 1024, g_, b_); }
                pg8::EpiOut E{A_->out, A_->out, (const float*)WSP(WS_MOD) + (size_t)layer * 8 * 3072 + 2048};
                pg8::gemm_phase<pg8::EpiOut, pg8::StaticOrder, true, true>(F.lds, g, S, E);
            }
            SEAM();
        }
    }
#ifdef EXTRA_SEAMS
    for (int e_ = 0; e_ < EXTRA_SEAMS; ++e_) SEAM();
#endif
    if (P_ON(11) && RUN) { cargs_t A_ = fresh_args(); FRESH_F(); p_final_norm(Fp, A_->out, A_->in[10], A_->out); }
}

extern "C" void kernel_launch(void* const* d_in, const int* in_sizes, int n_in, void* d_out, int out_size, void* d_ws, size_t ws_size, hipStream_t stream) {
    static int grid = 0;
    if (grid == 0) {
        if (n_in != 11 || in_sizes[0] != MTOK * DM || out_size != MTOK * DM || ws_size < WS_NEED) {
            fprintf(stderr, "kernel_launch: unexpected shapes / workspace (n_in %d, in0 %d, out %d, ws %zu, need %zu); nothing launched\n", n_in, n_in > 0 ? in_sizes[0] : -1, out_size, ws_size, (size_t)WS_NEED); grid = -1; return; }
        int dev = 0, cus = 0, per_cu = 0;
        if (hipGetDevice(&dev) != hipSuccess || hipDeviceGetAttribute(&cus, hipDeviceAttributeMultiprocessorCount, dev) != hipSuccess) { fprintf(stderr, "kernel_launch: device query failed\n"); grid = -1; return; }
        if (hipFuncSetAttribute((const void*)trunk_fwd, hipFuncAttributeMaxDynamicSharedMemorySize, LDS_BYTES) != hipSuccess) { fprintf(stderr, "kernel_launch: hipFuncSetAttribute failed\n"); grid = -1; return; }
        if (hipOccupancyMaxActiveBlocksPerMultiprocessor(&per_cu, (const void*)trunk_fwd, NWAVES * 64, LDS_BYTES) != hipSuccess || per_cu < 1)
            fprintf(stderr, "kernel_launch: note: occupancy query reports %d workgroups per CU\n", per_cu);
        (void)hipGetLastError();
        grid = cus;
    }
    if (grid < 0) return;
    if (hipMemsetAsync((char*)d_ws + WS_CTL, 0, CTL_ZERO_BYTES, stream) != hipSuccess) { fprintf(stderr, "kernel_launch: memset failed\n"); return; }
    Args a{};
    for (int i = 0; i < 11; ++i) a.in[i] = (const float*)d_in[i];
    a.pos = (const int*)d_in[2]; a.out = (float*)d_out; a.ws = (unsigned char*)d_ws; a.seg = 0; a.pad = 0;
#if MK_ONE_LAUNCH
    hipLaunchKernelGGL(trunk_fwd, dim3(grid), dim3(NWAVES * 64), LDS_BYTES, stream, a);
#else
    for (int s = 0; s <= N_SEAMS; ++s) { a.seg = s; hipLaunchKernelGGL(trunk_fwd, dim3(grid), dim3(NWAVES * 64), LDS_BYTES, stream, a); }
#endif
    const hipError_t le = hipPeekAtLastError();
    if (le != hipSuccess) fprintf(stderr, "kernel_launch: launch failed: %s\n", hipGetErrorName(le));
}
```

```cpp
#include <hip/hip_runtime.h>
#include <cstdio>
#include <cstdint>
#include <cmath>
constexpr int NWAVES = 8;
constexpr int NB = 8, SEQ = 4096, DM = 1024, MTOK = NB * SEQ;
constexpr int A_N = 10240, B_NL = 3144, B_NP = 3328;
constexpr int MC = 8192, NCHUNK = MTOK / MC;
constexpr float NORM_EPS = 1e-6f;
#ifndef PMASK
#define PMASK 0xffff
#endif
#define P_ON(k) ((PMASK >> (k)) & 1)
#ifndef DUPMASK
#define DUPMASK 0
#endif
#define DUP(k) ((DUPMASK >> (k)) & 1)
#ifndef MK_ONE_LAUNCH
#define MK_ONE_LAUNCH 1
#endif
constexpr int N_SEAMS = 1 + 2 * ((1 + 3 * NCHUNK + 1) + 5);

constexpr size_t MiB = 1u << 20;
constexpr size_t WS_CTL = 0, CTL_ZERO_BYTES = 1 * MiB;
constexpr size_t WS_MOD = 1 * MiB;
constexpr size_t WS_COS = 2 * MiB, WS_SIN = 6 * MiB;
constexpr size_t WS_WA = 10 * MiB;
constexpr size_t WS_WB = 50 * MiB;
constexpr size_t WS_WO = 63 * MiB;
constexpr size_t WS_U = 72 * MiB;
constexpr size_t WS_ACT = 136 * MiB;
constexpr size_t A_SUB = (size_t)MC * 1024 * 2;
constexpr size_t WS_LSE = WS_ACT + 10 * A_SUB;
constexpr size_t WS_END_A = WS_LSE + (size_t)3 * MC * 16 * 4;
constexpr size_t WS_BQ = WS_ACT, WS_BK = WS_BQ + 64 * MiB, WS_BV = WS_BK + 16 * MiB, WS_BQI = WS_BV + 16 * MiB, WS_BKI = WS_BQI + 32 * MiB,
                 WS_BWI = WS_BKI + 4 * MiB, WS_BG = WS_BWI + 2 * MiB, WS_BMASK = WS_BG + 64 * MiB, WS_END_B = WS_BMASK + 16 * MiB;
constexpr size_t WS_NEED = (WS_END_A > WS_END_B ? WS_END_A : WS_END_B);
static_assert(WS_WA + (size_t)2 * A_N * 1024 * 2 <= WS_WB && WS_WB + (size_t)2 * B_NP * 1024 * 2 <= WS_WO && WS_WO + (size_t)4 * 1024 * 1024 * 2 <= WS_U && WS_U + (size_t)MTOK * 1024 * 2 <= WS_ACT, "ws map");
constexpr int CW_BAR = 4096;

namespace pg8 {
#define PG8_LAS __attribute__((address_space(3)))
typedef unsigned short bf16_t;
typedef short bf16x8 __attribute__((ext_vector_type(8)));
typedef float f32x4 __attribute__((ext_vector_type(4)));
typedef unsigned u32x4 __attribute__((ext_vector_type(4)));
constexpr int BM = 256, BK = 64, HALF = 128, HTB = HALF * BK * 2  , STAGE_BYTES = 8 * HTB, NXCD = 8, WGM = 8;

__host__ __device__ __forceinline__ int lds_byte(int r, int c) { const int st = (r >> 4) * 2 + (c >> 5), rr = r & 15, cc = c & 31, ob = rr * 64 + cc * 2; return st * 1024 + (ob ^ (((ob >> 9) & 1) << 5)); }
__host__ __device__ __forceinline__ void stage_rc(int b, int& R, int& C) { const int st = b / 1024, sb = b % 1024, swz = sb ^ (((sb >> 9) & 1) << 5); R = (st >> 1) * 16 + swz / 64; C = (st & 1) * 32 + (swz % 64) / 2; }
__host__ __device__ __forceinline__ int perm32(int rho) { const int n = rho >> 4, i = rho & 15; return 8 * (i >> 2) + 4 * n + (i & 3); }

struct Unit { int pm, pn; };
struct Gemm { const bf16_t* A; const bf16_t* Bt; int M, N, K; };

struct StaticOrder {
    int nM, nN, nwg, G, c;
    __host__ __device__ void init(int M, int N, int G_, int c_) { nM = M / BM; nN = N / BM; nwg = nM * nN; G = G_; c = c_; }
    __host__ __device__ bool next(int i, Unit& u) const {
        const long L = (long)i * G + c; if (L >= nwg) return false;
        int wgid = (int)L; { const int q = nwg / NXCD, r = nwg % NXCD, xcd = wgid % NXCD, off = wgid / NXCD; wgid = (xcd < r ? xcd * (q + 1) : r * (q + 1) + (xcd - r) * q) + off; }
        const int nig = WGM * nN, gid = wgid / nig, fm = gid * WGM, gsz = (nM - fm) < WGM ? (nM - fm) : WGM;
        u.pm = fm + ((wgid % nig) % gsz); u.pn = (wgid % nig) / gsz; return true;
    }
    __device__ __forceinline__ void a_ready(const Unit&) const {}
    __device__ __forceinline__ void done(const Unit&) const {}
};

typedef float f32x2g_t __attribute__((ext_vector_type(2))); typedef __bf16 bf16x2g_t __attribute__((ext_vector_type(2)));
__device__ __forceinline__ unsigned cvt_pk_bf16(float lo, float hi) { const f32x2g_t v = {lo, hi}; const bf16x2g_t b = __builtin_convertvector(v, bf16x2g_t); return __builtin_bit_cast(unsigned, b); }
typedef float f32x2 __attribute__((ext_vector_type(2)));
constexpr float C2F = 0.125f * 1.4426950408889634f;
constexpr float WSC = 0.35355339059327373f * 0.125f;
__device__ __forceinline__ float silu_f(float x) { return x * __builtin_amdgcn_rcpf(1.0f + __builtin_amdgcn_exp2f(-1.4426950408889634f * x)); }
__device__ __forceinline__ f32x4 silu4(f32x4 v) { return (f32x4){silu_f(v[0]), silu_f(v[1]), silu_f(v[2]), silu_f(v[3])}; }
__device__ __forceinline__ u32x4 pack8(f32x4 a, f32x4 b) { u32x4 w; w.x = cvt_pk_bf16(a[0], a[1]); w.y = cvt_pk_bf16(a[2], a[3]); w.z = cvt_pk_bf16(b[0], b[1]); w.w = cvt_pk_bf16(b[2], b[3]); return w; }

__device__ __forceinline__ void epi_store_rows(const f32x4 (&acc)[2][2][4][2], int kind, bf16_t* ob, int pitch, int row0, int col0, int j0, const float* cs, const float* sn) {
#pragma unroll
    for (int ai = 0; ai < 2; ++ai) {
        f32x4 c4[8], s4[8];
        if (kind < 2) {
#pragma unroll
            for (int i = 0; i < 4; ++i) { const int row = row0 + ai * HALF + i * 16;
                c4[ai * 4 + i] = *(const f32x4*)(cs + (size_t)row * 32 + j0); s4[ai * 4 + i] = *(const f32x4*)(sn + (size_t)row * 32 + j0); }
        }
#pragma unroll
        for (int m = 0; m < 4; ++m) {
            const int row = row0 + ai * HALF + m * 16;
            bf16_t* rowp = ob + (size_t)row * pitch + col0;
#pragma unroll
            for (int bj = 0; bj < 2; ++bj) {
                f32x4 v0 = acc[ai][bj][m][0], v1 = acc[ai][bj][m][1];
                if (kind < 2) { const f32x4 o0 = v0 * c4[ai * 4 + m] - v1 * s4[ai * 4 + m], o1 = v1 * c4[ai * 4 + m] + v0 * s4[ai * 4 + m]; v0 = o0; v1 = o1; if (kind == 0) { v0 = v0 * C2F; v1 = v1 * C2F; } }
                else if (kind == 3) { v0 = silu4(v0); v1 = silu4(v1); }
                *(u32x4*)(rowp + bj * HALF) = pack8(v0, v1);
            }
        }
    }
}
struct EpiA {
    static constexpr bool PERM = true, AFTER_DRAIN = false;
    unsigned char* ws; int row_off;
    __device__ __forceinline__ void operator()(const f32x4 (&acc)[2][2][4][2], const Unit& u, int wr, int wc, int fr, int fq) const {
        asm volatile("" : "+v"(fr), "+v"(fq));
        const int t = u.pn >> 2, kind = (t == 9) ? 3 : (t % 3);
        const float* cs = (const float*)(ws + WS_COS) + (size_t)row_off * 32; const float* sn = (const float*)(ws + WS_SIN) + (size_t)row_off * 32;
        epi_store_rows(acc, kind, (bf16_t*)(ws + WS_ACT) + (size_t)t * (A_SUB / 2), 1024, u.pm * BM + wr * 64 + fr, (u.pn & 3) * BM + wc * 32 + 8 * fq, 16 * (wc & 1) + 4 * fq, cs, sn);
    }
};
struct EpiB {
    static constexpr bool PERM = true, AFTER_DRAIN = false;
    unsigned char* ws;
    __device__ __forceinline__ void operator()(const f32x4 (&acc)[2][2][4][2], const Unit& u, int wr, int wc, int fr, int fq) const {
        asm volatile("" : "+v"(fr), "+v"(fq));
        bf16_t* Q = (bf16_t*)(ws + WS_BQ); bf16_t* K = (bf16_t*)(ws + WS_BK); bf16_t* V = (bf16_t*)(ws + WS_BV); bf16_t* QI = (bf16_t*)(ws + WS_BQI); bf16_t* KI = (bf16_t*)(ws + WS_BKI); bf16_t* G = (bf16_t*)(ws + WS_BG);
        float* WI = (float*)(ws + WS_BWI); const float* cs = (const float*)(ws + WS_COS); const float* sn = (const float*)(ws + WS_SIN);
        const int pn = u.pn, row0 = u.pm * BM + wr * 64 + fr, cw = wc * 32 + 8 * fq, j0 = 16 * (wc & 1) + 4 * fq;
        if (pn < 4)       epi_store_rows(acc, 0, Q, 1024, row0, pn * BM + cw, j0, cs, sn);
        else if (pn == 4) epi_store_rows(acc, 1, K, 256, row0, cw, j0, cs, sn);
        else if (pn == 5) epi_store_rows(acc, 2, V, 256, row0, cw, j0, cs, sn);
        else if (pn < 8)  epi_store_rows(acc, 1, QI, 512, row0, (pn - 6) * BM + cw, j0, cs, sn);
        else if (pn > 8)  epi_store_rows(acc, 3, G, 1024, row0, (pn - 9) * BM + cw, j0, cs, sn);
        else {
#pragma unroll
            for (int ai = 0; ai < 2; ++ai)
#pragma unroll
                for (int m = 0; m < 4; ++m) {
                    const int row = row0 + ai * HALF + m * 16;
                    const f32x4 v0 = acc[ai][0][m][0], v1 = acc[ai][0][m][1];
                    if (wc < 2) {
                        const f32x4 c4 = *(const f32x4*)(cs + (size_t)row * 32 + j0), s4 = *(const f32x4*)(sn + (size_t)row * 32 + j0);
                        *(u32x4*)(KI + (size_t)row * 64 + cw) = pack8(v0 * c4 - v1 * s4, v1 * c4 + v0 * s4);
                    } else if (wc == 2 && fq == 0) {
                        *(f32x4*)(WI + (size_t)row * 8) = v0 * WSC; *(f32x4*)(WI + (size_t)row * 8 + 4) = v1 * WSC;
                    }
                }
        }
    }
};
struct EpiOut {
    static constexpr bool PERM = false, AFTER_DRAIN = false;
    const float* hin; float* hout; const float* gate;
    __device__ __forceinline__ void operator()(const f32x4 (&acc)[2][2][4][2], const Unit& u, int wr, int wc, int fr, int fq) const {
        asm volatile("" : "+v"(fr), "+v"(fq));
        const int col0 = u.pn * BM + wc * 32 + 4 * fq;
        const int b = (u.pm * BM) >> 12;
        f32x4 g4[2][2];
#pragma unroll
        for (int bj = 0; bj < 2; ++bj)
#pragma unroll
            for (int n = 0; n < 2; ++n) g4[bj][n] = *(const f32x4*)(gate + (size_t)b * 3072 + col0 + bj * HALF + n * 16);
#pragma unroll
        for (int ai = 0; ai < 2; ++ai) {
#pragma unroll
          for (int mh = 0; mh < 2; ++mh) {
            f32x4 h4[4][2][2];
#pragma unroll
            for (int m = 2 * mh; m < 2 * mh + 2; ++m) { const int row = u.pm * BM + ai * HALF + wr * 64 + m * 16 + fr;
#pragma unroll
                for (int bj = 0; bj < 2; ++bj)
#pragma unroll
                    for (int n = 0; n < 2; ++n) h4[m][bj][n] = *(const f32x4*)(hin + (size_t)row * 1024 + col0 + bj * HALF + n * 16); }
#pragma unroll
            for (int m = 2 * mh; m < 2 * mh + 2; ++m) { const int row = u.pm * BM + ai * HALF + wr * 64 + m * 16 + fr;
#pragma unroll
                for (int bj = 0; bj < 2; ++bj)
#pragma unroll
                    for (int n = 0; n < 2; ++n) *(f32x4*)(hout + (size_t)row * 1024 + col0 + bj * HALF + n * 16) = h4[m][bj][n] + g4[bj][n] * acc[ai][bj][m][n]; }
          }
        }
    }
};

template <class Epi, class Sched, bool ALIGN_EPI = false, bool SP2 = false>
__device__ __forceinline__ void gemm_phase(PG8_LAS unsigned char* lds, const Gemm g, const Sched& S, const Epi& E) {
    int tid_ = threadIdx.x; asm volatile("" : "+v"(tid_));
    const int tid = tid_, wid = __builtin_amdgcn_readfirstlane(tid >> 6), lane = tid & 63, wr = wid >> 2, wc = wid & 3, fr = lane & 15, fq = lane >> 4;
    const int K = g.K, nt = K / BK;
    unsigned voffA[2], voffB[2];
#pragma unroll
    for (int i = 0; i < 2; ++i) { int R, C; stage_rc(tid * 16 + i * 8192, R, C); const int Rb = Epi::PERM ? ((R & ~31) + perm32(R & 31)) : R;
        voffA[i] = (unsigned)(R * K + C) * 2u; voffB[i] = (unsigned)(Rb * K + C) * 2u; }
    const size_t kstep = (size_t)(BK * 2);
    const size_t hstep = (size_t)HALF * K * 2;
    const size_t tstep = 2 * hstep;
    const unsigned ldsw = (unsigned)wid * 1024u;
    const int aoff = lds_byte(wr * 64 + fr, fq * 8), boff = lds_byte(wc * 32 + fr, fq * 8);
#define PG8_SA(b, h) (((b) * 2 + (h)) * HTB)
#define PG8_SB(b, h) ((4 + (b) * 2 + (h)) * HTB)
#define PG8_STAGE(bufoff, gbase, voff) do { _Pragma("unroll") for (int _i = 0; _i < 2; ++_i) \
        __builtin_amdgcn_global_load_lds((const unsigned*)((const char*)(gbase) + (voff)[_i]), (PG8_LAS unsigned*)(lds + (bufoff) + ldsw + _i * 8192), 16, 0, 0); } while (0)
#define PG8_LDA(dst, b, h) do { _Pragma("unroll") for (int m = 0; m < 4; ++m) _Pragma("unroll") for (int k = 0; k < 2; ++k) dst[m][k] = *(const PG8_LAS bf16x8*)(lds + PG8_SA(b, h) + aoff + m * 2048 + k * 1024); } while (0)
#define PG8_LDB(dst, b, h) do { _Pragma("unroll") for (int n = 0; n < 2; ++n) _Pragma("unroll") for (int k = 0; k < 2; ++k) dst[n][k] = *(const PG8_LAS bf16x8*)(lds + PG8_SB(b, h) + boff + n * 2048 + k * 1024); } while (0)
#define PG8_MMA(ai, bj, At, Bt) do { __builtin_amdgcn_s_setprio(1); _Pragma("unroll") for (int m = 0; m < 4; ++m) _Pragma("unroll") for (int n = 0; n < 2; ++n) _Pragma("unroll") for (int k = 0; k < 2; ++k) \
        acc[ai][bj][m][n] = __builtin_amdgcn_mfma_f32_16x16x32_bf16(Bt[n][k], At[m][k], acc[ai][bj][m][n], 0, 0, 0); __builtin_amdgcn_s_setprio(0); } while (0)
#define PG8_WAIT_V(n) asm volatile("s_waitcnt vmcnt(" #n ")" ::: "memory")
#define PG8_WAIT_L(n) asm volatile("s_waitcnt lgkmcnt(" #n ")" ::: "memory")
#define PG8_BAR __builtin_amdgcn_s_barrier()
#define PG8_SCHED __builtin_amdgcn_sched_barrier(0)
    Unit cur, nxt; int ui = 0;
    if (!S.next(0, cur)) return;
    f32x4 acc[2][2][4][2];
#pragma unroll
    for (int a = 0; a < 2; ++a)
#pragma unroll
        for (int b = 0; b < 2; ++b)
#pragma unroll
            for (int m = 0; m < 4; ++m)
#pragma unroll
                for (int n = 0; n < 2; ++n) acc[a][b][m][n] = (f32x4){0.f, 0.f, 0.f, 0.f};
    bf16x8 At[4][2], B0[2][2], B1[2][2];
    const char* cA = (const char*)g.A + (size_t)cur.pm * tstep; const char* cB = (const char*)g.Bt + (size_t)cur.pn * tstep;
    S.a_ready(cur);
    if constexpr (SP2) {
        PG8_STAGE(PG8_SB(0, 0), cB, voffB); PG8_STAGE(PG8_SB(0, 1), cB + hstep, voffB); PG8_STAGE(PG8_SA(0, 0), cA, voffA); PG8_STAGE(PG8_SA(0, 1), cA + hstep, voffA);
        if (wr == 1) PG8_BAR;
        PG8_WAIT_V(2); PG8_BAR;
        PG8_STAGE(PG8_SB(1, 0), cB + kstep, voffB); PG8_STAGE(PG8_SA(1, 0), cA + kstep, voffA); PG8_STAGE(PG8_SB(1, 1), cB + hstep + kstep, voffB);
        PG8_WAIT_V(6); PG8_BAR;
    } else {
        PG8_STAGE(PG8_SB(0, 0), cB, voffB); PG8_STAGE(PG8_SA(0, 0), cA, voffA); PG8_STAGE(PG8_SB(0, 1), cB + hstep, voffB); PG8_STAGE(PG8_SA(0, 1), cA + hstep, voffA);
        if (wr == 1) PG8_BAR;
        PG8_WAIT_V(4); PG8_BAR;
        PG8_STAGE(PG8_SB(1, 0), cB + kstep, voffB); PG8_STAGE(PG8_SA(1, 0), cA + kstep, voffA); PG8_STAGE(PG8_SB(1, 1), cB + hstep + kstep, voffB);
        PG8_WAIT_V(6); PG8_BAR;
    }
    for (;;) {
        const bool has_next = S.next(ui + 1, nxt);
        const char* nA = has_next ? (const char*)g.A + (size_t)nxt.pm * tstep : cA; const char* nB = has_next ? (const char*)g.Bt + (size_t)nxt.pn * tstep : cB;
        for (int t = 0; t < nt; t += 2) {
            const bool last = (t == nt - 2);
            const char* a1 = cA + (size_t)(t + 1) * kstep;
            const char* a2 = last ? nA : cA + (size_t)(t + 2) * kstep; const char* b2 = last ? nB : cB + (size_t)(t + 2) * kstep;
            const char* a3 = a2 + kstep; const char* b3 = b2 + kstep;
            if (last && has_next) S.a_ready(nxt);
            if constexpr (SP2) {
            PG8_LDB(B0, 0, 0); PG8_LDB(B1, 0, 1); PG8_SCHED; PG8_LDA(At, 0, 0); PG8_STAGE(PG8_SA(1, 1), a1 + hstep, voffA);
            PG8_WAIT_V(8); PG8_WAIT_L(0); PG8_BAR; PG8_MMA(0, 0, At, B0); PG8_MMA(0, 1, At, B1); PG8_BAR; PG8_SCHED;
            PG8_LDA(At, 0, 1); PG8_STAGE(PG8_SB(0, 0), b2, voffB); PG8_STAGE(PG8_SB(0, 1), b2 + hstep, voffB); PG8_STAGE(PG8_SA(0, 0), a2, voffA);
            PG8_WAIT_V(8); PG8_WAIT_L(0); PG8_BAR; PG8_MMA(1, 0, At, B0); PG8_MMA(1, 1, At, B1); PG8_BAR; PG8_SCHED;
            PG8_LDB(B0, 1, 0); PG8_LDB(B1, 1, 1); PG8_SCHED; PG8_LDA(At, 1, 0); PG8_STAGE(PG8_SA(0, 1), a2 + hstep, voffA);
            PG8_WAIT_V(8); PG8_WAIT_L(0); PG8_BAR; PG8_MMA(0, 0, At, B0); PG8_MMA(0, 1, At, B1); PG8_BAR; PG8_SCHED;
            PG8_LDA(At, 1, 1); PG8_STAGE(PG8_SB(1, 0), b3, voffB); PG8_STAGE(PG8_SB(1, 1), b3 + hstep, voffB); PG8_STAGE(PG8_SA(1, 0), a3, voffA);
            PG8_WAIT_V(8); PG8_WAIT_L(0); PG8_BAR; PG8_MMA(1, 0, At, B0); PG8_MMA(1, 1, At, B1); PG8_BAR; PG8_SCHED;
            } else {
            PG8_LDB(B0, 0, 0); PG8_SCHED; PG8_LDA(At, 0, 0); PG8_STAGE(PG8_SA(1, 1), a1 + hstep, voffA);
            PG8_WAIT_L(8); PG8_BAR; PG8_WAIT_L(0); PG8_MMA(0, 0, At, B0); PG8_BAR; PG8_SCHED;
            PG8_LDB(B1, 0, 1); PG8_STAGE(PG8_SB(0, 0), b2, voffB);
            PG8_BAR; PG8_WAIT_L(0); PG8_MMA(0, 1, At, B1); PG8_BAR;
            PG8_LDA(At, 0, 1); PG8_STAGE(PG8_SA(0, 0), a2, voffA);
            PG8_BAR; PG8_WAIT_L(0); PG8_MMA(1, 0, At, B0); PG8_BAR; PG8_SCHED;
            PG8_STAGE(PG8_SB(0, 1), b2 + hstep, voffB);
            PG8_WAIT_V(6); PG8_BAR; PG8_MMA(1, 1, At, B1); PG8_BAR;
            PG8_LDB(B0, 1, 0); PG8_SCHED; PG8_LDA(At, 1, 0); PG8_STAGE(PG8_SA(0, 1), a2 + hstep, voffA);
            PG8_WAIT_L(8); PG8_BAR; PG8_WAIT_L(0); PG8_MMA(0, 0, At, B0); PG8_BAR; PG8_SCHED;
            PG8_LDB(B1, 1, 1); PG8_STAGE(PG8_SB(1, 0), b3, voffB);
            PG8_BAR; PG8_WAIT_L(0); PG8_MMA(0, 1, At, B1); PG8_BAR;
            PG8_LDA(At, 1, 1); PG8_STAGE(PG8_SA(1, 0), a3, voffA);
            PG8_BAR; PG8_WAIT_L(0); PG8_MMA(1, 0, At, B0); PG8_BAR; PG8_SCHED;
            PG8_STAGE(PG8_SB(1, 1), b3 + hstep, voffB);
            PG8_WAIT_V(6); PG8_BAR; PG8_MMA(1, 1, At, B1); PG8_BAR;
            }
        }
        if constexpr (ALIGN_EPI) { if (wr == 0) PG8_BAR; }
        if constexpr (!Epi::AFTER_DRAIN) { E(acc, cur, wr, wc, fr, fq); S.done(cur); }
        if (!has_next) break;
#pragma unroll
        for (int a = 0; a < 2; ++a)
#pragma unroll
            for (int b = 0; b < 2; ++b)
#pragma unroll
                for (int m = 0; m < 4; ++m)
#pragma unroll
                    for (int n = 0; n < 2; ++n) acc[a][b][m][n] = (f32x4){0.f, 0.f, 0.f, 0.f};
        cur = nxt; cA = nA; cB = nB; ++ui;
        if constexpr (ALIGN_EPI) { if (wr == 1) PG8_BAR; }
    }
    PG8_WAIT_V(0);
    if constexpr (!ALIGN_EPI) { if (wr == 0) PG8_BAR; }
    PG8_BAR;
    if constexpr (Epi::AFTER_DRAIN) { E.fused(acc, cur, wr, wc, fr, fq, lds, wid, lane); S.done(cur); }
#undef PG8_SA
#undef PG8_SB
#undef PG8_STAGE
#undef PG8_LDA
#undef PG8_LDB
#undef PG8_MMA
#undef PG8_WAIT_V
#undef PG8_WAIT_L
#undef PG8_BAR
#undef PG8_SCHED
}
}
#define GAS __attribute__((address_space(1)))
#define LAS __attribute__((address_space(3)))
typedef unsigned short bf16;
typedef unsigned v4u __attribute__((ext_vector_type(4)));
typedef float f32x4 __attribute__((ext_vector_type(4)));
typedef short bf16x8 __attribute__((ext_vector_type(8)));
typedef GAS unsigned gu32;
typedef GAS unsigned long long gu64;
#define RLX_AGENT __ATOMIC_RELAXED, __HIP_MEMORY_SCOPE_AGENT
#define LDS_WAIT() asm volatile("s_waitcnt lgkmcnt(0)" ::: "memory")
#define VM_WAIT() asm volatile("s_waitcnt vmcnt(0)" ::: "memory")
__device__ __forceinline__ unsigned long long rt() { return __builtin_amdgcn_s_memrealtime(); }
__device__ __forceinline__ unsigned f2bf(float f) { unsigned u = __builtin_bit_cast(unsigned, f); return (u + 0x7fffu + ((u >> 16) & 1u)) >> 16; }
__device__ __forceinline__ unsigned pk2(float lo, float hi) { return f2bf(lo) | (f2bf(hi) << 16); }

#define XB_TMO      128
#define XB_XCNT(j)  (256  + 64 * (j))
#define XB_XSUB(j)  (1280 + 64 * (j))
#define XB_XGEN(j)  (2304 + 64 * (j))
#define XB_TOP      3328
#define XB_TOPGEN   3392
#define XCD_BAR_WORDS 3456
#define XB_SPIN_CAP (1u << 18)

__device__ __forceinline__ unsigned xb_ld(unsigned* p)              { return __hip_atomic_load(p, __ATOMIC_RELAXED, __HIP_MEMORY_SCOPE_AGENT); }
__device__ __forceinline__ unsigned xb_add(unsigned* p, unsigned v) { return __hip_atomic_fetch_add(p, v, __ATOMIC_RELAXED, __HIP_MEMORY_SCOPE_AGENT); }
__device__ __forceinline__ unsigned xb_xcc_id() { return (unsigned)__builtin_amdgcn_s_getreg((3 << 11) | 20) & 0xFu; }
#define XB_SPIN(cond, bar) do { unsigned _sp = 0; while (cond) { __builtin_amdgcn_s_sleep(1); \
    if ((++_sp & 255u) == 0u) { if (xb_ld(&(bar)[XB_TMO])) break; if (_sp > XB_SPIN_CAP) { atomicAdd(&(bar)[XB_TMO], 1u); break; } } } } while (0)

struct XcdBarrier {
    unsigned* bar; unsigned x;
    volatile LAS unsigned* st;
};

__device__ __forceinline__ XcdBarrier xcd_barrier_post(unsigned* bar, volatile LAS unsigned* st) {
    XcdBarrier b; b.bar = bar; b.x = xb_xcc_id(); b.st = st;
    if (threadIdx.x == 0) (void)xb_add(&bar[XB_XCNT(b.x)], 1u);
    return b;
}
__device__ __forceinline__ void xcd_barrier_complete(unsigned* bar, unsigned x, unsigned& nloc, unsigned& nx) {
    const unsigned G = gridDim.x * gridDim.y * gridDim.z;
    unsigned sum, cnt, mine, sp = 0u;
    for (;;) {
        sum = 0u; cnt = 0u; mine = 0u;
#pragma unroll
        for (unsigned j = 0; j < 16; ++j) { const unsigned c = xb_ld(&bar[XB_XCNT(j)]); sum += c; cnt += (c > 0u) ? 1u : 0u; mine = (j == x) ? c : mine; }
        if (sum == G) break;
        __builtin_amdgcn_s_sleep(1);
        if ((++sp & 255u) == 0u) { if (xb_ld(&bar[XB_TMO])) break; if (sp > XB_SPIN_CAP) { atomicAdd(&bar[XB_TMO], 1u); break; } }
    }
    nloc = mine > 0u ? mine : 1u; nx = cnt > 0u ? cnt : 1u;
}

__device__ __forceinline__ void xcd_barrier(const XcdBarrier& b) {
    asm volatile("s_waitcnt vmcnt(0)" ::: "memory");
    __syncthreads();
    if (threadIdx.x == 0) {
        unsigned* bar = b.bar;
        __builtin_amdgcn_s_waitcnt(0);
        unsigned nloc = b.st[0], nx = b.st[1];
        if (nloc == 0u) { xcd_barrier_complete(bar, b.x, nloc, nx); b.st[0] = nloc; b.st[1] = nx; }
        const unsigned old = xb_add(&bar[XB_XSUB(b.x)], 1u);
        const unsigned gen = old / nloc;
        if (old + 1u == (gen + 1u) * nloc) {
            __builtin_amdgcn_fence(__ATOMIC_RELEASE, "agent");
            asm volatile("s_waitcnt vmcnt(0)" ::: "memory");
            const unsigned og = xb_add(&bar[XB_TOP], 1u);
            const unsigned tg = og / nx;
            if (og + 1u == (tg + 1u) * nx) xb_add(&bar[XB_TOPGEN], 1u);
            else XB_SPIN(xb_ld(&bar[XB_TOPGEN]) == tg, bar);
            __builtin_amdgcn_fence(__ATOMIC_ACQUIRE, "agent");
            xb_add(&bar[XB_XGEN(b.x)], 1u);
            asm volatile("s_waitcnt vmcnt(0)" ::: "memory");
        } else {
            XB_SPIN(xb_ld(&bar[XB_XGEN(b.x)]) == gen, bar);
            __builtin_amdgcn_fence(__ATOMIC_ACQUIRE, "agent");
            asm volatile("s_waitcnt vmcnt(0)" ::: "memory");
        }
    }
    __syncthreads();
}

constexpr int RING_BYTES = 131072;
constexpr int SEL_HIST_OFF = 131072, SEL_CAND_OFF = SEL_HIST_OFF + 16384, SEL_STAGE_OFF = SEL_CAND_OFF + 4096, MISC_OFF = SEL_STAGE_OFF + 4096, LDS_BYTES = 159744;
static_assert(MISC_OFF + 256 <= LDS_BYTES, "LDS map");

typedef short s16x4 __attribute__((ext_vector_type(4)));
typedef short v4i16_t __attribute__((ext_vector_type(4)));
typedef float f32x16 __attribute__((ext_vector_type(16)));
typedef unsigned u32x2 __attribute__((ext_vector_type(2)));
__device__ __forceinline__ float wave_sum(float v) {
#pragma unroll
    for (int o = 1; o < 64; o <<= 1) v += __shfl_xor(v, o);
    return v;
}
typedef float f32x2c_t __attribute__((ext_vector_type(2))); typedef __bf16 bf16x2c_t __attribute__((ext_vector_type(2)));
__device__ __forceinline__ unsigned cvtpk(float lo, float hi) { const f32x2c_t v = {lo, hi}; const bf16x2c_t b = __builtin_convertvector(v, bf16x2c_t); return __builtin_bit_cast(unsigned, b); }
__device__ __forceinline__ float bf_lo(unsigned w) { return __uint_as_float(w << 16); }
__device__ __forceinline__ float bf_hi(unsigned w) { return __uint_as_float(w & 0xffff0000u); }
__device__ __forceinline__ float swap_max(float m) { auto rr = __builtin_amdgcn_permlane32_swap(__float_as_uint(m), __float_as_uint(m), false, false); return fmaxf(__uint_as_float(rr[0]), __uint_as_float(rr[1])); }
__device__ __forceinline__ float swap_sum(float m) { auto rr = __builtin_amdgcn_permlane32_swap(__float_as_uint(m), __float_as_uint(m), false, false); return __uint_as_float(rr[0]) + __uint_as_float(rr[1]); }
__device__ __forceinline__ int crow(int r, int hi) { return (r & 3) + 8 * (r >> 2) + 4 * hi; }
__device__ __forceinline__ unsigned vimg(unsigned row, unsigned ch) { return row * 128u + 16u * (ch ^ ((row & 3u) | (((row >> 1) & 1u) << 2))); }
__device__ __forceinline__ unsigned kimg(unsigned row, unsigned ch) { return row * 128u + 16u * (ch ^ ((row >> 1) & 7u)); }
__device__ __forceinline__ s16x4 vtr(const LAS unsigned char* p) { return __builtin_bit_cast(s16x4, __builtin_amdgcn_ds_read_tr16_b64_v4i16((LAS v4i16_t*)p)); }
#define MFMA32(a, b, c) __builtin_amdgcn_mfma_f32_32x32x16_bf16((a), (b), (c), 0, 0, 0)

struct Frame {
    LAS unsigned char* lds; volatile LAS unsigned* MISC; gu32* ctl;
    int tid, lane, wave, vcu, G, bx;
};
struct Args { const float* in[11]; const int* pos; float* out; unsigned char* ws; int seg; int pad; };
typedef const Args __attribute__((address_space(4)))* cargs_t;

__device__ __forceinline__ int rope_perm64(int c) { return ((c & 31) >> 2) * 8 + (c & 3) + ((c >> 5) << 2); }
template <int KIND> __device__ __forceinline__ int phys_row(int n) {
    if (KIND == 0) { if (n < 9216 && ((n >> 10) % 3) < 2) return (n & ~63) + rope_perm64(n & 63); return n; }
    if (KIND == 1) { if (n < 1280 || (n >= 1536 && n < 2112)) return (n & ~63) + rope_perm64(n & 63); if (n >= 2120) return n + 184; return n; }
    return n;
}
template <int KIND> __device__ __forceinline__ void transpose_item(const float* W, int K, int N, bf16* WT, LAS float* scr, int item, int lane) {
    const int nblk = (N + 31) / 32, kb = item / nblk, nb = item % nblk, k0 = 64 * kb, n0 = 32 * nb;
    const bool nok = n0 + (lane & 31) < N;
#pragma unroll 8
    for (int i = 0; i < 32; ++i) { const int kk = 2 * i + (lane >> 5); scr[kk * 33 + (lane & 31)] = nok ? W[(size_t)(k0 + kk) * N + n0 + (lane & 31)] : 0.f; }
    LDS_WAIT(); asm volatile("" ::: "memory");
    const int c = lane & 7;
#pragma unroll
    for (int j = 0; j < 4; ++j) { const int n = (lane >> 3) + 8 * j; const LAS float* s = scr + (8 * c) * 33 + n;
        v4u o; o.x = pk2(s[0 * 33], s[1 * 33]); o.y = pk2(s[2 * 33], s[3 * 33]); o.z = pk2(s[4 * 33], s[5 * 33]); o.w = pk2(s[6 * 33], s[7 * 33]);
        if (n0 + n < N) *(GAS v4u*)(WT + (size_t)phys_row<KIND>(n0 + n) * K + k0 + 8 * c) = o; }
    LDS_WAIT(); asm volatile("" ::: "memory");
}
__constant__ float INVF[32] = {1.000000000e+00f, 7.498942614e-01f, 5.623413324e-01f, 4.216965139e-01f, 3.162277639e-01f, 2.371373773e-01f, 1.778279394e-01f, 1.333521307e-01f, 1.000000015e-01f, 7.498941571e-02f,
    5.623413250e-02f, 4.216965288e-02f, 3.162277490e-02f, 2.371373773e-02f, 1.778279431e-02f, 1.333521493e-02f, 9.999999776e-03f, 7.498941850e-03f, 5.623413250e-03f, 4.216964822e-03f, 3.162277630e-03f, 2.371373586e-03f,
    1.778279431e-03f, 1.333521446e-03f, 1.000000047e-03f, 7.498942432e-04f, 5.623413017e-04f, 4.216965172e-04f, 3.162277571e-04f, 2.371373703e-04f, 1.778279402e-04f, 1.333521504e-04f};

__device__ __forceinline__ void p_prologue(Frame& F, cargs_t ap) {
    const float* const* in_ = nullptr; (void)in_;
    struct { const float* in[11]; const int* pos; unsigned char* ws; } a;
#pragma unroll
    for (int i = 0; i < 11; ++i) a.in[i] = ap->in[i];
    a.pos = ap->pos; a.ws = ap->ws;
    unsigned char* ws = a.ws;
    LAS float* scr = (LAS float*)(F.lds + F.wave * 12288);
    const int gw = F.vcu * NWAVES + F.wave, NGW = F.G * NWAVES;
    constexpr int I_A = 16 * (A_N / 32), I_B = 16 * ((B_NL + 31) / 32), I_O = 16 * 32;
    constexpr int NITEMS = 2 * I_A + 2 * I_B + 4 * I_O;
    for (int it = gw; it < NITEMS; it += NGW) {
        int r = it;
        if (r < 2 * I_A) { const int l = r / I_A; transpose_item<0>(a.in[6] + (size_t)l * 1024 * A_N, 1024, A_N, (bf16*)(ws + WS_WA) + (size_t)l * A_N * 1024, scr, r % I_A, F.lane); continue; } r -= 2 * I_A;
        if (r < 2 * I_B) { const int l = r / I_B; transpose_item<1>(a.in[8] + (size_t)l * 1024 * B_NL, 1024, B_NL, (bf16*)(ws + WS_WB) + (size_t)l * B_NP * 1024, scr, r % I_B, F.lane); continue; } r -= 2 * I_B;
        { const int l = r / I_O;
          const float* W = ((l & 1) ? a.in[9] : a.in[7]) + (size_t)(l >> 1) * 1024 * 1024;
          transpose_item<2>(W, 1024, 1024, (bf16*)(ws + WS_WO) + (size_t)l * 1024 * 1024, scr, r % I_O, F.lane); }
    }
    { const int gt = (F.vcu * NWAVES + F.wave) * 64 + F.lane, NGT = NGW * 64;
      for (int i = gt; i < 2 * 184 * 128; i += NGT) { const int l = i / (184 * 128), rr = (i / 128) % 184, c = i % 128;
          *(GAS v4u*)((bf16*)(ws + WS_WB) + (size_t)l * B_NP * 1024 + (size_t)(2120 + rr) * 1024 + c * 8) = (v4u){0u, 0u, 0u, 0u}; }
      float* cs = (float*)(ws + WS_COS); float* sn = (float*)(ws + WS_SIN);
      for (int i = gt; i < MTOK * 32; i += NGT) { const int tok = i >> 5, j = i & 31;
          const float angf = (float)a.pos[tok] * INVF[j]; const double x = (double)angf;
          const double k = __builtin_rint(x * 0.15915494309189535); double r = __builtin_fma(-k, 6.283185307179586, x); r = __builtin_fma(-k, 2.4492935982947064e-16, r);
          const float rf = (float)r; cs[i] = __cosf(rf); sn[i] = __sinf(rf); }
    }
    { LAS float* cact = (LAS float*)(F.lds + 98304);
      for (int i = F.tid; i < 8 * 1024; i += NWAVES * 64) { const float v = a.in[1][i]; cact[i] = v / (1.f + __expf(-v)); }
      __syncthreads();
      const float* adaw = a.in[4]; const float* adab = a.in[5]; float* mod = (float*)(ws + WS_MOD);
      const int col = F.lane & 15, kq = F.lane >> 4;
      for (int it = gw; it < 4 * 192; it += NGW) { const int l = it / 192, n0 = (it % 192) * 16;
          float acc[8];
#pragma unroll
          for (int b = 0; b < 8; ++b) acc[b] = 0.f;
          const float* wp = adaw + (size_t)l * 1024 * 3072 + (size_t)(kq * 256) * 3072 + n0 + col;
#pragma unroll 32
          for (int k = 0; k < 256; ++k) { const float w = wp[(size_t)k * 3072];
#pragma unroll
              for (int b = 0; b < 8; ++b) acc[b] += cact[b * 1024 + kq * 256 + k] * w; }
#pragma unroll
          for (int b = 0; b < 8; ++b) { float v = acc[b]; v += __shfl_xor(v, 16); v += __shfl_xor(v, 32); acc[b] = v; }
          if (kq == 0) {
#pragma unroll
              for (int b = 0; b < 8; ++b) mod[((size_t)l * 8 + b) * 3072 + n0 + col] = acc[b] + adab[(size_t)l * 3072 + n0 + col]; }
      }
    }
}

__device__ __forceinline__ void p_norm_mod(Frame& F, const float* hin, const float* g, const float* mod_l, bf16* U) {
    const int gw = F.vcu * NWAVES + F.wave, NGW = F.G * NWAVES;
    for (int r0 = gw * 16; r0 < MTOK; r0 += NGW * 16) {
        const int b = r0 >> 12;
        f32x4 A[4], Bv[4];
#pragma unroll
        for (int j = 0; j < 4; ++j) { const int c = 4 * F.lane + 256 * j; const f32x4 gg = *(const f32x4*)(g + c), sc = *(const f32x4*)(mod_l + (size_t)b * 3072 + 1024 + c);
            A[j] = gg * (sc + 1.0f); Bv[j] = *(const f32x4*)(mod_l + (size_t)b * 3072 + c); }
        for (int rr = 0; rr < 16; ++rr) {
            const int row = r0 + rr; const GAS f32x4* xr = (const GAS f32x4*)(hin + (size_t)row * DM) + F.lane;
            f32x4 v[4]; float s = 0.f;
#pragma unroll
            for (int j = 0; j < 4; ++j) { v[j] = xr[64 * j]; s += (v[j].x * v[j].x + v[j].y * v[j].y) + (v[j].z * v[j].z + v[j].w * v[j].w); }
            const float rstd = 1.0f / sqrtf(wave_sum(s) * (1.f / DM) + NORM_EPS);
            GAS u32x2* o8 = (GAS u32x2*)(U + (size_t)row * DM) + F.lane;
#pragma unroll
            for (int j = 0; j < 4; ++j) { const f32x4 y = (v[j] * rstd) * A[j] + Bv[j]; o8[64 * j] = (u32x2){cvtpk(y.x, y.y), cvtpk(y.z, y.w)}; }
        }
    }
}
__device__ __forceinline__ void p_final_norm(Frame& F, const float* hin, const float* g, float* out) {
    const int gw = F.vcu * NWAVES + F.wave, NGW = F.G * NWAVES;
    f32x4 A[4];
#pragma unroll
    for (int j = 0; j < 4; ++j) A[j] = *(const f32x4*)(g + 4 * F.lane + 256 * j);
    for (int row = gw; row < MTOK; row += NGW) {
        const GAS f32x4* xr = (const GAS f32x4*)(hin + (size_t)row * DM) + F.lane;
        f32x4 v[4]; float s = 0.f;
#pragma unroll
        for (int j = 0; j < 4; ++j) { v[j] = xr[64 * j]; s += (v[j].x * v[j].x + v[j].y * v[j].y) + (v[j].z * v[j].z + v[j].w * v[j].w); }
        const float rstd = 1.0f / sqrtf(wave_sum(s) * (1.f / DM) + NORM_EPS);
        GAS f32x4* o = (GAS f32x4*)(out + (size_t)row * DM) + F.lane;
#pragma unroll
        for (int j = 0; j < 4; ++j) o[64 * j] = (v[j] * rstd) * A[j];
    }
}

__device__ __forceinline__ void attnA_tile(const bf16* Qp, bf16* Op, const bf16* Kp, const bf16* Vp, float* lsep, int lse_stride, int rstride, int i0, LAS unsigned char* vst, int lane) {
    const int q32 = lane & 31, hi = lane >> 5;
    bf16x8 qf[4];
    { const bf16* qrow = Qp + (size_t)(i0 + q32) * rstride + 8 * hi;
#pragma unroll
      for (int ks = 0; ks < 4; ++ks) qf[ks] = *(const bf16x8*)(qrow + 16 * ks); }
    f32x16 o0 = {}, o1 = {};
    float m_run = -INFINITY, l_run = 0.f;
    const int kt0 = (i0 >= 128) ? 0 : (128 - i0) / 32;
    const int vc = lane & 7, vrow = lane >> 3;
    bf16x8 kall[5][4]; v4u vb[2][4];
#pragma unroll
    for (int kt = 0; kt < 5; ++kt) if (kt >= kt0) { const bf16* kr_ = Kp + (size_t)(i0 - 128 + 32 * kt + q32) * rstride + 8 * hi;
#pragma unroll
        for (int ks = 0; ks < 4; ++ks) kall[kt][ks] = *(const bf16x8*)(kr_ + 16 * ks); }
#define ATT_LOADV(kt_, buf_) do { _Pragma("unroll") for (int i = 0; i < 4; ++i) vb[buf_][i] = *(const v4u*)(Vp + (size_t)(i0 - 128 + 32 * (kt_) + vrow + 8 * i) * rstride + 8 * vc); } while (0)
#pragma unroll
    for (int kt = 0; kt < 5; ++kt) if (kt == kt0 || kt == kt0 + 1) ATT_LOADV(kt, kt & 1);
    const int q4 = (lane & 15) >> 2, blk = (lane >> 4) & 1, p4 = lane & 3;
#pragma unroll
    for (int kt = 0; kt < 5; ++kt) if (kt >= kt0) {
#pragma unroll
        for (int i = 0; i < 4; ++i) *(LAS v4u*)(vst + vimg(vrow + 8 * i, vc)) = vb[kt & 1][i];
        if (kt + 2 < 5) ATT_LOADV(kt + 2, kt & 1);
        bf16x8 kc[4];
#pragma unroll
        for (int ks = 0; ks < 4; ++ks) kc[ks] = kall[kt][ks];
        f32x16 p = {};
#pragma unroll
        for (int ks = 0; ks < 4; ++ks) p = MFMA32(kc[ks], qf[ks], p);
        if (kt == 0) {
#pragma unroll
            for (int r = 0; r < 16; ++r) if (crow(r, hi) < q32) p[r] = -INFINITY;
        }
        if (kt == 4) {
#pragma unroll
            for (int r = 0; r < 16; ++r) if (crow(r, hi) > q32) p[r] = -INFINITY;
        }
        LDS_WAIT(); asm volatile("" ::: "memory");
        s16x4 vlo[4], vup[4];
#pragma unroll
        for (int ks = 0; ks < 2; ++ks)
#pragma unroll
            for (int d0 = 0; d0 < 2; ++d0) {
                vlo[2 * ks + d0] = vtr(vst + vimg(16 * ks + 4 * hi + q4, 4 * d0 + 2 * blk + (p4 >> 1)) + 8 * (p4 & 1));
                vup[2 * ks + d0] = vtr(vst + vimg(16 * ks + 8 + 4 * hi + q4, 4 * d0 + 2 * blk + (p4 >> 1)) + 8 * (p4 & 1));
            }
        float mt = p[0];
#pragma unroll
        for (int r = 1; r < 16; ++r) mt = fmaxf(mt, p[r]);
        mt = swap_max(mt);
        if (__any(mt > m_run)) {
            const float m_new = fmaxf(m_run, mt);
            const float alpha = __builtin_amdgcn_exp2f(m_run - m_new);
            l_run *= alpha; m_run = m_new;
#pragma unroll
            for (int r = 0; r < 16; ++r) { o0[r] *= alpha; o1[r] *= alpha; }
        }
        float s = 0.f;
#pragma unroll
        for (int r = 0; r < 16; ++r) { p[r] = __builtin_amdgcn_exp2f(p[r] - m_run); s += p[r]; }
        l_run += s;
        bf16x8 pf[2];
#pragma unroll
        for (int ks = 0; ks < 2; ++ks) { v4u w; w.x = cvtpk(p[8 * ks + 0], p[8 * ks + 1]); w.y = cvtpk(p[8 * ks + 2], p[8 * ks + 3]); w.z = cvtpk(p[8 * ks + 4], p[8 * ks + 5]); w.w = cvtpk(p[8 * ks + 6], p[8 * ks + 7]); pf[ks] = __builtin_bit_cast(bf16x8, w); }
#pragma unroll
        for (int ks = 0; ks < 2; ++ks)
#pragma unroll
            for (int d0 = 0; d0 < 2; ++d0) {
                const s16x4 lo = vlo[2 * ks + d0], up = vup[2 * ks + d0];
                const bf16x8 vf = (bf16x8){lo[0], lo[1], lo[2], lo[3], up[0], up[1], up[2], up[3]};
                if (d0 == 0) o0 = MFMA32(vf, pf[ks], o0); else o1 = MFMA32(vf, pf[ks], o1);
            }
        LDS_WAIT(); asm volatile("" ::: "memory");
    }
#undef ATT_LOADV
    const float l_tot = swap_sum(l_run), inv = 1.0f / l_tot;
    bf16* orow = Op + (size_t)(i0 + q32) * rstride;
#pragma unroll
    for (int g4 = 0; g4 < 4; ++g4) {
        *(u32x2*)(orow + 8 * g4 + 4 * hi) = (u32x2){cvtpk(o0[4 * g4] * inv, o0[4 * g4 + 1] * inv), cvtpk(o0[4 * g4 + 2] * inv, o0[4 * g4 + 3] * inv)};
        *(u32x2*)(orow + 32 + 8 * g4 + 4 * hi) = (u32x2){cvtpk(o1[4 * g4] * inv, o1[4 * g4 + 1] * inv), cvtpk(o1[4 * g4 + 2] * inv, o1[4 * g4 + 3] * inv)};
    }
    if (hi == 0) lsep[(size_t)(i0 + q32) * lse_stride] = m_run + __builtin_amdgcn_logf(l_tot);
}
struct AUnit { bf16* Qp; const bf16* Kp; const bf16* Vp; float* lsep; int lse_stride, rstride, i0; };
__device__ __forceinline__ AUnit a_unit(int u, bf16* act, float* lse) {
    const int cb = u & 15, h = (u >> 4) & 15, g = (u >> 8) % 3, bl = u / 768;
    const int dl = (g == 0) ? 1 : (g == 1 ? 4 : 16), nbk = 16 / dl;
    const int r = cb / nbk, bk = cb % nbk;
    const size_t row_base = (size_t)bl * SEQ + r;
    AUnit U;
    U.Qp = act + (size_t)(3 * g + 0) * (A_SUB / 2) + row_base * 1024 + h * 64;
    U.Kp = act + (size_t)(3 * g + 1) * (A_SUB / 2) + row_base * 1024 + h * 64;
    U.Vp = act + (size_t)(3 * g + 2) * (A_SUB / 2) + row_base * 1024 + h * 64;
    U.lsep = lse + ((size_t)g * MC + row_base) * 16 + h; U.lse_stride = 16 * dl; U.rstride = dl * 1024; U.i0 = bk * 256;
    return U;
}
#define A_LOADS(U_) do { const int lo_ = ((U_).i0 >= 128) ? 0 : 128; \
        _Pragma("unroll") for (int i = 0; i < 6; ++i) { const int c_ = F.tid + 512 * i, row_ = c_ >> 3, ch_ = c_ & 7; \
            if (row_ >= lo_) { const size_t off_ = (size_t)((U_).i0 - 128 + row_) * (U_).rstride + 8 * ch_; kreg[i] = *(const v4u*)((U_).Kp + off_); vreg[i] = *(const v4u*)((U_).Vp + off_); } } \
        { const bf16* qrow_ = (U_).Qp + (size_t)((U_).i0 + 32 * F.wave + q32) * (U_).rstride + 8 * hi; \
          _Pragma("unroll") for (int ks = 0; ks < 4; ++ks) qn[ks] = *(const bf16x8*)(qrow_ + 16 * ks); } } while (0)
#define A_STAGE() do { _Pragma("unroll") for (int i = 0; i < 6; ++i) { const int c_ = F.tid + 512 * i, row_ = c_ >> 3, ch_ = c_ & 7; \
            *(LAS v4u*)(Kl + kimg(row_, ch_)) = kreg[i]; *(LAS v4u*)(Vl + vimg(row_, ch_)) = vreg[i]; } } while (0)
__device__ __forceinline__ void p_attnA(Frame& F, bf16* act, float* lse, bf16* dump) {
    LAS unsigned char* Vl = F.lds; LAS unsigned char* Kl = F.lds + 49152;
    constexpr int NBL = MC / SEQ, NUNITS = NBL * 3 * 16 * 16;
    const int lane = F.lane, q32 = lane & 31, hi = lane >> 5;
    const int q4 = (lane & 15) >> 2, blk = (lane >> 4) & 1, p4 = lane & 3;
    v4u kreg[6], vreg[6]; bf16x8 qn[4], qf[4];
#pragma unroll
    for (int i = 0; i < 6; ++i) { kreg[i] = (v4u){0u, 0u, 0u, 0u}; vreg[i] = (v4u){0u, 0u, 0u, 0u}; }
    int u = F.bx;
    if (u >= NUNITS) return;
    AUnit cur = a_unit(u, act, lse);
    A_LOADS(cur);
    A_STAGE();
#pragma unroll
    for (int ks = 0; ks < 4; ++ks) qf[ks] = qn[ks];
    __syncthreads();
    for (;;) {
        const int un = u + F.G; const bool has_next = un < NUNITS;
        AUnit nxt = cur;
#ifndef ATTA_NOPF
        if (has_next) { nxt = a_unit(un, act, lse); A_LOADS(nxt); }
#endif
        {
            const int i0w = cur.i0 + 32 * F.wave;
            f32x16 o0 = {}, o1 = {};
            float m_run = -INFINITY, l_run = 0.f;
            const int kt0 = (i0w >= 128) ? 0 : (128 - i0w) / 32;
            for (int kt = kt0; kt < 5; ++kt) {
                const int lrow = 32 * F.wave + 32 * kt;
                f32x16 p = {};
#ifdef ATTA_FULLWAIT
                bf16x8 kfr[4];
#pragma unroll
                for (int ks = 0; ks < 4; ++ks) kfr[ks] = *(const LAS bf16x8*)(Kl + kimg(lrow + q32, 2 * ks + hi));
                asm volatile("s_waitcnt lgkmcnt(0)" : "+v"(kfr[0]), "+v"(kfr[1]), "+v"(kfr[2]), "+v"(kfr[3]) :: "memory");
#pragma unroll
                for (int ks = 0; ks < 4; ++ks) p = MFMA32(kfr[ks], qf[ks], p);
#else
#pragma unroll
                for (int ks = 0; ks < 4; ++ks) { const bf16x8 kf = *(const LAS bf16x8*)(Kl + kimg(lrow + q32, 2 * ks + hi)); p = MFMA32(kf, qf[ks], p); }
#endif
                if (kt == 0) {
#pragma unroll
                    for (int r = 0; r < 16; ++r) if (crow(r, hi) < q32) p[r] = -INFINITY;
                }
                if (kt == 4) {
#pragma unroll
                    for (int r = 0; r < 16; ++r) if (crow(r, hi) > q32) p[r] = -INFINITY;
                }
                float mt = p[0];
#pragma unroll
                for (int r = 1; r < 16; ++r) mt = fmaxf(mt, p[r]);
                mt = swap_max(mt);
                if (__any(mt > m_run)) {
                    const float m_new = fmaxf(m_run, mt);
                    const float alpha = __builtin_amdgcn_exp2f(m_run - m_new);
                    l_run *= alpha; m_run = m_new;
#pragma unroll
                    for (int r = 0; r < 16; ++r) { o0[r] *= alpha; o1[r] *= alpha; }
                }
                float ssum = 0.f;
#pragma unroll
                for (int r = 0; r < 16; ++r) { p[r] = __builtin_amdgcn_exp2f(p[r] - m_run); ssum += p[r]; }
                l_run += ssum;
                bf16x8 pf[2];
#pragma unroll
                for (int ks = 0; ks < 2; ++ks) { v4u w; w.x = cvtpk(p[8 * ks + 0], p[8 * ks + 1]); w.y = cvtpk(p[8 * ks + 2], p[8 * ks + 3]); w.z = cvtpk(p[8 * ks + 4], p[8 * ks + 5]); w.w = cvtpk(p[8 * ks + 6], p[8 * ks + 7]); pf[ks] = __builtin_bit_cast(bf16x8, w); }
#pragma unroll
                for (int ks = 0; ks < 2; ++ks)
#pragma unroll
                    for (int d0 = 0; d0 < 2; ++d0) {
                        s16x4 lo = vtr(Vl + vimg(lrow + 16 * ks + 4 * hi + q4, 4 * d0 + 2 * blk + (p4 >> 1)) + 8 * (p4 & 1));
                        s16x4 up = vtr(Vl + vimg(lrow + 16 * ks + 8 + 4 * hi + q4, 4 * d0 + 2 * blk + (p4 >> 1)) + 8 * (p4 & 1));
#ifdef ATTA_FULLWAIT
                        asm volatile("s_waitcnt lgkmcnt(0)" : "+v"(lo), "+v"(up) :: "memory");
#endif
                        const bf16x8 vf = (bf16x8){lo[0], lo[1], lo[2], lo[3], up[0], up[1], up[2], up[3]};
                        if (d0 == 0) o0 = MFMA32(vf, pf[ks], o0); else o1 = MFMA32(vf, pf[ks], o1);
                    }
            }
            const float l_tot = swap_sum(l_run), inv = 1.0f / l_tot;
            bf16* Ob = dump ? dump + (cur.Qp - act) % (A_SUB / 2) : cur.Qp;
            bf16* orow = Ob + (size_t)(i0w + q32) * cur.rstride;
#pragma unroll
            for (int g4 = 0; g4 < 4; ++g4) {
                *(u32x2*)(orow + 8 * g4 + 4 * hi) = (u32x2){cvtpk(o0[4 * g4] * inv, o0[4 * g4 + 1] * inv), cvtpk(o0[4 * g4 + 2] * inv, o0[4 * g4 + 3] * inv)};
                *(u32x2*)(orow + 32 + 8 * g4 + 4 * hi) = (u32x2){cvtpk(o1[4 * g4] * inv, o1[4 * g4 + 1] * inv), cvtpk(o1[4 * g4 + 2] * inv, o1[4 * g4 + 3] * inv)};
            }
            if (hi == 0) cur.lsep[(size_t)(i0w + q32) * cur.lse_stride] = m_run + __builtin_amdgcn_logf(l_tot);
        }
        if (!has_next) break;
        __syncthreads();
#ifdef ATTA_NOPF
        nxt = a_unit(un, act, lse); A_LOADS(nxt);
#endif
        A_STAGE();
#pragma unroll
        for (int ks = 0; ks < 4; ++ks) qf[ks] = qn[ks];
        cur = nxt; u = un;
        __syncthreads();
    }
    __syncthreads();
}
#undef A_LOADS
#undef A_STAGE
__device__ __forceinline__ void p_mergeA(Frame& F, const bf16* act, const float* lse, bf16* Z  ) {
    const int gw = F.vcu * NWAVES + F.wave, NGW = F.G * NWAVES;
    const int head = F.lane >> 2;
    for (int row = gw; row < MC; row += NGW) {
        float l0 = lse[((size_t)0 * MC + row) * 16 + head], l1 = lse[((size_t)1 * MC + row) * 16 + head], l2 = lse[((size_t)2 * MC + row) * 16 + head];
        const float mx = fmaxf(l0, fmaxf(l1, l2));
        float e0 = __builtin_amdgcn_exp2f(l0 - mx), e1 = __builtin_amdgcn_exp2f(l1 - mx), e2 = __builtin_amdgcn_exp2f(l2 - mx);
        const float inv = 1.0f / (e0 + e1 + e2); e0 *= inv; e1 *= inv; e2 *= inv;
#pragma unroll
        for (int hf = 0; hf < 2; ++hf) {
            const size_t off = (size_t)row * 1024 + 16 * F.lane + 8 * hf;
            const v4u a0 = *(const v4u*)(act + (size_t)0 * (A_SUB / 2) + off), a1 = *(const v4u*)(act + (size_t)3 * (A_SUB / 2) + off), a2 = *(const v4u*)(act + (size_t)6 * (A_SUB / 2) + off),
                      gg = *(const v4u*)(act + (size_t)9 * (A_SUB / 2) + off);
            v4u o;
#pragma unroll
            for (int k = 0; k < 4; ++k) {
                const float ylo = (e0 * bf_lo(a0[k]) + e1 * bf_lo(a1[k]) + e2 * bf_lo(a2[k])) * bf_lo(gg[k]);
                const float yhi = (e0 * bf_hi(a0[k]) + e1 * bf_hi(a1[k]) + e2 * bf_hi(a2[k])) * bf_hi(gg[k]);
                o[k] = cvtpk(ylo, yhi);
            }
            *(v4u*)(Z + off) = o;
        }
    }
}

__device__ __forceinline__ unsigned ordkey(float f) { unsigned u = __float_as_uint(f); if ((u << 1) == 0u) u = 0u; return (u & 0x80000000u) ? ~u : (u | 0x80000000u); }
#define IDX_LOAD_QW(qf_, wv_, b_, t0_) do { const size_t tk_ = (size_t)(b_) * SEQ + (t0_); const int c32_ = F.lane & 31, hi_ = F.lane >> 5; \
        const int tl_ = 2 * ((c32_ >> 2) & 1) + (c32_ >> 4), hd_ = ((c32_ >> 3) & 1) * 4 + (c32_ & 3); \
        _Pragma("unroll") for (int R = 0; R < 2; ++R) { const bf16* qp_ = QI + (tk_ + 4 * R + tl_) * 512 + hd_ * 64 + 8 * hi_; \
            _Pragma("unroll") for (int ks = 0; ks < 4; ++ks) qf_[R][ks] = *(const bf16x8*)(qp_ + 16 * ks); \
            _Pragma("unroll") for (int tt = 0; tt < 2; ++tt) { const float* wp_ = WI + (tk_ + 4 * R + 2 * hi_ + tt) * 8; wv_[R][tt][0] = *(const f32x4*)wp_; wv_[R][tt][1] = *(const f32x4*)(wp_ + 4); } } } while (0)
__device__ __forceinline__ void index_tile(Frame& F, int b, int t0, const bf16* QI, const bf16* KI, const float* WI, unsigned long long* maskw,
                                           bf16x8 (&qf)[2][4], f32x4 (&wv)[2][2][2], bf16x8 (&qn)[2][4], f32x4 (&wn)[2][2][2], bool has_next, int bn, int t0n) {
    LAS float* sc = (LAS float*)F.lds;
    LAS unsigned* hist = (LAS unsigned*)(F.lds + SEL_HIST_OFF) + F.wave * 512;
    LAS unsigned* cand = (LAS unsigned*)(F.lds + SEL_CAND_OFF);
    LAS unsigned long long* stage = (LAS unsigned long long*)(F.lds + SEL_STAGE_OFF);
    const int lane = F.lane, c32 = lane & 31, hi = lane >> 5;
    const size_t tok0 = (size_t)b * SEQ + t0;
#ifndef IDX_REP_SCORE
#define IDX_REP_SCORE 1
#endif
#ifndef IDX_REP_SEL
#define IDX_REP_SEL 1
#endif
    for (int rep_ = 0; rep_ < IDX_REP_SCORE; ++rep_) {
        const int nkt = (t0 + 8 + 31) >> 5;
        bf16x8 kf[4], kg[4];
        const bf16* kbase = KI + ((size_t)b * SEQ + c32) * 64 + 8 * hi;
        int kt = F.wave;
        if (kt < nkt) {
#pragma unroll
            for (int ks = 0; ks < 4; ++ks) kf[ks] = *(const bf16x8*)(kbase + (size_t)kt * 32 * 64 + 16 * ks);
        }
        if (kt + NWAVES < nkt) {
#pragma unroll
            for (int ks = 0; ks < 4; ++ks) kg[ks] = *(const bf16x8*)(kbase + (size_t)(kt + NWAVES) * 32 * 64 + 16 * ks);
        }
        for (; kt < nkt; kt += NWAVES) {
            bf16x8 kc[4];
#pragma unroll
            for (int ks = 0; ks < 4; ++ks) { kc[ks] = kf[ks]; kf[ks] = kg[ks]; }
            if (kt + 2 * NWAVES < nkt) {
#pragma unroll
                for (int ks = 0; ks < 4; ++ks) kg[ks] = *(const bf16x8*)(kbase + (size_t)(kt + 2 * NWAVES) * 32 * 64 + 16 * ks);
            }
#pragma unroll
            for (int R = 0; R < 2; ++R) {
                f32x16 acc = {};
#pragma unroll
                for (int ks = 0; ks < 4; ++ks) acc = MFMA32(qf[R][ks], kc[ks], acc);
#pragma unroll
                for (int tt = 0; tt < 2; ++tt) {
                    float s = 0.f;
#pragma unroll
                    for (int i = 0; i < 8; ++i) s += wv[R][tt][i >> 2][i & 3] * fmaxf(acc[8 * tt + i], 0.f);
                    sc[(4 * R + 2 * hi + tt) * 4096 + kt * 32 + c32] = s;
                }
            }
        }
    }
    __syncthreads();
    if (has_next) IDX_LOAD_QW(qn, wn, bn, t0n);
    for (int rep_ = 0; rep_ < IDX_REP_SEL; ++rep_) {
        const int t = t0 + F.wave, n = t + 1;
        const LAS float* scq = sc + F.wave * 4096;
        unsigned long long myword = 0ull;
        bool done = false;
        if (n <= 256) {
            const int j = lane; const int rem = n - 64 * j;
            myword = rem >= 64 ? ~0ull : (rem > 0 ? ((1ull << rem) - 1ull) : 0ull);
            done = true;
        } else {
            float lo = INFINITY, hi = -INFINITY;
            for (int i = 0; i * 256 < n; ++i) { const int idx = 4 * (lane + 64 * i); const f32x4 v = *(const LAS f32x4*)(scq + idx);
#pragma unroll
                for (int e = 0; e < 4; ++e) if (idx + e < n) { lo = fminf(lo, v[e]); hi = fmaxf(hi, v[e]); } }
#pragma unroll
            for (int o = 1; o < 64; o <<= 1) { lo = fminf(lo, __shfl_xor(lo, o)); hi = fmaxf(hi, __shfl_xor(hi, o)); }
            if (hi > lo) {
                const float scale = 512.0f / (hi - lo);
                *(LAS v4u*)(hist + 8 * lane) = (v4u){0u, 0u, 0u, 0u}; *(LAS v4u*)(hist + 8 * lane + 4) = (v4u){0u, 0u, 0u, 0u};
                LDS_WAIT(); asm volatile("" ::: "memory");
                for (int i = 0; i * 256 < n; ++i) { const int idx = 4 * (lane + 64 * i); const f32x4 v = *(const LAS f32x4*)(scq + idx);
#pragma unroll
                    for (int e = 0; e < 4; ++e) if (idx + e < n) { const int bn = min(511, (int)((v[e] - lo) * scale));
                        __hip_atomic_fetch_add(hist + bn, 1u, __ATOMIC_RELAXED, __HIP_MEMORY_SCOPE_WORKGROUP); } }
                LDS_WAIT(); asm volatile("" ::: "memory");
                const v4u c0 = *(const LAS v4u*)(hist + 8 * lane), c1 = *(const LAS v4u*)(hist + 8 * lane + 4);
                unsigned cc[8] = {c0.x, c0.y, c0.z, c0.w, c1.x, c1.y, c1.z, c1.w};
                const unsigned ls = ((c0.x + c0.y) + (c0.z + c0.w)) + ((c1.x + c1.y) + (c1.z + c1.w));
                unsigned inc = ls;
#pragma unroll
                for (int o = 1; o < 64; o <<= 1) { const unsigned v = __shfl_up(inc, o); if (lane >= o) inc += v; }
                const unsigned total = __shfl(inc, 63);
                const unsigned S = total - inc;
                const bool found = (S < 256u) && (256u <= S + ls);
                unsigned acc = S; int bin = 0; unsigned above = S; bool got = false;
#pragma unroll
                for (int q = 7; q >= 0; --q) { if (!got) { if (acc + cc[q] >= 256u) { bin = q; above = acc; got = true; } else acc += cc[q]; } }
                const unsigned long long fm = __ballot(found);
                const int src = fm ? (__ffsll((long long)fm) - 1) : 0;
                const int B = __shfl(8 * lane + bin, src); const unsigned aboveb = __shfl(above, src);
                const unsigned mB = __shfl(cc[0] * 0u + ((bin == 0) ? cc[0] : (bin == 1) ? cc[1] : (bin == 2) ? cc[2] : (bin == 3) ? cc[3] : (bin == 4) ? cc[4] : (bin == 5) ? cc[5] : (bin == 6) ? cc[6] : cc[7]), src);
                const unsigned kk2 = 256u - aboveb;
                if (mB <= 64u) {
                    LAS unsigned* ckey = cand + F.wave * 128; LAS unsigned* cidx = ckey + 64;
                    unsigned base = 0u;
                    for (int j4 = 0; 256 * j4 < n; ++j4) {
                        float xs[4];
#pragma unroll
                        for (int c = 0; c < 4; ++c) xs[c] = scq[64 * (4 * j4 + c) + lane];
#pragma unroll
                        for (int c = 0; c < 4; ++c) {
                            const int j = 4 * j4 + c, sidx = 64 * j + lane; const bool v = sidx < n; const float x = xs[c];
                            const int bq = min(511, (int)((x - lo) * scale));
                            const bool gt = v && bq > B, eq = v && bq == B;
                            const unsigned long long wj = __ballot(gt), em = __ballot(eq);
                            if (eq) { const unsigned pos = base + (unsigned)__popcll(em & ((1ull << lane) - 1ull)); ckey[pos] = ordkey(x); cidx[pos] = (unsigned)sidx; }
                            base += (unsigned)__popcll(em);
                            if (lane == j) myword = wj;
                        }
                    }
                    stage[F.wave * 64 + lane] = myword;
                    LDS_WAIT(); asm volatile("" ::: "memory");
                    const unsigned m = base;
                    const unsigned mykey = (unsigned)lane < m ? ckey[lane] : 0u, myidx = (unsigned)lane < m ? cidx[lane] : 0u;
                    unsigned rank = 0u;
                    for (unsigned f = 0; f < m; ++f) { const unsigned kf = ckey[f]; rank += (kf > mykey || (kf == mykey && f < (unsigned)lane)) ? 1u : 0u; }
                    if ((unsigned)lane < m && rank < kk2)
                        __hip_atomic_fetch_or((LAS unsigned*)stage + F.wave * 128 + (myidx >> 5), 1u << (myidx & 31u), __ATOMIC_RELAXED, __HIP_MEMORY_SCOPE_WORKGROUP);
                    done = true;
                }
            }
        }
        if (!done) {
            unsigned T = 0u; int kk = 256; unsigned prefix = 0u;
#pragma unroll
            for (int pass = 0; pass < 4; ++pass) {
                const int shift = 24 - 8 * pass;
                *(LAS v4u*)(hist + 4 * lane) = (v4u){0u, 0u, 0u, 0u};
                LDS_WAIT(); asm volatile("" ::: "memory");
                for (int s2 = lane; s2 < n; s2 += 64) {
                    const unsigned key = ordkey(scq[s2]);
                    const bool in = (pass == 0) ? true : ((key >> ((shift + 8) & 31)) == prefix);
                    if (in) __hip_atomic_fetch_add(hist + ((key >> shift) & 255u), 1u, __ATOMIC_RELAXED, __HIP_MEMORY_SCOPE_WORKGROUP);
                }
                LDS_WAIT(); asm volatile("" ::: "memory");
                const v4u c = *(const LAS v4u*)(hist + 4 * lane);
                const unsigned ls = c.x + c.y + c.z + c.w;
                unsigned inc = ls;
#pragma unroll
                for (int o = 1; o < 64; o <<= 1) { const unsigned v = __shfl_up(inc, o); if (lane >= o) inc += v; }
                const unsigned total = __shfl(inc, 63);
                const unsigned S = total - inc;
                const bool found = (S < (unsigned)kk) && ((unsigned)kk <= S + ls);
                unsigned acc = S; int bin; unsigned above;
                if (acc + c.w >= (unsigned)kk) { bin = 3; above = acc; }
                else { acc += c.w; if (acc + c.z >= (unsigned)kk) { bin = 2; above = acc; }
                else { acc += c.z; if (acc + c.y >= (unsigned)kk) { bin = 1; above = acc; }
                else { acc += c.y; bin = 0; above = acc; } } }
                const unsigned long long fm = __ballot(found);
                const int src = fm ? (__ffsll((long long)fm) - 1) : 0;
                const int binb = __shfl(4 * lane + bin, src); const unsigned aboveb = __shfl(above, src);
                prefix = (prefix << 8) | (unsigned)binb; kk -= (int)aboveb;
            }
            T = prefix;
            unsigned taken = 0u; myword = 0ull;
            for (int j = 0; 64 * j < n; ++j) {
                const int s2 = 64 * j + lane; const bool v = s2 < n;
                const unsigned key = v ? ordkey(scq[s2]) : 0u;
                const bool gt = v && key > T, eq = v && key == T;
                const unsigned long long em = __ballot(eq);
                const unsigned rank = taken + (unsigned)__popcll(em & ((1ull << lane) - 1ull));
                const bool sel = gt || (eq && rank < (unsigned)kk);
                taken += (unsigned)__popcll(em);
                const unsigned long long w = __ballot(sel);
                if (lane == j) myword = w;
            }
            stage[F.wave * 64 + lane] = myword;
        } else if (n <= 256) stage[F.wave * 64 + lane] = myword;
    }
    __syncthreads();
    { const int j = F.tid >> 3, tq = F.tid & 7; maskw[((size_t)b * 64 + j) * 4096 + t0 + tq] = stage[tq * 64 + j]; }
}
__device__ __forceinline__ void p_index(Frame& F, const bf16* QI, const bf16* KI, const float* WI, unsigned long long* maskw) {
    bf16x8 qf[2][4], qn[2][4]; f32x4 wv[2][2][2], wn[2][2][2];
    int L = F.vcu; if (L >= 4096) return;
    int b, t0; { const int i = L >> 8, v = L & 255; b = i >> 1; t0 = 8 * ((i & 1) ? 511 - v : v); }
    IDX_LOAD_QW(qf, wv, b, t0);
    for (;;) {
        const int Ln = L + F.G; const bool has_next = Ln < 4096;
        int bn = b, t0n = t0; if (has_next) { const int i = Ln >> 8, v = Ln & 255; bn = i >> 1; t0n = 8 * ((i & 1) ? 511 - v : v); }
        index_tile(F, b, t0, QI, KI, WI, maskw, qf, wv, qn, wn, has_next, bn, t0n);
        if (!has_next) break;
#pragma unroll
        for (int R = 0; R < 2; ++R) {
#pragma unroll
            for (int ks = 0; ks < 4; ++ks) qf[R][ks] = qn[R][ks];
#pragma unroll
            for (int tt = 0; tt < 2; ++tt) { wv[R][tt][0] = wn[R][tt][0]; wv[R][tt][1] = wn[R][tt][1]; } }
        L = Ln; b = bn; t0 = t0n;
    }
}

__device__ __forceinline__ float mask_sel(float p, unsigned bits, int c) {
    const unsigned m = (unsigned)__builtin_amdgcn_sbfe((int)bits, (unsigned)c, 1u);
    return __uint_as_float((m & __float_as_uint(p)) | (~m & 0xff800000u));
}
__device__ __forceinline__ void attnB_unit(Frame& F, int b, int kvh, int blkq, const bf16* Q, const bf16* K, const bf16* V, const bf16* G, const unsigned long long* maskw, bf16* Z) {
    const int lane = F.lane, q32 = lane & 31, hi = lane >> 5, w = F.wave;
    const int head = 4 * kvh + (w >> 1), tok = blkq * 64 + 32 * (w & 1) + q32;
    const size_t grow = (size_t)b * SEQ + tok;
    const int NT = blkq + 1;
    bf16x8 qf[4];
    { const bf16* qrow = Q + grow * 1024 + head * 64 + 8 * hi;
#pragma unroll
      for (int ks = 0; ks < 4; ++ks) qf[ks] = *(const bf16x8*)(qrow + 16 * ks); }
    LAS unsigned char* Kb = F.lds; LAS unsigned char* Vb = F.lds + 16384;
    const int srow = F.tid >> 3, sch = F.tid & 7;
    const bf16* ksrc = K + ((size_t)b * SEQ + srow) * 256 + kvh * 64 + 8 * sch;
    const bf16* vsrc = V + ((size_t)b * SEQ + srow) * 256 + kvh * 64 + 8 * sch;
    const unsigned long long* mp = maskw + (size_t)b * 64 * 4096 + tok;
    v4u kreg = *(const v4u*)ksrc, vreg = *(const v4u*)vsrc;
    unsigned long long mw_next = mp[0];
    *(LAS v4u*)(Kb + kimg(srow, sch)) = kreg; *(LAS v4u*)(Vb + vimg(srow, sch)) = vreg;
    __syncthreads();
    f32x16 o0 = {}, o1 = {}, ol = {}, negm = {};
    const short one = (q32 == 0) ? (short)0x3F80 : (short)0;
    const bf16x8 ones = (bf16x8){one, one, one, one, one, one, one, one};
    const int q4 = (lane & 15) >> 2, blk = (lane >> 4) & 1, p4 = lane & 3;
    const unsigned koff0 = kimg(q32, hi), voff0 = vimg(4 * hi + q4, 2 * blk + (p4 >> 1)) + 8 * (p4 & 1);
    for (int j = 0; j < NT; ++j) {
        const unsigned long long mw = mw_next;
        if (j + 1 < NT) { kreg = *(const v4u*)(ksrc + (size_t)(j + 1) * 64 * 256); vreg = *(const v4u*)(vsrc + (size_t)(j + 1) * 64 * 256); mw_next = mp[(size_t)(j + 1) * 4096]; }
        const LAS unsigned char* Kc = Kb + (j & 1) * 8192; const LAS unsigned char* Vc = Vb + (j & 1) * 8192;
        f32x16 p0 = negm, p1 = negm;
        bf16x8 kfr[8];
#pragma unroll
        for (int ks = 0; ks < 4; ++ks) { kfr[2 * ks] = *(const LAS bf16x8*)(Kc + kimg(q32, 2 * ks + hi)); kfr[2 * ks + 1] = *(const LAS bf16x8*)(Kc + kimg(32 + q32, 2 * ks + hi)); }
#pragma unroll
        for (int ks = 0; ks < 4; ++ks) { p0 = MFMA32(kfr[2 * ks], qf[ks], p0); p1 = MFMA32(kfr[2 * ks + 1], qf[ks], p1); }
        s16x4 vlo[8], vup[8];
#pragma unroll
        for (int kq = 0; kq < 4; ++kq)
#pragma unroll
            for (int d0 = 0; d0 < 2; ++d0) {
                vlo[2 * kq + d0] = vtr(Vc + vimg(16 * kq + 4 * hi + q4, 4 * d0 + 2 * blk + (p4 >> 1)) + 8 * (p4 & 1));
                vup[2 * kq + d0] = vtr(Vc + vimg(16 * kq + 8 + 4 * hi + q4, 4 * d0 + 2 * blk + (p4 >> 1)) + 8 * (p4 & 1));
            }
        const unsigned b0 = (unsigned)mw >> (4 * hi), b1 = (unsigned)(mw >> 32) >> (4 * hi);
#pragma unroll
        for (int r = 0; r < 16; ++r) { p0[r] = mask_sel(p0[r], b0, (r & 3) + 8 * (r >> 2)); p1[r] = mask_sel(p1[r], b1, (r & 3) + 8 * (r >> 2)); }
        float rm = fmaxf(p0[0], p1[0]);
#pragma unroll
        for (int r = 1; r < 16; ++r) rm = fmaxf(fmaxf(rm, p0[r]), p1[r]);
        rm = swap_max(rm);
        if (j == 0 || __any(rm > 8.0f)) {
            const float delta = (j == 0) ? ((rm > -INFINITY) ? rm : 0.f) : fmaxf(rm, 0.f);
#pragma unroll
            for (int r = 0; r < 16; ++r) { p0[r] -= delta; p1[r] -= delta; negm[r] -= delta; }
            if (j != 0) { const float alpha = __builtin_amdgcn_exp2f(-delta);
#pragma unroll
                for (int r = 0; r < 16; ++r) { o0[r] *= alpha; o1[r] *= alpha; ol[r] *= alpha; } }
        }
#pragma unroll
        for (int r = 0; r < 16; ++r) { p0[r] = __builtin_amdgcn_exp2f(p0[r]); p1[r] = __builtin_amdgcn_exp2f(p1[r]); }
        bf16x8 pf[4];
#pragma unroll
        for (int ks = 0; ks < 2; ++ks) {
            v4u wa, wb;
            wa.x = cvtpk(p0[8 * ks + 0], p0[8 * ks + 1]); wa.y = cvtpk(p0[8 * ks + 2], p0[8 * ks + 3]); wa.z = cvtpk(p0[8 * ks + 4], p0[8 * ks + 5]); wa.w = cvtpk(p0[8 * ks + 6], p0[8 * ks + 7]);
            wb.x = cvtpk(p1[8 * ks + 0], p1[8 * ks + 1]); wb.y = cvtpk(p1[8 * ks + 2], p1[8 * ks + 3]); wb.z = cvtpk(p1[8 * ks + 4], p1[8 * ks + 5]); wb.w = cvtpk(p1[8 * ks + 6], p1[8 * ks + 7]);
            pf[ks] = __builtin_bit_cast(bf16x8, wa); pf[2 + ks] = __builtin_bit_cast(bf16x8, wb);
        }
#pragma unroll
        for (int kq = 0; kq < 4; ++kq) {
#pragma unroll
            for (int d0 = 0; d0 < 2; ++d0) {
                const s16x4 lo = vlo[2 * kq + d0], up = vup[2 * kq + d0];
                const bf16x8 vf = (bf16x8){lo[0], lo[1], lo[2], lo[3], up[0], up[1], up[2], up[3]};
                if (d0 == 0) o0 = MFMA32(vf, pf[kq], o0); else o1 = MFMA32(vf, pf[kq], o1);
            }
            ol = MFMA32(ones, pf[kq], ol);
        }
        if (j + 1 < NT) { *(LAS v4u*)(Kb + ((j + 1) & 1) * 8192 + kimg(srow, sch)) = kreg; *(LAS v4u*)(Vb + ((j + 1) & 1) * 8192 + vimg(srow, sch)) = vreg; }
        __syncthreads();
    }
    (void)koff0; (void)voff0;
    const float l_tot = swap_sum(ol[0]), inv = 1.0f / l_tot;
    const bf16* grow_p = G + grow * 1024 + head * 64;
    bf16* zrow = Z + grow * 1024 + head * 64;
#pragma unroll
    for (int g4 = 0; g4 < 4; ++g4) {
        const u32x2 ga = *(const u32x2*)(grow_p + 8 * g4 + 4 * hi), gb = *(const u32x2*)(grow_p + 32 + 8 * g4 + 4 * hi);
        *(u32x2*)(zrow + 8 * g4 + 4 * hi) = (u32x2){cvtpk(o0[4 * g4] * inv * bf_lo(ga.x), o0[4 * g4 + 1] * inv * bf_hi(ga.x)), cvtpk(o0[4 * g4 + 2] * inv * bf_lo(ga.y), o0[4 * g4 + 3] * inv * bf_hi(ga.y))};
        *(u32x2*)(zrow + 32 + 8 * g4 + 4 * hi) = (u32x2){cvtpk(o1[4 * g4] * inv * bf_lo(gb.x), o1[4 * g4 + 1] * inv * bf_hi(gb.x)), cvtpk(o1[4 * g4 + 2] * inv * bf_lo(gb.y), o1[4 * g4 + 3] * inv * bf_hi(gb.y))};
    }
}
__device__ __forceinline__ void p_attnB(Frame& F, const bf16* Q, const bf16* K, const bf16* V, const bf16* G, const unsigned long long* maskw, bf16* Z) {
    for (int L = F.vcu; L < 2048; L += F.G) {
        const int i = L >> 8, v = L & 255, bh = v >> 3, s = v & 7;
        const int blkq = 16 * (i >> 1) + ((i & 1) ? 15 - s : s);
        attnB_unit(F, bh >> 2, bh & 3, blkq, Q, K, V, G, maskw, Z);
    }
}

__device__ __forceinline__ cargs_t fresh_args() { cargs_t p = (cargs_t)__builtin_amdgcn_kernarg_segment_ptr(); asm volatile("" : "+s"(p)); return p; }
__global__ void __launch_bounds__(NWAVES * 64, 2) trunk_fwd(Args args_unused) {
    extern __shared__ __attribute__((aligned(16))) unsigned char lds[];
    Frame F;
    F.lds = (LAS unsigned char*)lds;
    F.MISC = (volatile LAS unsigned*)(F.lds + MISC_OFF);
    F.tid = threadIdx.x; F.lane = F.tid & 63; F.wave = __builtin_amdgcn_readfirstlane(F.tid >> 6);
    F.G = gridDim.x; F.bx = blockIdx.x; { const int bx = blockIdx.x; F.vcu = (F.G % 8 == 0) ? (bx % 8) * (F.G / 8) + bx / 8 : bx; }
    F.ctl = (gu32*)(fresh_args()->ws + WS_CTL);
    if (F.tid < 64) ((LAS unsigned*)(F.lds + MISC_OFF))[F.tid] = 0u;
    __syncthreads();
#if MK_ONE_LAUNCH
    XcdBarrier bar = xcd_barrier_post((unsigned*)(F.ctl + CW_BAR), F.MISC + 8);
#define SEAM() do { XcdBarrier b_ = bar; asm volatile("" : "+s"(b_.bar), "+s"(b_.x)); xcd_barrier(b_); } while (0)
#define RUN 1
#else
    int seam = 0; const int seg = fresh_args()->seg;
#define SEAM() (++seam)
#define RUN (seam == seg)
#endif
#define WSP(off) (A_->ws + (off))
#define FRESH_F() Frame Fp = F; { int t_ = threadIdx.x; asm volatile("" : "+v"(t_)); Fp.tid = t_; Fp.lane = t_ & 63; Fp.wave = __builtin_amdgcn_readfirstlane(t_ >> 6); asm volatile("" : "+s"(Fp.vcu), "+s"(Fp.G), "+s"(Fp.bx)); }
    if (DUP(0)) { { cargs_t A_ = fresh_args(); FRESH_F(); p_prologue(Fp, A_); } SEAM(); }
    if (P_ON(0) && RUN) { cargs_t A_ = fresh_args(); FRESH_F(); p_prologue(Fp, A_); }
    SEAM();
    for (int lp = 0; lp < 2; ++lp) {
        {
            const int layer = 2 * lp;
            for (int rep_ = 0; rep_ < 1 + DUP(1); ++rep_) { if (rep_) SEAM();
            if (P_ON(1) && RUN) { cargs_t A_ = fresh_args(); FRESH_F(); const float* hin = (layer == 0) ? A_->in[0] : A_->out;
                p_norm_mod(Fp, hin, A_->in[3] + (size_t)layer * 1024, (const float*)WSP(WS_MOD) + (size_t)layer * 8 * 3072, (bf16*)WSP(WS_U)); } }
            SEAM();
            for (int ch = 0; ch < NCHUNK; ++ch) {
                for (int rep_ = 0; rep_ < 1 + DUP(2); ++rep_) { if (rep_) SEAM();
                if (P_ON(2) && RUN) { cargs_t A_ = fresh_args();
                    pg8::Gemm g{(bf16*)WSP(WS_U) + (size_t)ch * MC * 1024, (bf16*)WSP(WS_WA) + (size_t)lp * A_N * 1024, MC, A_N, 1024};
                    pg8::StaticOrder S; { int g_ = F.G, b_ = F.bx; asm volatile("" : "+s"(g_), "+s"(b_)); S.init(MC, A_N, g_, b_); }
                    pg8::EpiA E{A_->ws, ch * MC};
                    pg8::gemm_phase<pg8::EpiA, pg8::StaticOrder, true, true>(F.lds, g, S, E);
                } }
                SEAM();
                if (DUP(3)) { { cargs_t A_ = fresh_args(); FRESH_F(); p_attnA(Fp, (bf16*)WSP(WS_ACT), (float*)WSP(WS_LSE), (bf16*)WSP(WS_END_A)); } SEAM(); }
                if (P_ON(3) && RUN) { cargs_t A_ = fresh_args(); FRESH_F(); p_attnA(Fp, (bf16*)WSP(WS_ACT), (float*)WSP(WS_LSE), nullptr); }
                SEAM();
                if (DUP(4)) { { cargs_t A_ = fresh_args(); FRESH_F(); p_mergeA(Fp, (const bf16*)WSP(WS_ACT), (const float*)WSP(WS_LSE), (bf16*)WSP(WS_U) + (size_t)ch * MC * 1024); } SEAM(); }
                if (P_ON(4) && RUN) { cargs_t A_ = fresh_args(); FRESH_F(); p_mergeA(Fp, (const bf16*)WSP(WS_ACT), (const float*)WSP(WS_LSE), (bf16*)WSP(WS_U) + (size_t)ch * MC * 1024); }
                SEAM();
            }
            for (int rep_ = 0; rep_ < 1 + ((DUP(5) && layer == 0) ? 1 : 0); ++rep_) { if (rep_) SEAM();
            if (P_ON(5) && RUN) { cargs_t A_ = fresh_args(); const float* hin = (layer == 0) ? A_->in[0] : A_->out;
                pg8::Gemm g{(bf16*)WSP(WS_U), (bf16*)WSP(WS_WO) + (size_t)layer * 1024 * 1024, MTOK, 1024, 1024};
                pg8::StaticOrder S; { int g_ = F.G, b_ = F.bx; asm volatile("" : "+s"(g_), "+s"(b_)); S.init(MTOK, 1024, g_, b_); }
                pg8::EpiOut E{hin, A_->out, (const float*)WSP(WS_MOD) + (size_t)layer * 8 * 3072 + 2048};
                pg8::gemm_phase<pg8::EpiOut, pg8::StaticOrder, true, true>(F.lds, g, S, E);
            } }
            SEAM();
        }
        {
            const int layer = 2 * lp + 1;
            if (P_ON(6) && RUN) { cargs_t A_ = fresh_args(); FRESH_F();
                p_norm_mod(Fp, A_->out, A_->in[3] + (size_t)layer * 1024, (const float*)WSP(WS_MOD) + (size_t)layer * 8 * 3072, (bf16*)WSP(WS_U)); }
            SEAM();
            for (int rep_ = 0; rep_ < 1 + DUP(7); ++rep_) { if (rep_) SEAM();
            if (P_ON(7) && RUN) { cargs_t A_ = fresh_args();
                pg8::Gemm g{(bf16*)WSP(WS_U), (bf16*)WSP(WS_WB) + (size_t)lp * B_NP * 1024, MTOK, B_NP, 1024};
                pg8::StaticOrder S; { int g_ = F.G, b_ = F.bx; asm volatile("" : "+s"(g_), "+s"(b_)); S.init(MTOK, B_NP, g_, b_); }
                pg8::EpiB E{A_->ws};
                pg8::gemm_phase<pg8::EpiB, pg8::StaticOrder, true, true>(F.lds, g, S, E);
            } }
            SEAM();
            if (DUP(8)) { { cargs_t A_ = fresh_args(); FRESH_F(); p_index(Fp, (const bf16*)WSP(WS_BQI), (const bf16*)WSP(WS_BKI), (const float*)WSP(WS_BWI), (unsigned long long*)WSP(WS_BMASK)); } SEAM(); }
            if (P_ON(8) && RUN) { cargs_t A_ = fresh_args(); FRESH_F(); p_index(Fp, (const bf16*)WSP(WS_BQI), (const bf16*)WSP(WS_BKI), (const float*)WSP(WS_BWI), (unsigned long long*)WSP(WS_BMASK)); }
            SEAM();
            if (DUP(9)) { { cargs_t A_ = fresh_args(); FRESH_F(); p_attnB(Fp, (const bf16*)WSP(WS_BQ), (const bf16*)WSP(WS_BK), (const bf16*)WSP(WS_BV), (const bf16*)WSP(WS_BG), (const unsigned long long*)WSP(WS_BMASK), (bf16*)WSP(WS_U)); } SEAM(); }
            if (P_ON(9) && RUN) { cargs_t A_ = fresh_args(); FRESH_F(); p_attnB(Fp, (const bf16*)WSP(WS_BQ), (const bf16*)WSP(WS_BK), (const bf16*)WSP(WS_BV), (const bf16*)WSP(WS_BG), (const unsigned long long*)WSP(WS_BMASK), (bf16*)WSP(WS_U)); }
            SEAM();
            if (P_ON(10) && RUN) { cargs_t A_ = fresh_args();
                pg8::Gemm g{(bf16*)WSP(WS_U), (bf16*)WSP(WS_WO) + (size_t)layer * 1024 * 1024, MTOK, 1024, 1024};
                pg8::StaticOrder S; { int g_ = F.G, b_ = F.bx; asm volatile("" : "+s"(g_), "+s"(b_)); S.init(MTOK, 1024, g_, b_); }
                pg8::EpiOut E{A_->out, A_->out, (const float*)WSP(WS_MOD) + (size_t)layer * 8 * 3072 + 2048};
                pg8::gemm_phase<pg8::EpiOut, pg8::StaticOrder, true, true>(F.lds, g, S, E);
            }
            SEAM();
        }
    }
#ifdef EXTRA_SEAMS
    for (int e_ = 0; e_ < EXTRA_SEAMS; ++e_) SEAM();
#endif
    if (P_ON(11) && RUN) { cargs_t A_ = fresh_args(); FRESH_F(); p_final_norm(Fp, A_->out, A_->in[10], A_->out); }
}

extern "C" void kernel_launch(void* const* d_in, const int* in_sizes, int n_in, void* d_out, int out_size, void* d_ws, size_t ws_size, hipStream_t stream) {
    static int grid = 0;
    if (grid == 0) {
        if (n_in != 11 || in_sizes[0] != MTOK * DM || out_size != MTOK * DM || ws_size < WS_NEED) {
            fprintf(stderr, "kernel_launch: unexpected shapes / workspace (n_in %d, in0 %d, out %d, ws %zu, need %zu); nothing launched\n", n_in, n_in > 0 ? in_sizes[0] : -1, out_size, ws_size, (size_t)WS_NEED); grid = -1; return; }
        int dev = 0, cus = 0, per_cu = 0;
        if (hipGetDevice(&dev) != hipSuccess || hipDeviceGetAttribute(&cus, hipDeviceAttributeMultiprocessorCount, dev) != hipSuccess) { fprintf(stderr, "kernel_launch: device query failed\n"); grid = -1; return; }
        if (hipFuncSetAttribute((const void*)trunk_fwd, hipFuncAttributeMaxDynamicSharedMemorySize, LDS_BYTES) != hipSuccess) { fprintf(stderr, "kernel_launch: hipFuncSetAttribute failed\n"); grid = -1; return; }
        if (hipOccupancyMaxActiveBlocksPerMultiprocessor(&per_cu, (const void*)trunk_fwd, NWAVES * 64, LDS_BYTES) != hipSuccess || per_cu < 1)
            fprintf(stderr, "kernel_launch: note: occupancy query reports %d workgroups per CU\n", per_cu);
        (void)hipGetLastError();
        grid = cus;
    }
    if (grid < 0) return;
    if (hipMemsetAsync((char*)d_ws + WS_CTL, 0, CTL_ZERO_BYTES, stream) != hipSuccess) { fprintf(stderr, "kernel_launch: memset failed\n"); return; }
    Args a{};
    for (int i = 0; i < 11; ++i) a.in[i] = (const float*)d_in[i];
    a.pos = (const int*)d_in[2]; a.out = (float*)d_out; a.ws = (unsigned char*)d_ws; a.seg = 0; a.pad = 0;
#if MK_ONE_LAUNCH
    hipLaunchKernelGGL(trunk_fwd, dim3(grid), dim3(NWAVES * 64), LDS_BYTES, stream, a);
#else
    for (int s = 0; s <= N_SEAMS; ++s) { a.seg = s; hipLaunchKernelGGL(trunk_fwd, dim3(grid), dim3(NWAVES * 64), LDS_BYTES, stream, a); }
#endif
    const hipError_t le = hipPeekAtLastError();
    if (le != hipSuccess) fprintf(stderr, "kernel_launch: launch failed: %s\n", hipGetErrorName(le));
}
```

```cpp
#include <hip/hip_runtime.h>
#include <cstdio>
#include <cstdint>
#include <cmath>
constexpr int NWAVES = 8;
constexpr int NB = 8, SEQ = 4096, DM = 1024, MTOK = NB * SEQ;
constexpr int A_N = 10240, B_NL = 3144, B_NP = 3328;
constexpr int MC = 8192, NCHUNK = MTOK / MC;
constexpr float NORM_EPS = 1e-6f;
#ifndef PMASK
#define PMASK 0xffff
#endif
#define P_ON(k) ((PMASK >> (k)) & 1)
#ifndef DUPMASK
#define DUPMASK 0
#endif
#define DUP(k) ((DUPMASK >> (k)) & 1)
#ifndef MK_ONE_LAUNCH
#define MK_ONE_LAUNCH 1
#endif
constexpr int N_SEAMS = 1 + 2 * ((1 + 3 * NCHUNK + 1) + 5);

constexpr size_t MiB = 1u << 20;
constexpr size_t WS_CTL = 0, CTL_ZERO_BYTES = 1 * MiB;
constexpr size_t WS_MOD = 1 * MiB;
constexpr size_t WS_COS = 2 * MiB, WS_SIN = 6 * MiB;
constexpr size_t WS_WA = 10 * MiB;
constexpr size_t WS_WB = 50 * MiB;
constexpr size_t WS_WO = 63 * MiB;
constexpr size_t WS_U = 72 * MiB;
constexpr size_t WS_ACT = 136 * MiB;
constexpr size_t A_SUB = (size_t)MC * 1024 * 2;
constexpr size_t WS_LSE = WS_ACT + 10 * A_SUB;
constexpr size_t WS_END_A = WS_LSE + (size_t)3 * MC * 16 * 4;
constexpr size_t WS_BQ = WS_ACT, WS_BK = WS_BQ + 64 * MiB, WS_BV = WS_BK + 16 * MiB, WS_BQI = WS_BV + 16 * MiB, WS_BKI = WS_BQI + 32 * MiB,
                 WS_BWI = WS_BKI + 4 * MiB, WS_BG = WS_BWI + 2 * MiB, WS_BMASK = WS_BG + 64 * MiB, WS_END_B = WS_BMASK + 16 * MiB;
constexpr size_t WS_NEED = (WS_END_A > WS_END_B ? WS_END_A : WS_END_B);
static_assert(WS_WA + (size_t)2 * A_N * 1024 * 2 <= WS_WB && WS_WB + (size_t)2 * B_NP * 1024 * 2 <= WS_WO && WS_WO + (size_t)4 * 1024 * 1024 * 2 <= WS_U && WS_U + (size_t)MTOK * 1024 * 2 <= WS_ACT, "ws map");
constexpr int CW_BAR = 4096;

namespace pg8 {
#define PG8_LAS __attribute__((address_space(3)))
typedef unsigned short bf16_t;
typedef short bf16x8 __attribute__((ext_vector_type(8)));
typedef float f32x4 __attribute__((ext_vector_type(4)));
typedef unsigned u32x4 __attribute__((ext_vector_type(4)));
constexpr int BM = 256, BK = 64, HALF = 128, HTB = HALF * BK * 2  , STAGE_BYTES = 8 * HTB, NXCD = 8, WGM = 8;

__host__ __device__ __forceinline__ int lds_byte(int r, int c) { const int st = (r >> 4) * 2 + (c >> 5), rr = r & 15, cc = c & 31, ob = rr * 64 + cc * 2; return st * 1024 + (ob ^ (((ob >> 9) & 1) << 5)); }
__host__ __device__ __forceinline__ void stage_rc(int b, int& R, int& C) { const int st = b / 1024, sb = b % 1024, swz = sb ^ (((sb >> 9) & 1) << 5); R = (st >> 1) * 16 + swz / 64; C = (st & 1) * 32 + (swz % 64) / 2; }
__host__ __device__ __forceinline__ int perm32(int rho) { const int n = rho >> 4, i = rho & 15; return 8 * (i >> 2) + 4 * n + (i & 3); }

struct Unit { int pm, pn; };
struct Gemm { const bf16_t* A; const bf16_t* Bt; int M, N, K; };

struct StaticOrder {
    int nM, nN, nwg, G, c;
    __host__ __device__ void init(int M, int N, int G_, int c_) { nM = M / BM; nN = N / BM; nwg = nM * nN; G = G_; c = c_; }
    __host__ __device__ bool next(int i, Unit& u) const {
        const long L = (long)i * G + c; if (L >= nwg) return false;
        int wgid = (int)L; { const int q = nwg / NXCD, r = nwg % NXCD, xcd = wgid % NXCD, off = wgid / NXCD; wgid = (xcd < r ? xcd * (q + 1) : r * (q + 1) + (xcd - r) * q) + off; }
        const int nig = WGM * nN, gid = wgid / nig, fm = gid * WGM, gsz = (nM - fm) < WGM ? (nM - fm) : WGM;
        u.pm = fm + ((wgid % nig) % gsz); u.pn = (wgid % nig) / gsz; return true;
    }
    __device__ __forceinline__ void a_ready(const Unit&) const {}
    __device__ __forceinline__ void done(const Unit&) const {}
};

typedef float f32x2g_t __attribute__((ext_vector_type(2))); typedef __bf16 bf16x2g_t __attribute__((ext_vector_type(2)));
__device__ __forceinline__ unsigned cvt_pk_bf16(float lo, float hi) { const f32x2g_t v = {lo, hi}; const bf16x2g_t b = __builtin_convertvector(v, bf16x2g_t); return __builtin_bit_cast(unsigned, b); }
typedef float f32x2 __attribute__((ext_vector_type(2)));
constexpr float C2F = 0.125f * 1.4426950408889634f;
constexpr float WSC = 0.35355339059327373f * 0.125f;
__device__ __forceinline__ float silu_f(float x) { return x * __builtin_amdgcn_rcpf(1.0f + __builtin_amdgcn_exp2f(-1.4426950408889634f * x)); }
__device__ __forceinline__ f32x4 silu4(f32x4 v) { return (f32x4){silu_f(v[0]), silu_f(v[1]), silu_f(v[2]), silu_f(v[3])}; }
__device__ __forceinline__ u32x4 pack8(f32x4 a, f32x4 b) { u32x4 w; w.x = cvt_pk_bf16(a[0], a[1]); w.y = cvt_pk_bf16(a[2], a[3]); w.z = cvt_pk_bf16(b[0], b[1]); w.w = cvt_pk_bf16(b[2], b[3]); return w; }

__device__ __forceinline__ void epi_store_rows(const f32x4 (&acc)[2][2][4][2], int kind, bf16_t* ob, int pitch, int row0, int col0, int j0, const float* cs, const float* sn) {
#pragma unroll
    for (int ai = 0; ai < 2; ++ai) {
        f32x4 c4[8], s4[8];
        if (kind < 2) {
#pragma unroll
            for (int i = 0; i < 4; ++i) { const int row = row0 + ai * HALF + i * 16;
                c4[ai * 4 + i] = *(const f32x4*)(cs + (size_t)row * 32 + j0); s4[ai * 4 + i] = *(const f32x4*)(sn + (size_t)row * 32 + j0); }
        }
#pragma unroll
        for (int m = 0; m < 4; ++m) {
            const int row = row0 + ai * HALF + m * 16;
            bf16_t* rowp = ob + (size_t)row * pitch + col0;
#pragma unroll
            for (int bj = 0; bj < 2; ++bj) {
                f32x4 v0 = acc[ai][bj][m][0], v1 = acc[ai][bj][m][1];
                if (kind < 2) { const f32x4 o0 = v0 * c4[ai * 4 + m] - v1 * s4[ai * 4 + m], o1 = v1 * c4[ai * 4 + m] + v0 * s4[ai * 4 + m]; v0 = o0; v1 = o1; if (kind == 0) { v0 = v0 * C2F; v1 = v1 * C2F; } }
                else if (kind == 3) { v0 = silu4(v0); v1 = silu4(v1); }
                *(u32x4*)(rowp + bj * HALF) = pack8(v0, v1);
            }
        }
    }
}
struct EpiA {
    static constexpr bool PERM = true, AFTER_DRAIN = false;
    unsigned char* ws; int row_off;
    __device__ __forceinline__ void operator()(const f32x4 (&acc)[2][2][4][2], const Unit& u, int wr, int wc, int fr, int fq) const {
        asm volatile("" : "+v"(fr), "+v"(fq));
        const int t = u.pn >> 2, kind = (t == 9) ? 3 : (t % 3);
        const float* cs = (const float*)(ws + WS_COS) + (size_t)row_off * 32; const float* sn = (const float*)(ws + WS_SIN) + (size_t)row_off * 32;
        epi_store_rows(acc, kind, (bf16_t*)(ws + WS_ACT) + (size_t)t * (A_SUB / 2), 1024, u.pm * BM + wr * 64 + fr, (u.pn & 3) * BM + wc * 32 + 8 * fq, 16 * (wc & 1) + 4 * fq, cs, sn);
    }
};
struct EpiB {
    static constexpr bool PERM = true, AFTER_DRAIN = false;
    unsigned char* ws;
    __device__ __forceinline__ void operator()(const f32x4 (&acc)[2][2][4][2], const Unit& u, int wr, int wc, int fr, int fq) const {
        asm volatile("" : "+v"(fr), "+v"(fq));
        bf16_t* Q = (bf16_t*)(ws + WS_BQ); bf16_t* K = (bf16_t*)(ws + WS_BK); bf16_t* V = (bf16_t*)(ws + WS_BV); bf16_t* QI = (bf16_t*)(ws + WS_BQI); bf16_t* KI = (bf16_t*)(ws + WS_BKI); bf16_t* G = (bf16_t*)(ws + WS_BG);
        float* WI = (float*)(ws + WS_BWI); const float* cs = (const float*)(ws + WS_COS); const float* sn = (const float*)(ws + WS_SIN);
        const int pn = u.pn, row0 = u.pm * BM + wr * 64 + fr, cw = wc * 32 + 8 * fq, j0 = 16 * (wc & 1) + 4 * fq;
        if (pn < 4)       epi_store_rows(acc, 0, Q, 1024, row0, pn * BM + cw, j0, cs, sn);
        else if (pn == 4) epi_store_rows(acc, 1, K, 256, row0, cw, j0, cs, sn);
        else if (pn == 5) epi_store_rows(acc, 2, V, 256, row0, cw, j0, cs, sn);
        else if (pn < 8)  epi_store_rows(acc, 1, QI, 512, row0, (pn - 6) * BM + cw, j0, cs, sn);
        else if (pn > 8)  epi_store_rows(acc, 3, G, 1024, row0, (pn - 9) * BM + cw, j0, cs, sn);
        else {
#pragma unroll
            for (int ai = 0; ai < 2; ++ai)
#pragma unroll
                for (int m = 0; m < 4; ++m) {
                    const int row = row0 + ai * HALF + m * 16;
                    const f32x4 v0 = acc[ai][0][m][0], v1 = acc[ai][0][m][1];
                    if (wc < 2) {
                        const f32x4 c4 = *(const f32x4*)(cs + (size_t)row * 32 + j0), s4 = *(const f32x4*)(sn + (size_t)row * 32 + j0);
                        *(u32x4*)(KI + ((size_t)((row >> 5) * 8 + (cw >> 3)) * 32 + (row & 31)) * 8) = pack8(v0 * c4 - v1 * s4, v1 * c4 + v0 * s4);
                    } else if (wc == 2 && fq == 0) {
                        *(f32x4*)(WI + (size_t)row * 8) = v0 * WSC; *(f32x4*)(WI + (size_t)row * 8 + 4) = v1 * WSC;
                    }
                }
        }
    }
};
struct EpiOut {
    static constexpr bool PERM = false, AFTER_DRAIN = false;
    const float* hin; float* hout; const float* gate;
    __device__ __forceinline__ void operator()(const f32x4 (&acc)[2][2][4][2], const Unit& u, int wr, int wc, int fr, int fq) const {
        asm volatile("" : "+v"(fr), "+v"(fq));
        const int col0 = u.pn * BM + wc * 32 + 4 * fq;
        const int b = (u.pm * BM) >> 12;
        f32x4 g4[2][2];
#pragma unroll
        for (int bj = 0; bj < 2; ++bj)
#pragma unroll
            for (int n = 0; n < 2; ++n) g4[bj][n] = *(const f32x4*)(gate + (size_t)b * 3072 + col0 + bj * HALF + n * 16);
#pragma unroll
        for (int ai = 0; ai < 2; ++ai) {
#pragma unroll
          for (int mh = 0; mh < 2; ++mh) {
            f32x4 h4[4][2][2];
#pragma unroll
            for (int m = 2 * mh; m < 2 * mh + 2; ++m) { const int row = u.pm * BM + ai * HALF + wr * 64 + m * 16 + fr;
#pragma unroll
                for (int bj = 0; bj < 2; ++bj)
#pragma unroll
                    for (int n = 0; n < 2; ++n) h4[m][bj][n] = *(const f32x4*)(hin + (size_t)row * 1024 + col0 + bj * HALF + n * 16); }
#pragma unroll
            for (int m = 2 * mh; m < 2 * mh + 2; ++m) { const int row = u.pm * BM + ai * HALF + wr * 64 + m * 16 + fr;
#pragma unroll
                for (int bj = 0; bj < 2; ++bj)
#pragma unroll
                    for (int n = 0; n < 2; ++n) *(f32x4*)(hout + (size_t)row * 1024 + col0 + bj * HALF + n * 16) = h4[m][bj][n] + g4[bj][n] * acc[ai][bj][m][n]; }
          }
        }
    }
};

template <class Epi, class Sched, bool ALIGN_EPI = false, bool SP2 = false>
__device__ __forceinline__ void gemm_phase(PG8_LAS unsigned char* lds, const Gemm g, const Sched& S, const Epi& E) {
    int tid_ = threadIdx.x; asm volatile("" : "+v"(tid_));
    const int tid = tid_, wid = __builtin_amdgcn_readfirstlane(tid >> 6), lane = tid & 63, wr = wid >> 2, wc = wid & 3, fr = lane & 15, fq = lane >> 4;
    const int K = g.K, nt = K / BK;
    unsigned voffA[2], voffB[2];
#pragma unroll
    for (int i = 0; i < 2; ++i) { int R, C; stage_rc(tid * 16 + i * 8192, R, C); const int Rb = Epi::PERM ? ((R & ~31) + perm32(R & 31)) : R;
        voffA[i] = (unsigned)(R * K + C) * 2u; voffB[i] = (unsigned)(Rb * K + C) * 2u; }
    const size_t kstep = (size_t)(BK * 2);
    const size_t hstep = (size_t)HALF * K * 2;
    const size_t tstep = 2 * hstep;
    const unsigned ldsw = (unsigned)wid * 1024u;
    const int aoff = lds_byte(wr * 64 + fr, fq * 8), boff = lds_byte(wc * 32 + fr, fq * 8);
#define PG8_SA(b, h) (((b) * 2 + (h)) * HTB)
#define PG8_SB(b, h) ((4 + (b) * 2 + (h)) * HTB)
#define PG8_STAGE(bufoff, gbase, voff) do { _Pragma("unroll") for (int _i = 0; _i < 2; ++_i) \
        __builtin_amdgcn_global_load_lds((const unsigned*)((const char*)(gbase) + (voff)[_i]), (PG8_LAS unsigned*)(lds + (bufoff) + ldsw + _i * 8192), 16, 0, 0); } while (0)
#define PG8_LDA(dst, b, h) do { _Pragma("unroll") for (int m = 0; m < 4; ++m) _Pragma("unroll") for (int k = 0; k < 2; ++k) dst[m][k] = *(const PG8_LAS bf16x8*)(lds + PG8_SA(b, h) + aoff + m * 2048 + k * 1024); } while (0)
#define PG8_LDB(dst, b, h) do { _Pragma("unroll") for (int n = 0; n < 2; ++n) _Pragma("unroll") for (int k = 0; k < 2; ++k) dst[n][k] = *(const PG8_LAS bf16x8*)(lds + PG8_SB(b, h) + boff + n * 2048 + k * 1024); } while (0)
#define PG8_MMA(ai, bj, At, Bt) do { __builtin_amdgcn_s_setprio(1); _Pragma("unroll") for (int m = 0; m < 4; ++m) _Pragma("unroll") for (int n = 0; n < 2; ++n) _Pragma("unroll") for (int k = 0; k < 2; ++k) \
        acc[ai][bj][m][n] = __builtin_amdgcn_mfma_f32_16x16x32_bf16(Bt[n][k], At[m][k], acc[ai][bj][m][n], 0, 0, 0); __builtin_amdgcn_s_setprio(0); } while (0)
#define PG8_WAIT_V(n) asm volatile("s_waitcnt vmcnt(" #n ")" ::: "memory")
#define PG8_WAIT_L(n) asm volatile("s_waitcnt lgkmcnt(" #n ")" ::: "memory")
#define PG8_BAR __builtin_amdgcn_s_barrier()
#define PG8_SCHED __builtin_amdgcn_sched_barrier(0)
    Unit cur, nxt; int ui = 0;
    if (!S.next(0, cur)) return;
    f32x4 acc[2][2][4][2];
#pragma unroll
    for (int a = 0; a < 2; ++a)
#pragma unroll
        for (int b = 0; b < 2; ++b)
#pragma unroll
            for (int m = 0; m < 4; ++m)
#pragma unroll
                for (int n = 0; n < 2; ++n) acc[a][b][m][n] = (f32x4){0.f, 0.f, 0.f, 0.f};
    bf16x8 At[4][2], B0[2][2], B1[2][2];
    const char* cA = (const char*)g.A + (size_t)cur.pm * tstep; const char* cB = (const char*)g.Bt + (size_t)cur.pn * tstep;
    S.a_ready(cur);
    if constexpr (SP2) {
        PG8_STAGE(PG8_SB(0, 0), cB, voffB); PG8_STAGE(PG8_SB(0, 1), cB + hstep, voffB); PG8_STAGE(PG8_SA(0, 0), cA, voffA); PG8_STAGE(PG8_SA(0, 1), cA + hstep, voffA);
        if (wr == 1) PG8_BAR;
        PG8_WAIT_V(2); PG8_BAR;
        PG8_STAGE(PG8_SB(1, 0), cB + kstep, voffB); PG8_STAGE(PG8_SA(1, 0), cA + kstep, voffA); PG8_STAGE(PG8_SB(1, 1), cB + hstep + kstep, voffB);
        PG8_WAIT_V(6); PG8_BAR;
    } else {
        PG8_STAGE(PG8_SB(0, 0), cB, voffB); PG8_STAGE(PG8_SA(0, 0), cA, voffA); PG8_STAGE(PG8_SB(0, 1), cB + hstep, voffB); PG8_STAGE(PG8_SA(0, 1), cA + hstep, voffA);
        if (wr == 1) PG8_BAR;
        PG8_WAIT_V(4); PG8_BAR;
        PG8_STAGE(PG8_SB(1, 0), cB + kstep, voffB); PG8_STAGE(PG8_SA(1, 0), cA + kstep, voffA); PG8_STAGE(PG8_SB(1, 1), cB + hstep + kstep, voffB);
        PG8_WAIT_V(6); PG8_BAR;
    }
    for (;;) {
        const bool has_next = S.next(ui + 1, nxt);
        const char* nA = has_next ? (const char*)g.A + (size_t)nxt.pm * tstep : cA; const char* nB = has_next ? (const char*)g.Bt + (size_t)nxt.pn * tstep : cB;
        for (int t = 0; t < nt; t += 2) {
            const bool last = (t == nt - 2);
            const char* a1 = cA + (size_t)(t + 1) * kstep;
            const char* a2 = last ? nA : cA + (size_t)(t + 2) * kstep; const char* b2 = last ? nB : cB + (size_t)(t + 2) * kstep;
            const char* a3 = a2 + kstep; const char* b3 = b2 + kstep;
            if (last && has_next) S.a_ready(nxt);
            if constexpr (SP2) {
            PG8_LDB(B0, 0, 0); PG8_LDB(B1, 0, 1); PG8_SCHED; PG8_LDA(At, 0, 0); PG8_STAGE(PG8_SA(1, 1), a1 + hstep, voffA);
            PG8_WAIT_V(8); PG8_WAIT_L(0); PG8_BAR; PG8_MMA(0, 0, At, B0); PG8_MMA(0, 1, At, B1); PG8_BAR; PG8_SCHED;
            PG8_LDA(At, 0, 1); PG8_STAGE(PG8_SB(0, 0), b2, voffB); PG8_STAGE(PG8_SB(0, 1), b2 + hstep, voffB); PG8_STAGE(PG8_SA(0, 0), a2, voffA);
            PG8_WAIT_V(8); PG8_WAIT_L(0); PG8_BAR; PG8_MMA(1, 0, At, B0); PG8_MMA(1, 1, At, B1); PG8_BAR; PG8_SCHED;
            PG8_LDB(B0, 1, 0); PG8_LDB(B1, 1, 1); PG8_SCHED; PG8_LDA(At, 1, 0); PG8_STAGE(PG8_SA(0, 1), a2 + hstep, voffA);
            PG8_WAIT_V(8); PG8_WAIT_L(0); PG8_BAR; PG8_MMA(0, 0, At, B0); PG8_MMA(0, 1, At, B1); PG8_BAR; PG8_SCHED;
            PG8_LDA(At, 1, 1); PG8_STAGE(PG8_SB(1, 0), b3, voffB); PG8_STAGE(PG8_SB(1, 1), b3 + hstep, voffB); PG8_STAGE(PG8_SA(1, 0), a3, voffA);
            PG8_WAIT_V(8); PG8_WAIT_L(0); PG8_BAR; PG8_MMA(1, 0, At, B0); PG8_MMA(1, 1, At, B1); PG8_BAR; PG8_SCHED;
            } else {
            PG8_LDB(B0, 0, 0); PG8_SCHED; PG8_LDA(At, 0, 0); PG8_STAGE(PG8_SA(1, 1), a1 + hstep, voffA);
            PG8_WAIT_L(8); PG8_BAR; PG8_WAIT_L(0); PG8_MMA(0, 0, At, B0); PG8_BAR; PG8_SCHED;
            PG8_LDB(B1, 0, 1); PG8_STAGE(PG8_SB(0, 0), b2, voffB);
            PG8_BAR; PG8_WAIT_L(0); PG8_MMA(0, 1, At, B1); PG8_BAR;
            PG8_LDA(At, 0, 1); PG8_STAGE(PG8_SA(0, 0), a2, voffA);
            PG8_BAR; PG8_WAIT_L(0); PG8_MMA(1, 0, At, B0); PG8_BAR; PG8_SCHED;
            PG8_STAGE(PG8_SB(0, 1), b2 + hstep, voffB);
            PG8_WAIT_V(6); PG8_BAR; PG8_MMA(1, 1, At, B1); PG8_BAR;
            PG8_LDB(B0, 1, 0); PG8_SCHED; PG8_LDA(At, 1, 0); PG8_STAGE(PG8_SA(0, 1), a2 + hstep, voffA);
            PG8_WAIT_L(8); PG8_BAR; PG8_WAIT_L(0); PG8_MMA(0, 0, At, B0); PG8_BAR; PG8_SCHED;
            PG8_LDB(B1, 1, 1); PG8_STAGE(PG8_SB(1, 0), b3, voffB);
            PG8_BAR; PG8_WAIT_L(0); PG8_MMA(0, 1, At, B1); PG8_BAR;
            PG8_LDA(At, 1, 1); PG8_STAGE(PG8_SA(1, 0), a3, voffA);
            PG8_BAR; PG8_WAIT_L(0); PG8_MMA(1, 0, At, B0); PG8_BAR; PG8_SCHED;
            PG8_STAGE(PG8_SB(1, 1), b3 + hstep, voffB);
            PG8_WAIT_V(6); PG8_BAR; PG8_MMA(1, 1, At, B1); PG8_BAR;
            }
        }
        if constexpr (ALIGN_EPI) { if (wr == 0) PG8_BAR; }
        if constexpr (!Epi::AFTER_DRAIN) { E(acc, cur, wr, wc, fr, fq); S.done(cur); }
        if (!has_next) break;
#pragma unroll
        for (int a = 0; a < 2; ++a)
#pragma unroll
            for (int b = 0; b < 2; ++b)
#pragma unroll
                for (int m = 0; m < 4; ++m)
#pragma unroll
                    for (int n = 0; n < 2; ++n) acc[a][b][m][n] = (f32x4){0.f, 0.f, 0.f, 0.f};
        cur = nxt; cA = nA; cB = nB; ++ui;
        if constexpr (ALIGN_EPI) { if (wr == 1) PG8_BAR; }
    }
    PG8_WAIT_V(0);
    if constexpr (!ALIGN_EPI) { if (wr == 0) PG8_BAR; }
    PG8_BAR;
    if constexpr (Epi::AFTER_DRAIN) { E.fused(acc, cur, wr, wc, fr, fq, lds, wid, lane); S.done(cur); }
#undef PG8_SA
#undef PG8_SB
#undef PG8_STAGE
#undef PG8_LDA
#undef PG8_LDB
#undef PG8_MMA
#undef PG8_WAIT_V
#undef PG8_WAIT_L
#undef PG8_BAR
#undef PG8_SCHED
}
}
#define GAS __attribute__((address_space(1)))
#define LAS __attribute__((address_space(3)))
typedef unsigned short bf16;
typedef unsigned v4u __attribute__((ext_vector_type(4)));
typedef float f32x4 __attribute__((ext_vector_type(4)));
typedef short bf16x8 __attribute__((ext_vector_type(8)));
typedef GAS unsigned gu32;
typedef GAS unsigned long long gu64;
#define RLX_AGENT __ATOMIC_RELAXED, __HIP_MEMORY_SCOPE_AGENT
#define LDS_WAIT() asm volatile("s_waitcnt lgkmcnt(0)" ::: "memory")
#define VM_WAIT() asm volatile("s_waitcnt vmcnt(0)" ::: "memory")
__device__ __forceinline__ unsigned long long rt() { return __builtin_amdgcn_s_memrealtime(); }
__device__ __forceinline__ unsigned f2bf(float f) { unsigned u = __builtin_bit_cast(unsigned, f); return (u + 0x7fffu + ((u >> 16) & 1u)) >> 16; }
__device__ __forceinline__ unsigned pk2(float lo, float hi) { return f2bf(lo) | (f2bf(hi) << 16); }

#define XB_TMO      128
#define XB_XCNT(j)  (256  + 64 * (j))
#define XB_XSUB(j)  (1280 + 64 * (j))
#define XB_XGEN(j)  (2304 + 64 * (j))
#define XB_TOP      3328
#define XB_TOPGEN   3392
#define XCD_BAR_WORDS 3456
#define XB_SPIN_CAP (1u << 18)

__device__ __forceinline__ unsigned xb_ld(unsigned* p)              { return __hip_atomic_load(p, __ATOMIC_RELAXED, __HIP_MEMORY_SCOPE_AGENT); }
__device__ __forceinline__ unsigned xb_add(unsigned* p, unsigned v) { return __hip_atomic_fetch_add(p, v, __ATOMIC_RELAXED, __HIP_MEMORY_SCOPE_AGENT); }
__device__ __forceinline__ unsigned xb_xcc_id() { return (unsigned)__builtin_amdgcn_s_getreg((3 << 11) | 20) & 0xFu; }
#define XB_SPIN(cond, bar) do { unsigned _sp = 0; while (cond) { __builtin_amdgcn_s_sleep(1); \
    if ((++_sp & 255u) == 0u) { if (xb_ld(&(bar)[XB_TMO])) break; if (_sp > XB_SPIN_CAP) { atomicAdd(&(bar)[XB_TMO], 1u); break; } } } } while (0)

struct XcdBarrier {
    unsigned* bar; unsigned x;
    volatile LAS unsigned* st;
};

__device__ __forceinline__ XcdBarrier xcd_barrier_post(unsigned* bar, volatile LAS unsigned* st) {
    XcdBarrier b; b.bar = bar; b.x = xb_xcc_id(); b.st = st;
    if (threadIdx.x == 0) (void)xb_add(&bar[XB_XCNT(b.x)], 1u);
    return b;
}
__device__ __forceinline__ void xcd_barrier_complete(unsigned* bar, unsigned x, unsigned& nloc, unsigned& nx) {
    const unsigned G = gridDim.x * gridDim.y * gridDim.z;
    unsigned sum, cnt, mine, sp = 0u;
    for (;;) {
        sum = 0u; cnt = 0u; mine = 0u;
#pragma unroll
        for (unsigned j = 0; j < 16; ++j) { const unsigned c = xb_ld(&bar[XB_XCNT(j)]); sum += c; cnt += (c > 0u) ? 1u : 0u; mine = (j == x) ? c : mine; }
        if (sum == G) break;
        __builtin_amdgcn_s_sleep(1);
        if ((++sp & 255u) == 0u) { if (xb_ld(&bar[XB_TMO])) break; if (sp > XB_SPIN_CAP) { atomicAdd(&bar[XB_TMO], 1u); break; } }
    }
    nloc = mine > 0u ? mine : 1u; nx = cnt > 0u ? cnt : 1u;
}

__device__ __forceinline__ void xcd_barrier(const XcdBarrier& b) {
    asm volatile("s_waitcnt vmcnt(0)" ::: "memory");
    __syncthreads();
    if (threadIdx.x == 0) {
        unsigned* bar = b.bar;
        __builtin_amdgcn_s_waitcnt(0);
        unsigned nloc = b.st[0], nx = b.st[1];
        if (nloc == 0u) { xcd_barrier_complete(bar, b.x, nloc, nx); b.st[0] = nloc; b.st[1] = nx; }
        const unsigned old = xb_add(&bar[XB_XSUB(b.x)], 1u);
        const unsigned gen = old / nloc;
        if (old + 1u == (gen + 1u) * nloc) {
            __builtin_amdgcn_fence(__ATOMIC_RELEASE, "agent");
            asm volatile("s_waitcnt vmcnt(0)" ::: "memory");
            const unsigned og = xb_add(&bar[XB_TOP], 1u);
            const unsigned tg = og / nx;
            if (og + 1u == (tg + 1u) * nx) xb_add(&bar[XB_TOPGEN], 1u);
            else XB_SPIN(xb_ld(&bar[XB_TOPGEN]) == tg, bar);
            __builtin_amdgcn_fence(__ATOMIC_ACQUIRE, "agent");
            xb_add(&bar[XB_XGEN(b.x)], 1u);
            asm volatile("s_waitcnt vmcnt(0)" ::: "memory");
        } else {
            XB_SPIN(xb_ld(&bar[XB_XGEN(b.x)]) == gen, bar);
            __builtin_amdgcn_fence(__ATOMIC_ACQUIRE, "agent");
            asm volatile("s_waitcnt vmcnt(0)" ::: "memory");
        }
    }
    __syncthreads();
}

constexpr int RING_BYTES = 131072;
constexpr int SEL_HIST_OFF = 131072, SEL_CAND_OFF = SEL_HIST_OFF + 16384, SEL_STAGE_OFF = SEL_CAND_OFF + 4096, MISC_OFF = SEL_STAGE_OFF + 4096, LDS_BYTES = 159744;
static_assert(MISC_OFF + 256 <= LDS_BYTES, "LDS map");

typedef short s16x4 __attribute__((ext_vector_type(4)));
typedef short v4i16_t __attribute__((ext_vector_type(4)));
typedef float f32x16 __attribute__((ext_vector_type(16)));
typedef unsigned u32x2 __attribute__((ext_vector_type(2)));
__device__ __forceinline__ float wave_sum(float v) {
#pragma unroll
    for (int o = 1; o < 64; o <<= 1) v += __shfl_xor(v, o);
    return v;
}
typedef float f32x2c_t __attribute__((ext_vector_type(2))); typedef __bf16 bf16x2c_t __attribute__((ext_vector_type(2)));
__device__ __forceinline__ unsigned cvtpk(float lo, float hi) { const f32x2c_t v = {lo, hi}; const bf16x2c_t b = __builtin_convertvector(v, bf16x2c_t); return __builtin_bit_cast(unsigned, b); }
__device__ __forceinline__ float bf_lo(unsigned w) { return __uint_as_float(w << 16); }
__device__ __forceinline__ float bf_hi(unsigned w) { return __uint_as_float(w & 0xffff0000u); }
__device__ __forceinline__ float swap_max(float m) { auto rr = __builtin_amdgcn_permlane32_swap(__float_as_uint(m), __float_as_uint(m), false, false); return fmaxf(__uint_as_float(rr[0]), __uint_as_float(rr[1])); }
__device__ __forceinline__ float swap_sum(float m) { auto rr = __builtin_amdgcn_permlane32_swap(__float_as_uint(m), __float_as_uint(m), false, false); return __uint_as_float(rr[0]) + __uint_as_float(rr[1]); }
__device__ __forceinline__ int crow(int r, int hi) { return (r & 3) + 8 * (r >> 2) + 4 * hi; }
__device__ __forceinline__ unsigned vimg(unsigned row, unsigned ch) { return row * 128u + 16u * (ch ^ ((row & 3u) | (((row >> 1) & 1u) << 2))); }
__device__ __forceinline__ unsigned kimg(unsigned row, unsigned ch) { return row * 128u + 16u * (ch ^ ((row >> 1) & 7u)); }
__device__ __forceinline__ s16x4 vtr(const LAS unsigned char* p) { return __builtin_bit_cast(s16x4, __builtin_amdgcn_ds_read_tr16_b64_v4i16((LAS v4i16_t*)p)); }
#define MFMA32(a, b, c) __builtin_amdgcn_mfma_f32_32x32x16_bf16((a), (b), (c), 0, 0, 0)

struct Frame {
    LAS unsigned char* lds; volatile LAS unsigned* MISC; gu32* ctl;
    int tid, lane, wave, vcu, G, bx;
};
struct Args { const float* in[11]; const int* pos; float* out; unsigned char* ws; int seg; int pad; };
typedef const Args __attribute__((address_space(4)))* cargs_t;

__device__ __forceinline__ int rope_perm64(int c) { return ((c & 31) >> 2) * 8 + (c & 3) + ((c >> 5) << 2); }
template <int KIND> __device__ __forceinline__ int phys_row(int n) {
    if (KIND == 0) { if (n < 9216 && ((n >> 10) % 3) < 2) return (n & ~63) + rope_perm64(n & 63); return n; }
    if (KIND == 1) { if (n < 1280 || (n >= 1536 && n < 2112)) return (n & ~63) + rope_perm64(n & 63); if (n >= 2120) return n + 184; return n; }
    return n;
}
template <int KIND> __device__ __forceinline__ void transpose_item(const float* W, int K, int N, bf16* WT, LAS float* scr, int item, int lane) {
    const int nblk = (N + 31) / 32, kb = item / nblk, nb = item % nblk, k0 = 64 * kb, n0 = 32 * nb;
    const bool nok = n0 + (lane & 31) < N;
#pragma unroll 8
    for (int i = 0; i < 32; ++i) { const int kk = 2 * i + (lane >> 5); scr[kk * 33 + (lane & 31)] = nok ? W[(size_t)(k0 + kk) * N + n0 + (lane & 31)] : 0.f; }
    LDS_WAIT(); asm volatile("" ::: "memory");
    const int c = lane & 7;
#pragma unroll
    for (int j = 0; j < 4; ++j) { const int n = (lane >> 3) + 8 * j; const LAS float* s = scr + (8 * c) * 33 + n;
        v4u o; o.x = pk2(s[0 * 33], s[1 * 33]); o.y = pk2(s[2 * 33], s[3 * 33]); o.z = pk2(s[4 * 33], s[5 * 33]); o.w = pk2(s[6 * 33], s[7 * 33]);
        if (n0 + n < N) *(GAS v4u*)(WT + (size_t)phys_row<KIND>(n0 + n) * K + k0 + 8 * c) = o; }
    LDS_WAIT(); asm volatile("" ::: "memory");
}
__constant__ float INVF[32] = {1.000000000e+00f, 7.498942614e-01f, 5.623413324e-01f, 4.216965139e-01f, 3.162277639e-01f, 2.371373773e-01f, 1.778279394e-01f, 1.333521307e-01f, 1.000000015e-01f, 7.498941571e-02f,
    5.623413250e-02f, 4.216965288e-02f, 3.162277490e-02f, 2.371373773e-02f, 1.778279431e-02f, 1.333521493e-02f, 9.999999776e-03f, 7.498941850e-03f, 5.623413250e-03f, 4.216964822e-03f, 3.162277630e-03f, 2.371373586e-03f,
    1.778279431e-03f, 1.333521446e-03f, 1.000000047e-03f, 7.498942432e-04f, 5.623413017e-04f, 4.216965172e-04f, 3.162277571e-04f, 2.371373703e-04f, 1.778279402e-04f, 1.333521504e-04f};

__device__ __forceinline__ void p_prologue(Frame& F, cargs_t ap) {
    const float* const* in_ = nullptr; (void)in_;
    struct { const float* in[11]; const int* pos; unsigned char* ws; } a;
#pragma unroll
    for (int i = 0; i < 11; ++i) a.in[i] = ap->in[i];
    a.pos = ap->pos; a.ws = ap->ws;
    unsigned char* ws = a.ws;
    LAS float* scr = (LAS float*)(F.lds + F.wave * 12288);
    const int gw = F.vcu * NWAVES + F.wave, NGW = F.G * NWAVES;
    constexpr int I_A = 16 * (A_N / 32), I_B = 16 * ((B_NL + 31) / 32), I_O = 16 * 32;
    constexpr int NITEMS = 2 * I_A + 2 * I_B + 4 * I_O;
    for (int it = gw; it < NITEMS; it += NGW) {
        int r = it;
        if (r < 2 * I_A) { const int l = r / I_A; transpose_item<0>(a.in[6] + (size_t)l * 1024 * A_N, 1024, A_N, (bf16*)(ws + WS_WA) + (size_t)l * A_N * 1024, scr, r % I_A, F.lane); continue; } r -= 2 * I_A;
        if (r < 2 * I_B) { const int l = r / I_B; transpose_item<1>(a.in[8] + (size_t)l * 1024 * B_NL, 1024, B_NL, (bf16*)(ws + WS_WB) + (size_t)l * B_NP * 1024, scr, r % I_B, F.lane); continue; } r -= 2 * I_B;
        { const int l = r / I_O;
          const float* W = ((l & 1) ? a.in[9] : a.in[7]) + (size_t)(l >> 1) * 1024 * 1024;
          transpose_item<2>(W, 1024, 1024, (bf16*)(ws + WS_WO) + (size_t)l * 1024 * 1024, scr, r % I_O, F.lane); }
    }
    { const int gt = (F.vcu * NWAVES + F.wave) * 64 + F.lane, NGT = NGW * 64;
      for (int i = gt; i < 2 * 184 * 128; i += NGT) { const int l = i / (184 * 128), rr = (i / 128) % 184, c = i % 128;
          *(GAS v4u*)((bf16*)(ws + WS_WB) + (size_t)l * B_NP * 1024 + (size_t)(2120 + rr) * 1024 + c * 8) = (v4u){0u, 0u, 0u, 0u}; }
      float* cs = (float*)(ws + WS_COS); float* sn = (float*)(ws + WS_SIN);
      for (int i = gt; i < MTOK * 32; i += NGT) { const int tok = i >> 5, j = i & 31;
          const float angf = (float)a.pos[tok] * INVF[j]; const double x = (double)angf;
          const double k = __builtin_rint(x * 0.15915494309189535); double r = __builtin_fma(-k, 6.283185307179586, x); r = __builtin_fma(-k, 2.4492935982947064e-16, r);
          const float rf = (float)r; cs[i] = __cosf(rf); sn[i] = __sinf(rf); }
    }
    { LAS float* cact = (LAS float*)(F.lds + 98304);
      for (int i = F.tid; i < 8 * 1024; i += NWAVES * 64) { const float v = a.in[1][i]; cact[i] = v / (1.f + __expf(-v)); }
      __syncthreads();
      const float* adaw = a.in[4]; const float* adab = a.in[5]; float* mod = (float*)(ws + WS_MOD);
      const int col = F.lane & 15, kq = F.lane >> 4;
      for (int it = gw; it < 4 * 192; it += NGW) { const int l = it / 192, n0 = (it % 192) * 16;
          float acc[8];
#pragma unroll
          for (int b = 0; b < 8; ++b) acc[b] = 0.f;
          const float* wp = adaw + (size_t)l * 1024 * 3072 + (size_t)(kq * 256) * 3072 + n0 + col;
#pragma unroll 32
          for (int k = 0; k < 256; ++k) { const float w = wp[(size_t)k * 3072];
#pragma unroll
              for (int b = 0; b < 8; ++b) acc[b] += cact[b * 1024 + kq * 256 + k] * w; }
#pragma unroll
          for (int b = 0; b < 8; ++b) { float v = acc[b]; v += __shfl_xor(v, 16); v += __shfl_xor(v, 32); acc[b] = v; }
          if (kq == 0) {
#pragma unroll
              for (int b = 0; b < 8; ++b) mod[((size_t)l * 8 + b) * 3072 + n0 + col] = acc[b] + adab[(size_t)l * 3072 + n0 + col]; }
      }
    }
}

__device__ __forceinline__ void p_norm_mod(Frame& F, const float* hin, const float* g, const float* mod_l, bf16* U) {
    const int gw = F.vcu * NWAVES + F.wave, NGW = F.G * NWAVES;
    for (int r0 = gw * 16; r0 < MTOK; r0 += NGW * 16) {
        const int b = r0 >> 12;
        f32x4 A[4], Bv[4];
#pragma unroll
        for (int j = 0; j < 4; ++j) { const int c = 4 * F.lane + 256 * j; const f32x4 gg = *(const f32x4*)(g + c), sc = *(const f32x4*)(mod_l + (size_t)b * 3072 + 1024 + c);
            A[j] = gg * (sc + 1.0f); Bv[j] = *(const f32x4*)(mod_l + (size_t)b * 3072 + c); }
        for (int rr = 0; rr < 16; ++rr) {
            const int row = r0 + rr; const GAS f32x4* xr = (const GAS f32x4*)(hin + (size_t)row * DM) + F.lane;
            f32x4 v[4]; float s = 0.f;
#pragma unroll
            for (int j = 0; j < 4; ++j) { v[j] = xr[64 * j]; s += (v[j].x * v[j].x + v[j].y * v[j].y) + (v[j].z * v[j].z + v[j].w * v[j].w); }
            const float rstd = 1.0f / sqrtf(wave_sum(s) * (1.f / DM) + NORM_EPS);
            GAS u32x2* o8 = (GAS u32x2*)(U + (size_t)row * DM) + F.lane;
#pragma unroll
            for (int j = 0; j < 4; ++j) { const f32x4 y = (v[j] * rstd) * A[j] + Bv[j]; o8[64 * j] = (u32x2){cvtpk(y.x, y.y), cvtpk(y.z, y.w)}; }
        }
    }
}
__device__ __forceinline__ void p_final_norm(Frame& F, const float* hin, const float* g, float* out) {
    const int gw = F.vcu * NWAVES + F.wave, NGW = F.G * NWAVES;
    f32x4 A[4];
#pragma unroll
    for (int j = 0; j < 4; ++j) A[j] = *(const f32x4*)(g + 4 * F.lane + 256 * j);
    for (int row = gw; row < MTOK; row += NGW) {
        const GAS f32x4* xr = (const GAS f32x4*)(hin + (size_t)row * DM) + F.lane;
        f32x4 v[4]; float s = 0.f;
#pragma unroll
        for (int j = 0; j < 4; ++j) { v[j] = xr[64 * j]; s += (v[j].x * v[j].x + v[j].y * v[j].y) + (v[j].z * v[j].z + v[j].w * v[j].w); }
        const float rstd = 1.0f / sqrtf(wave_sum(s) * (1.f / DM) + NORM_EPS);
        GAS f32x4* o = (GAS f32x4*)(out + (size_t)row * DM) + F.lane;
#pragma unroll
        for (int j = 0; j < 4; ++j) o[64 * j] = (v[j] * rstd) * A[j];
    }
}

__device__ __forceinline__ void attnA_tile(const bf16* Qp, bf16* Op, const bf16* Kp, const bf16* Vp, float* lsep, int lse_stride, int rstride, int i0, LAS unsigned char* vst, int lane) {
    const int q32 = lane & 31, hi = lane >> 5;
    bf16x8 qf[4];
    { const bf16* qrow = Qp + (size_t)(i0 + q32) * rstride + 8 * hi;
#pragma unroll
      for (int ks = 0; ks < 4; ++ks) qf[ks] = *(const bf16x8*)(qrow + 16 * ks); }
    f32x16 o0 = {}, o1 = {};
    float m_run = -INFINITY, l_run = 0.f;
    const int kt0 = (i0 >= 128) ? 0 : (128 - i0) / 32;
    const int vc = lane & 7, vrow = lane >> 3;
    bf16x8 kall[5][4]; v4u vb[2][4];
#pragma unroll
    for (int kt = 0; kt < 5; ++kt) if (kt >= kt0) { const bf16* kr_ = Kp + (size_t)(i0 - 128 + 32 * kt + q32) * rstride + 8 * hi;
#pragma unroll
        for (int ks = 0; ks < 4; ++ks) kall[kt][ks] = *(const bf16x8*)(kr_ + 16 * ks); }
#define ATT_LOADV(kt_, buf_) do { _Pragma("unroll") for (int i = 0; i < 4; ++i) vb[buf_][i] = *(const v4u*)(Vp + (size_t)(i0 - 128 + 32 * (kt_) + vrow + 8 * i) * rstride + 8 * vc); } while (0)
#pragma unroll
    for (int kt = 0; kt < 5; ++kt) if (kt == kt0 || kt == kt0 + 1) ATT_LOADV(kt, kt & 1);
    const int q4 = (lane & 15) >> 2, blk = (lane >> 4) & 1, p4 = lane & 3;
#pragma unroll
    for (int kt = 0; kt < 5; ++kt) if (kt >= kt0) {
#pragma unroll
        for (int i = 0; i < 4; ++i) *(LAS v4u*)(vst + vimg(vrow + 8 * i, vc)) = vb[kt & 1][i];
        if (kt + 2 < 5) ATT_LOADV(kt + 2, kt & 1);
        bf16x8 kc[4];
#pragma unroll
        for (int ks = 0; ks < 4; ++ks) kc[ks] = kall[kt][ks];
        f32x16 p = {};
#pragma unroll
        for (int ks = 0; ks < 4; ++ks) p = MFMA32(kc[ks], qf[ks], p);
        if (kt == 0) {
#pragma unroll
            for (int r = 0; r < 16; ++r) if (crow(r, hi) < q32) p[r] = -INFINITY;
        }
        if (kt == 4) {
#pragma unroll
            for (int r = 0; r < 16; ++r) if (crow(r, hi) > q32) p[r] = -INFINITY;
        }
        LDS_WAIT(); asm volatile("" ::: "memory");
        s16x4 vlo[4], vup[4];
#pragma unroll
        for (int ks = 0; ks < 2; ++ks)
#pragma unroll
            for (int d0 = 0; d0 < 2; ++d0) {
                vlo[2 * ks + d0] = vtr(vst + vimg(16 * ks + 4 * hi + q4, 4 * d0 + 2 * blk + (p4 >> 1)) + 8 * (p4 & 1));
                vup[2 * ks + d0] = vtr(vst + vimg(16 * ks + 8 + 4 * hi + q4, 4 * d0 + 2 * blk + (p4 >> 1)) + 8 * (p4 & 1));
            }
        float mt = p[0];
#pragma unroll
        for (int r = 1; r < 16; ++r) mt = fmaxf(mt, p[r]);
        mt = swap_max(mt);
        if (__any(mt > m_run)) {
            const float m_new = fmaxf(m_run, mt);
            const float alpha = __builtin_amdgcn_exp2f(m_run - m_new);
            l_run *= alpha; m_run = m_new;
#pragma unroll
            for (int r = 0; r < 16; ++r) { o0[r] *= alpha; o1[r] *= alpha; }
        }
        float s = 0.f;
#pragma unroll
        for (int r = 0; r < 16; ++r) { p[r] = __builtin_amdgcn_exp2f(p[r] - m_run); s += p[r]; }
        l_run += s;
        bf16x8 pf[2];
#pragma unroll
        for (int ks = 0; ks < 2; ++ks) { v4u w; w.x = cvtpk(p[8 * ks + 0], p[8 * ks + 1]); w.y = cvtpk(p[8 * ks + 2], p[8 * ks + 3]); w.z = cvtpk(p[8 * ks + 4], p[8 * ks + 5]); w.w = cvtpk(p[8 * ks + 6], p[8 * ks + 7]); pf[ks] = __builtin_bit_cast(bf16x8, w); }
#pragma unroll
        for (int ks = 0; ks < 2; ++ks)
#pragma unroll
            for (int d0 = 0; d0 < 2; ++d0) {
                const s16x4 lo = vlo[2 * ks + d0], up = vup[2 * ks + d0];
                const bf16x8 vf = (bf16x8){lo[0], lo[1], lo[2], lo[3], up[0], up[1], up[2], up[3]};
                if (d0 == 0) o0 = MFMA32(vf, pf[ks], o0); else o1 = MFMA32(vf, pf[ks], o1);
            }
        LDS_WAIT(); asm volatile("" ::: "memory");
    }
#undef ATT_LOADV
    const float l_tot = swap_sum(l_run), inv = 1.0f / l_tot;
    bf16* orow = Op + (size_t)(i0 + q32) * rstride;
#pragma unroll
    for (int g4 = 0; g4 < 4; ++g4) {
        *(u32x2*)(orow + 8 * g4 + 4 * hi) = (u32x2){cvtpk(o0[4 * g4] * inv, o0[4 * g4 + 1] * inv), cvtpk(o0[4 * g4 + 2] * inv, o0[4 * g4 + 3] * inv)};
        *(u32x2*)(orow + 32 + 8 * g4 + 4 * hi) = (u32x2){cvtpk(o1[4 * g4] * inv, o1[4 * g4 + 1] * inv), cvtpk(o1[4 * g4 + 2] * inv, o1[4 * g4 + 3] * inv)};
    }
    if (hi == 0) lsep[(size_t)(i0 + q32) * lse_stride] = m_run + __builtin_amdgcn_logf(l_tot);
}
struct AUnit { bf16* Qp; const bf16* Kp; const bf16* Vp; float* lsep; int lse_stride, rstride, i0; };
__device__ __forceinline__ AUnit a_unit(int u, bf16* act, float* lse) {
    const int cb = u & 15, h = (u >> 4) & 15, g = (u >> 8) % 3, bl = u / 768;
    const int dl = (g == 0) ? 1 : (g == 1 ? 4 : 16), nbk = 16 / dl;
    const int r = cb / nbk, bk = cb % nbk;
    const size_t row_base = (size_t)bl * SEQ + r;
    AUnit U;
    U.Qp = act + (size_t)(3 * g + 0) * (A_SUB / 2) + row_base * 1024 + h * 64;
    U.Kp = act + (size_t)(3 * g + 1) * (A_SUB / 2) + row_base * 1024 + h * 64;
    U.Vp = act + (size_t)(3 * g + 2) * (A_SUB / 2) + row_base * 1024 + h * 64;
    U.lsep = lse + ((size_t)g * MC + row_base) * 16 + h; U.lse_stride = 16 * dl; U.rstride = dl * 1024; U.i0 = bk * 256;
    return U;
}
#define A_LOADS(U_) do { const int lo_ = ((U_).i0 >= 128) ? 0 : 128; \
        _Pragma("unroll") for (int i = 0; i < 6; ++i) { const int c_ = F.tid + 512 * i, row_ = c_ >> 3, ch_ = c_ & 7; \
            if (row_ >= lo_) { const size_t off_ = (size_t)((U_).i0 - 128 + row_) * (U_).rstride + 8 * ch_; kreg[i] = *(const v4u*)((U_).Kp + off_); vreg[i] = *(const v4u*)((U_).Vp + off_); } } \
        { const bf16* qrow_ = (U_).Qp + (size_t)((U_).i0 + 32 * F.wave + q32) * (U_).rstride + 8 * hi; \
          _Pragma("unroll") for (int ks = 0; ks < 4; ++ks) qn[ks] = *(const bf16x8*)(qrow_ + 16 * ks); } } while (0)
#define A_STAGE() do { _Pragma("unroll") for (int i = 0; i < 6; ++i) { const int c_ = F.tid + 512 * i, row_ = c_ >> 3, ch_ = c_ & 7; \
            *(LAS v4u*)(Kl + kimg(row_, ch_)) = kreg[i]; *(LAS v4u*)(Vl + vimg(row_, ch_)) = vreg[i]; } } while (0)
__device__ __forceinline__ void p_attnA(Frame& F, bf16* act, float* lse, bf16* dump) {
    LAS unsigned char* Vl = F.lds; LAS unsigned char* Kl = F.lds + 49152;
    constexpr int NBL = MC / SEQ, NUNITS = NBL * 3 * 16 * 16;
    const int lane = F.lane, q32 = lane & 31, hi = lane >> 5;
    const int q4 = (lane & 15) >> 2, blk = (lane >> 4) & 1, p4 = lane & 3;
    v4u kreg[6], vreg[6]; bf16x8 qn[4], qf[4];
#pragma unroll
    for (int i = 0; i < 6; ++i) { kreg[i] = (v4u){0u, 0u, 0u, 0u}; vreg[i] = (v4u){0u, 0u, 0u, 0u}; }
    int u = F.bx;
    if (u >= NUNITS) return;
    AUnit cur = a_unit(u, act, lse);
    A_LOADS(cur);
    A_STAGE();
#pragma unroll
    for (int ks = 0; ks < 4; ++ks) qf[ks] = qn[ks];
    __syncthreads();
    for (;;) {
        const int un = u + F.G; const bool has_next = un < NUNITS;
        AUnit nxt = cur;
#ifndef ATTA_NOPF
        if (has_next) { nxt = a_unit(un, act, lse); A_LOADS(nxt); }
#endif
        {
            const int i0w = cur.i0 + 32 * F.wave;
            f32x16 o0 = {}, o1 = {};
            float m_run = -INFINITY, l_run = 0.f;
            const int kt0 = (i0w >= 128) ? 0 : (128 - i0w) / 32;
            for (int kt = kt0; kt < 5; ++kt) {
                const int lrow = 32 * F.wave + 32 * kt;
                f32x16 p = {};
#ifdef ATTA_FULLWAIT
                bf16x8 kfr[4];
#pragma unroll
                for (int ks = 0; ks < 4; ++ks) kfr[ks] = *(const LAS bf16x8*)(Kl + kimg(lrow + q32, 2 * ks + hi));
                asm volatile("s_waitcnt lgkmcnt(0)" : "+v"(kfr[0]), "+v"(kfr[1]), "+v"(kfr[2]), "+v"(kfr[3]) :: "memory");
#pragma unroll
                for (int ks = 0; ks < 4; ++ks) p = MFMA32(kfr[ks], qf[ks], p);
#else
#pragma unroll
                for (int ks = 0; ks < 4; ++ks) { const bf16x8 kf = *(const LAS bf16x8*)(Kl + kimg(lrow + q32, 2 * ks + hi)); p = MFMA32(kf, qf[ks], p); }
#endif
                if (kt == 0) {
#pragma unroll
                    for (int r = 0; r < 16; ++r) if (crow(r, hi) < q32) p[r] = -INFINITY;
                }
                if (kt == 4) {
#pragma unroll
                    for (int r = 0; r < 16; ++r) if (crow(r, hi) > q32) p[r] = -INFINITY;
                }
                float mt = p[0];
#pragma unroll
                for (int r = 1; r < 16; ++r) mt = fmaxf(mt, p[r]);
                mt = swap_max(mt);
                if (__any(mt > m_run)) {
                    const float m_new = fmaxf(m_run, mt);
                    const float alpha = __builtin_amdgcn_exp2f(m_run - m_new);
                    l_run *= alpha; m_run = m_new;
#pragma unroll
                    for (int r = 0; r < 16; ++r) { o0[r] *= alpha; o1[r] *= alpha; }
                }
                float ssum = 0.f;
#pragma unroll
                for (int r = 0; r < 16; ++r) { p[r] = __builtin_amdgcn_exp2f(p[r] - m_run); ssum += p[r]; }
                l_run += ssum;
                bf16x8 pf[2];
#pragma unroll
                for (int ks = 0; ks < 2; ++ks) { v4u w; w.x = cvtpk(p[8 * ks + 0], p[8 * ks + 1]); w.y = cvtpk(p[8 * ks + 2], p[8 * ks + 3]); w.z = cvtpk(p[8 * ks + 4], p[8 * ks + 5]); w.w = cvtpk(p[8 * ks + 6], p[8 * ks + 7]); pf[ks] = __builtin_bit_cast(bf16x8, w); }
#pragma unroll
                for (int ks = 0; ks < 2; ++ks)
#pragma unroll
                    for (int d0 = 0; d0 < 2; ++d0) {
                        s16x4 lo = vtr(Vl + vimg(lrow + 16 * ks + 4 * hi + q4, 4 * d0 + 2 * blk + (p4 >> 1)) + 8 * (p4 & 1));
                        s16x4 up = vtr(Vl + vimg(lrow + 16 * ks + 8 + 4 * hi + q4, 4 * d0 + 2 * blk + (p4 >> 1)) + 8 * (p4 & 1));
#ifdef ATTA_FULLWAIT
                        asm volatile("s_waitcnt lgkmcnt(0)" : "+v"(lo), "+v"(up) :: "memory");
#endif
                        const bf16x8 vf = (bf16x8){lo[0], lo[1], lo[2], lo[3], up[0], up[1], up[2], up[3]};
                        if (d0 == 0) o0 = MFMA32(vf, pf[ks], o0); else o1 = MFMA32(vf, pf[ks], o1);
                    }
            }
            const float l_tot = swap_sum(l_run), inv = 1.0f / l_tot;
            bf16* Ob = dump ? dump + (cur.Qp - act) % (A_SUB / 2) : cur.Qp;
            bf16* orow = Ob + (size_t)(i0w + q32) * cur.rstride;
#pragma unroll
            for (int g4 = 0; g4 < 4; ++g4) {
                *(u32x2*)(orow + 8 * g4 + 4 * hi) = (u32x2){cvtpk(o0[4 * g4] * inv, o0[4 * g4 + 1] * inv), cvtpk(o0[4 * g4 + 2] * inv, o0[4 * g4 + 3] * inv)};
                *(u32x2*)(orow + 32 + 8 * g4 + 4 * hi) = (u32x2){cvtpk(o1[4 * g4] * inv, o1[4 * g4 + 1] * inv), cvtpk(o1[4 * g4 + 2] * inv, o1[4 * g4 + 3] * inv)};
            }
            if (hi == 0) cur.lsep[(size_t)(i0w + q32) * cur.lse_stride] = m_run + __builtin_amdgcn_logf(l_tot);
        }
        if (!has_next) break;
        __syncthreads();
#ifdef ATTA_NOPF
        nxt = a_unit(un, act, lse); A_LOADS(nxt);
#endif
        A_STAGE();
#pragma unroll
        for (int ks = 0; ks < 4; ++ks) qf[ks] = qn[ks];
        cur = nxt; u = un;
        __syncthreads();
    }
    __syncthreads();
}
#undef A_LOADS
#undef A_STAGE
__device__ __forceinline__ void p_mergeA(Frame& F, const bf16* act, const float* lse, bf16* Z  ) {
    const int gw = F.vcu * NWAVES + F.wave, NGW = F.G * NWAVES;
    const int head = F.lane >> 2;
    for (int row = gw; row < MC; row += NGW) {
        float l0 = lse[((size_t)0 * MC + row) * 16 + head], l1 = lse[((size_t)1 * MC + row) * 16 + head], l2 = lse[((size_t)2 * MC + row) * 16 + head];
        const float mx = fmaxf(l0, fmaxf(l1, l2));
        float e0 = __builtin_amdgcn_exp2f(l0 - mx), e1 = __builtin_amdgcn_exp2f(l1 - mx), e2 = __builtin_amdgcn_exp2f(l2 - mx);
        const float inv = 1.0f / (e0 + e1 + e2); e0 *= inv; e1 *= inv; e2 *= inv;
#pragma unroll
        for (int hf = 0; hf < 2; ++hf) {
            const size_t off = (size_t)row * 1024 + 16 * F.lane + 8 * hf;
            const v4u a0 = *(const v4u*)(act + (size_t)0 * (A_SUB / 2) + off), a1 = *(const v4u*)(act + (size_t)3 * (A_SUB / 2) + off), a2 = *(const v4u*)(act + (size_t)6 * (A_SUB / 2) + off),
                      gg = *(const v4u*)(act + (size_t)9 * (A_SUB / 2) + off);
            v4u o;
#pragma unroll
            for (int k = 0; k < 4; ++k) {
                const float ylo = (e0 * bf_lo(a0[k]) + e1 * bf_lo(a1[k]) + e2 * bf_lo(a2[k])) * bf_lo(gg[k]);
                const float yhi = (e0 * bf_hi(a0[k]) + e1 * bf_hi(a1[k]) + e2 * bf_hi(a2[k])) * bf_hi(gg[k]);
                o[k] = cvtpk(ylo, yhi);
            }
            *(v4u*)(Z + off) = o;
        }
    }
}

__device__ __forceinline__ unsigned ordkey(float f) { unsigned u = __float_as_uint(f); if ((u << 1) == 0u) u = 0u; return (u & 0x80000000u) ? ~u : (u | 0x80000000u); }
#define IDX_LOAD_QW(qf_, wv_, b_, t0_) do { const size_t tk_ = (size_t)(b_) * SEQ + (t0_); const int c32_ = F.lane & 31, hi_ = F.lane >> 5; \
        const int tl_ = 2 * ((c32_ >> 2) & 1) + (c32_ >> 4), hd_ = ((c32_ >> 3) & 1) * 4 + (c32_ & 3); \
        _Pragma("unroll") for (int R = 0; R < 2; ++R) { const bf16* qp_ = QI + (tk_ + 4 * R + tl_) * 512 + hd_ * 64 + 8 * hi_; \
            _Pragma("unroll") for (int ks = 0; ks < 4; ++ks) qf_[R][ks] = *(const bf16x8*)(qp_ + 16 * ks); \
            _Pragma("unroll") for (int tt = 0; tt < 2; ++tt) { const float* wp_ = WI + (tk_ + 4 * R + 2 * hi_ + tt) * 8; wv_[R][tt][0] = *(const f32x4*)wp_; wv_[R][tt][1] = *(const f32x4*)(wp_ + 4); } } } while (0)
__device__ __forceinline__ void index_tile(Frame& F, int b, int t0, const bf16* QI, const bf16* KI, const float* WI, unsigned long long* maskw,
                                           bf16x8 (&qf)[2][4], f32x4 (&wv)[2][2][2], bf16x8 (&qn)[2][4], f32x4 (&wn)[2][2][2], bool has_next, int bn, int t0n) {
    LAS float* sc = (LAS float*)F.lds;
    LAS unsigned* hist = (LAS unsigned*)(F.lds + SEL_HIST_OFF) + F.wave * 512;
    LAS unsigned* cand = (LAS unsigned*)(F.lds + SEL_CAND_OFF);
    LAS unsigned long long* stage = (LAS unsigned long long*)(F.lds + SEL_STAGE_OFF);
    const int lane = F.lane, c32 = lane & 31, hi = lane >> 5;
    const size_t tok0 = (size_t)b * SEQ + t0;
#ifndef IDX_REP_SCORE
#define IDX_REP_SCORE 1
#endif
#ifndef IDX_REP_SEL
#define IDX_REP_SEL 1
#endif
    for (int rep_ = 0; rep_ < IDX_REP_SCORE; ++rep_) {
        const int nkt = (t0 + 8 + 31) >> 5;
        bf16x8 kf[4], kg[4];
        const bf16* kbase = KI + ((size_t)b * SEQ * 64) + (size_t)(hi * 32 + c32) * 8;
        int kt = F.wave;
        if (kt < nkt) {
#pragma unroll
            for (int ks = 0; ks < 4; ++ks) kf[ks] = *(const bf16x8*)(kbase + (size_t)kt * 2048 + 512 * ks);
        }
        if (kt + NWAVES < nkt) {
#pragma unroll
            for (int ks = 0; ks < 4; ++ks) kg[ks] = *(const bf16x8*)(kbase + (size_t)(kt + NWAVES) * 2048 + 512 * ks);
        }
        for (; kt < nkt; kt += NWAVES) {
            bf16x8 kc[4];
#pragma unroll
            for (int ks = 0; ks < 4; ++ks) { kc[ks] = kf[ks]; kf[ks] = kg[ks]; }
            if (kt + 2 * NWAVES < nkt) {
#pragma unroll
                for (int ks = 0; ks < 4; ++ks) kg[ks] = *(const bf16x8*)(kbase + (size_t)(kt + 2 * NWAVES) * 2048 + 512 * ks);
            }
#pragma unroll
            for (int R = 0; R < 2; ++R) {
                f32x16 acc = {};
#pragma unroll
                for (int ks = 0; ks < 4; ++ks) acc = MFMA32(qf[R][ks], kc[ks], acc);
#pragma unroll
                for (int tt = 0; tt < 2; ++tt) {
                    float s = 0.f;
#pragma unroll
                    for (int i = 0; i < 8; ++i) s += wv[R][tt][i >> 2][i & 3] * fmaxf(acc[8 * tt + i], 0.f);
                    sc[(4 * R + 2 * hi + tt) * 4096 + kt * 32 + c32] = s;
                }
            }
        }
    }
    __syncthreads();
    if (has_next) IDX_LOAD_QW(qn, wn, bn, t0n);
    for (int rep_ = 0; rep_ < IDX_REP_SEL; ++rep_) {
        const int t = t0 + F.wave, n = t + 1;
        const LAS float* scq = sc + F.wave * 4096;
        unsigned long long myword = 0ull;
        bool done = false;
        if (n <= 256) {
            const int j = lane; const int rem = n - 64 * j;
            myword = rem >= 64 ? ~0ull : (rem > 0 ? ((1ull << rem) - 1ull) : 0ull);
            done = true;
        } else {
            float lo = INFINITY, hi = -INFINITY;
            const int ntrip = (n + 255) >> 8;
            {
                f32x4 vn = *(const LAS f32x4*)(scq + 4 * lane);
                for (int i = 0; i < ntrip; ++i) { const int idx = 4 * (lane + 64 * i); const f32x4 v = vn;
                    if (i + 1 < ntrip) vn = *(const LAS f32x4*)(scq + idx + 256);
#pragma unroll
                    for (int e = 0; e < 4; ++e) { const bool ok = idx + e < n; lo = fminf(lo, ok ? v[e] : INFINITY); hi = fmaxf(hi, ok ? v[e] : -INFINITY); } }
            }
#pragma unroll
            for (int o = 1; o < 64; o <<= 1) { lo = fminf(lo, __shfl_xor(lo, o)); hi = fmaxf(hi, __shfl_xor(hi, o)); }
            if (hi > lo) {
                const float scale = 512.0f / (hi - lo);
                *(LAS v4u*)(hist + 8 * lane) = (v4u){0u, 0u, 0u, 0u}; *(LAS v4u*)(hist + 8 * lane + 4) = (v4u){0u, 0u, 0u, 0u};
                LDS_WAIT(); asm volatile("" ::: "memory");
                {
                    LAS unsigned* dummy = cand + F.wave * 128 + 127;
                    f32x4 vn = *(const LAS f32x4*)(scq + 4 * lane);
                    for (int i = 0; i < ntrip; ++i) { const int idx = 4 * (lane + 64 * i); const f32x4 v = vn;
                        if (i + 1 < ntrip) vn = *(const LAS f32x4*)(scq + idx + 256);
#pragma unroll
                        for (int e = 0; e < 4; ++e) { const int bn = min(511, (int)((v[e] - lo) * scale));
                            LAS unsigned* dst = (idx + e < n) ? (hist + bn) : dummy;
                            __hip_atomic_fetch_add(dst, 1u, __ATOMIC_RELAXED, __HIP_MEMORY_SCOPE_WORKGROUP); } }
                }
                LDS_WAIT(); asm volatile("" ::: "memory");
                const v4u c0 = *(const LAS v4u*)(hist + 8 * lane), c1 = *(const LAS v4u*)(hist + 8 * lane + 4);
                unsigned cc[8] = {c0.x, c0.y, c0.z, c0.w, c1.x, c1.y, c1.z, c1.w};
                const unsigned ls = ((c0.x + c0.y) + (c0.z + c0.w)) + ((c1.x + c1.y) + (c1.z + c1.w));
                unsigned inc = ls;
#pragma unroll
                for (int o = 1; o < 64; o <<= 1) { const unsigned v = __shfl_up(inc, o); if (lane >= o) inc += v; }
                const unsigned total = __shfl(inc, 63);
                const unsigned S = total - inc;
                const bool found = (S < 256u) && (256u <= S + ls);
                unsigned acc = S; int bin = 0; unsigned above = S; bool got = false;
#pragma unroll
                for (int q = 7; q >= 0; --q) { if (!got) { if (acc + cc[q] >= 256u) { bin = q; above = acc; got = true; } else acc += cc[q]; } }
                const unsigned long long fm = __ballot(found);
                const int src = fm ? (__ffsll((long long)fm) - 1) : 0;
                const int B = __shfl(8 * lane + bin, src); const unsigned aboveb = __shfl(above, src);
                const unsigned mB = __shfl(cc[0] * 0u + ((bin == 0) ? cc[0] : (bin == 1) ? cc[1] : (bin == 2) ? cc[2] : (bin == 3) ? cc[3] : (bin == 4) ? cc[4] : (bin == 5) ? cc[5] : (bin == 6) ? cc[6] : cc[7]), src);
                const unsigned kk2 = 256u - aboveb;
                if (mB <= 64u) {
                    LAS unsigned* ckey = cand + F.wave * 128; LAS unsigned* cidx = ckey + 64;
                    unsigned base = 0u;
                    for (int j4 = 0; 256 * j4 < n; ++j4) {
                        float xs[4];
#pragma unroll
                        for (int c = 0; c < 4; ++c) xs[c] = scq[64 * (4 * j4 + c) + lane];
#pragma unroll
                        for (int c = 0; c < 4; ++c) {
                            const int j = 4 * j4 + c, sidx = 64 * j + lane; const bool v = sidx < n; const float x = xs[c];
                            const int bq = min(511, (int)((x - lo) * scale));
                            const bool gt = v && bq > B, eq = v && bq == B;
                            const unsigned long long wj = __ballot(gt), em = __ballot(eq);
                            if (eq) { const unsigned pos = base + (unsigned)__popcll(em & ((1ull << lane) - 1ull)); ckey[pos] = ordkey(x); cidx[pos] = (unsigned)sidx; }
                            base += (unsigned)__popcll(em);
                            if (lane == j) myword = wj;
                        }
                    }
                    stage[F.wave * 64 + lane] = myword;
                    LDS_WAIT(); asm volatile("" ::: "memory");
                    const unsigned m = base;
                    const unsigned mykey = (unsigned)lane < m ? ckey[lane] : 0u, myidx = (unsigned)lane < m ? cidx[lane] : 0u;
                    unsigned rank = 0u;
                    for (unsigned f = 0; f < m; ++f) { const unsigned kf = ckey[f]; rank += (kf > mykey || (kf == mykey && f < (unsigned)lane)) ? 1u : 0u; }
                    if ((unsigned)lane < m && rank < kk2)
                        __hip_atomic_fetch_or((LAS unsigned*)stage + F.wave * 128 + (myidx >> 5), 1u << (myidx & 31u), __ATOMIC_RELAXED, __HIP_MEMORY_SCOPE_WORKGROUP);
                    done = true;
                }
            }
        }
        if (!done) {
            unsigned T = 0u; int kk = 256; unsigned prefix = 0u;
#pragma unroll
            for (int pass = 0; pass < 4; ++pass) {
                const int shift = 24 - 8 * pass;
                *(LAS v4u*)(hist + 4 * lane) = (v4u){0u, 0u, 0u, 0u};
                LDS_WAIT(); asm volatile("" ::: "memory");
                for (int s2 = lane; s2 < n; s2 += 64) {
                    const unsigned key = ordkey(scq[s2]);
                    const bool in = (pass == 0) ? true : ((key >> ((shift + 8) & 31)) == prefix);
                    if (in) __hip_atomic_fetch_add(hist + ((key >> shift) & 255u), 1u, __ATOMIC_RELAXED, __HIP_MEMORY_SCOPE_WORKGROUP);
                }
                LDS_WAIT(); asm volatile("" ::: "memory");
                const v4u c = *(const LAS v4u*)(hist + 4 * lane);
                const unsigned ls = c.x + c.y + c.z + c.w;
                unsigned inc = ls;
#pragma unroll
                for (int o = 1; o < 64; o <<= 1) { const unsigned v = __shfl_up(inc, o); if (lane >= o) inc += v; }
                const unsigned total = __shfl(inc, 63);
                const unsigned S = total - inc;
                const bool found = (S < (unsigned)kk) && ((unsigned)kk <= S + ls);
                unsigned acc = S; int bin; unsigned above;
                if (acc + c.w >= (unsigned)kk) { bin = 3; above = acc; }
                else { acc += c.w; if (acc + c.z >= (unsigned)kk) { bin = 2; above = acc; }
                else { acc += c.z; if (acc + c.y >= (unsigned)kk) { bin = 1; above = acc; }
                else { acc += c.y; bin = 0; above = acc; } } }
                const unsigned long long fm = __ballot(found);
                const int src = fm ? (__ffsll((long long)fm) - 1) : 0;
                const int binb = __shfl(4 * lane + bin, src); const unsigned aboveb = __shfl(above, src);
                prefix = (prefix << 8) | (unsigned)binb; kk -= (int)aboveb;
            }
            T = prefix;
            unsigned taken = 0u; myword = 0ull;
            for (int j = 0; 64 * j < n; ++j) {
                const int s2 = 64 * j + lane; const bool v = s2 < n;
                const unsigned key = v ? ordkey(scq[s2]) : 0u;
                const bool gt = v && key > T, eq = v && key == T;
                const unsigned long long em = __ballot(eq);
                const unsigned rank = taken + (unsigned)__popcll(em & ((1ull << lane) - 1ull));
                const bool sel = gt || (eq && rank < (unsigned)kk);
                taken += (unsigned)__popcll(em);
                const unsigned long long w = __ballot(sel);
                if (lane == j) myword = w;
            }
            stage[F.wave * 64 + lane] = myword;
        } else if (n <= 256) stage[F.wave * 64 + lane] = myword;
    }
    __syncthreads();
    { const int j = F.tid >> 3, tq = F.tid & 7; maskw[((size_t)b * 64 + j) * 4096 + t0 + tq] = stage[tq * 64 + j]; }
}
__device__ __forceinline__ void p_index(Frame& F, const bf16* QI, const bf16* KI, const float* WI, unsigned long long* maskw) {
    bf16x8 qf[2][4], qn[2][4]; f32x4 wv[2][2][2], wn[2][2][2];
    int L = F.vcu; if (L >= 4096) return;
    int b, t0; { const int i = L >> 8, v = L & 255; b = i >> 1; t0 = 8 * ((i & 1) ? 511 - v : v); }
    IDX_LOAD_QW(qf, wv, b, t0);
    for (;;) {
        const int Ln = L + F.G; const bool has_next = Ln < 4096;
        int bn = b, t0n = t0; if (has_next) { const int i = Ln >> 8, v = Ln & 255; bn = i >> 1; t0n = 8 * ((i & 1) ? 511 - v : v); }
        index_tile(F, b, t0, QI, KI, WI, maskw, qf, wv, qn, wn, has_next, bn, t0n);
        if (!has_next) break;
#pragma unroll
        for (int R = 0; R < 2; ++R) {
#pragma unroll
            for (int ks = 0; ks < 4; ++ks) qf[R][ks] = qn[R][ks];
#pragma unroll
            for (int tt = 0; tt < 2; ++tt) { wv[R][tt][0] = wn[R][tt][0]; wv[R][tt][1] = wn[R][tt][1]; } }
        L = Ln; b = bn; t0 = t0n;
    }
}

__device__ __forceinline__ float mask_sel(float p, unsigned bits, int c) {
    const unsigned m = (unsigned)__builtin_amdgcn_sbfe((int)bits, (unsigned)c, 1u);
    return __uint_as_float((m & __float_as_uint(p)) | (~m & 0xff800000u));
}
__device__ __forceinline__ void attnB_unit(Frame& F, int b, int kvh, int blkq, const bf16* Q, const bf16* K, const bf16* V, const bf16* G, const unsigned long long* maskw, bf16* Z) {
    const int lane = F.lane, q32 = lane & 31, hi = lane >> 5, w = F.wave;
    const int head = 4 * kvh + (w >> 1), tok = blkq * 64 + 32 * (w & 1) + q32;
    const size_t grow = (size_t)b * SEQ + tok;
    const int NT = blkq + 1;
    bf16x8 qf[4];
    { const bf16* qrow = Q + grow * 1024 + head * 64 + 8 * hi;
#pragma unroll
      for (int ks = 0; ks < 4; ++ks) qf[ks] = *(const bf16x8*)(qrow + 16 * ks); }
    LAS unsigned char* Kb = F.lds; LAS unsigned char* Vb = F.lds + 16384;
    const int srow = F.tid >> 3, sch = F.tid & 7;
    const bf16* ksrc = K + ((size_t)b * SEQ + srow) * 256 + kvh * 64 + 8 * sch;
    const bf16* vsrc = V + ((size_t)b * SEQ + srow) * 256 + kvh * 64 + 8 * sch;
    const unsigned long long* mp = maskw + (size_t)b * 64 * 4096 + tok;
    v4u kreg = *(const v4u*)ksrc, vreg = *(const v4u*)vsrc;
    unsigned long long mw_next = mp[0];
    *(LAS v4u*)(Kb + kimg(srow, sch)) = kreg; *(LAS v4u*)(Vb + vimg(srow, sch)) = vreg;
    __syncthreads();
    f32x16 o0 = {}, o1 = {}, ol = {}, negm = {};
    const short one = (q32 == 0) ? (short)0x3F80 : (short)0;
    const bf16x8 ones = (bf16x8){one, one, one, one, one, one, one, one};
    const int q4 = (lane & 15) >> 2, blk = (lane >> 4) & 1, p4 = lane & 3;
    const unsigned koff0 = kimg(q32, hi), voff0 = vimg(4 * hi + q4, 2 * blk + (p4 >> 1)) + 8 * (p4 & 1);
    for (int j = 0; j < NT; ++j) {
        const unsigned long long mw = mw_next;
        if (j + 1 < NT) { kreg = *(const v4u*)(ksrc + (size_t)(j + 1) * 64 * 256); vreg = *(const v4u*)(vsrc + (size_t)(j + 1) * 64 * 256); mw_next = mp[(size_t)(j + 1) * 4096]; }
        const LAS unsigned char* Kc = Kb + (j & 1) * 8192; const LAS unsigned char* Vc = Vb + (j & 1) * 8192;
        f32x16 p0 = negm, p1 = negm;
        bf16x8 kfr[8];
#pragma unroll
        for (int ks = 0; ks < 4; ++ks) { kfr[2 * ks] = *(const LAS bf16x8*)(Kc + kimg(q32, 2 * ks + hi)); kfr[2 * ks + 1] = *(const LAS bf16x8*)(Kc + kimg(32 + q32, 2 * ks + hi)); }
#pragma unroll
        for (int ks = 0; ks < 4; ++ks) { p0 = MFMA32(kfr[2 * ks], qf[ks], p0); p1 = MFMA32(kfr[2 * ks + 1], qf[ks], p1); }
        s16x4 vlo[8], vup[8];
#pragma unroll
        for (int kq = 0; kq < 4; ++kq)
#pragma unroll
            for (int d0 = 0; d0 < 2; ++d0) {
                vlo[2 * kq + d0] = vtr(Vc + vimg(16 * kq + 4 * hi + q4, 4 * d0 + 2 * blk + (p4 >> 1)) + 8 * (p4 & 1));
                vup[2 * kq + d0] = vtr(Vc + vimg(16 * kq + 8 + 4 * hi + q4, 4 * d0 + 2 * blk + (p4 >> 1)) + 8 * (p4 & 1));
            }
        const unsigned b0 = (unsigned)mw >> (4 * hi), b1 = (unsigned)(mw >> 32) >> (4 * hi);
#pragma unroll
        for (int r = 0; r < 16; ++r) { p0[r] = mask_sel(p0[r], b0, (r & 3) + 8 * (r >> 2)); p1[r] = mask_sel(p1[r], b1, (r & 3) + 8 * (r >> 2)); }
        float rm = fmaxf(p0[0], p1[0]);
#pragma unroll
        for (int r = 1; r < 16; ++r) rm = fmaxf(fmaxf(rm, p0[r]), p1[r]);
        rm = swap_max(rm);
        if (j == 0 || __any(rm > 8.0f)) {
            const float delta = (j == 0) ? ((rm > -INFINITY) ? rm : 0.f) : fmaxf(rm, 0.f);
#pragma unroll
            for (int r = 0; r < 16; ++r) { p0[r] -= delta; p1[r] -= delta; negm[r] -= delta; }
            if (j != 0) { const float alpha = __builtin_amdgcn_exp2f(-delta);
#pragma unroll
                for (int r = 0; r < 16; ++r) { o0[r] *= alpha; o1[r] *= alpha; ol[r] *= alpha; } }
        }
#pragma unroll
        for (int r = 0; r < 16; ++r) { p0[r] = __builtin_amdgcn_exp2f(p0[r]); p1[r] = __builtin_amdgcn_exp2f(p1[r]); }
        bf16x8 pf[4];
#pragma unroll
        for (int ks = 0; ks < 2; ++ks) {
            v4u wa, wb;
            wa.x = cvtpk(p0[8 * ks + 0], p0[8 * ks + 1]); wa.y = cvtpk(p0[8 * ks + 2], p0[8 * ks + 3]); wa.z = cvtpk(p0[8 * ks + 4], p0[8 * ks + 5]); wa.w = cvtpk(p0[8 * ks + 6], p0[8 * ks + 7]);
            wb.x = cvtpk(p1[8 * ks + 0], p1[8 * ks + 1]); wb.y = cvtpk(p1[8 * ks + 2], p1[8 * ks + 3]); wb.z = cvtpk(p1[8 * ks + 4], p1[8 * ks + 5]); wb.w = cvtpk(p1[8 * ks + 6], p1[8 * ks + 7]);
            pf[ks] = __builtin_bit_cast(bf16x8, wa); pf[2 + ks] = __builtin_bit_cast(bf16x8, wb);
        }
#pragma unroll
        for (int kq = 0; kq < 4; ++kq) {
#pragma unroll
            for (int d0 = 0; d0 < 2; ++d0) {
                const s16x4 lo = vlo[2 * kq + d0], up = vup[2 * kq + d0];
                const bf16x8 vf = (bf16x8){lo[0], lo[1], lo[2], lo[3], up[0], up[1], up[2], up[3]};
                if (d0 == 0) o0 = MFMA32(vf, pf[kq], o0); else o1 = MFMA32(vf, pf[kq], o1);
            }
            ol = MFMA32(ones, pf[kq], ol);
        }
        if (j + 1 < NT) { *(LAS v4u*)(Kb + ((j + 1) & 1) * 8192 + kimg(srow, sch)) = kreg; *(LAS v4u*)(Vb + ((j + 1) & 1) * 8192 + vimg(srow, sch)) = vreg; }
        __syncthreads();
    }
    (void)koff0; (void)voff0;
    const float l_tot = swap_sum(ol[0]), inv = 1.0f / l_tot;
    const bf16* grow_p = G + grow * 1024 + head * 64;
    bf16* zrow = Z + grow * 1024 + head * 64;
#pragma unroll
    for (int g4 = 0; g4 < 4; ++g4) {
        const u32x2 ga = *(const u32x2*)(grow_p + 8 * g4 + 4 * hi), gb = *(const u32x2*)(grow_p + 32 + 8 * g4 + 4 * hi);
        *(u32x2*)(zrow + 8 * g4 + 4 * hi) = (u32x2){cvtpk(o0[4 * g4] * inv * bf_lo(ga.x), o0[4 * g4 + 1] * inv * bf_hi(ga.x)), cvtpk(o0[4 * g4 + 2] * inv * bf_lo(ga.y), o0[4 * g4 + 3] * inv * bf_hi(ga.y))};
        *(u32x2*)(zrow + 32 + 8 * g4 + 4 * hi) = (u32x2){cvtpk(o1[4 * g4] * inv * bf_lo(gb.x), o1[4 * g4 + 1] * inv * bf_hi(gb.x)), cvtpk(o1[4 * g4 + 2] * inv * bf_lo(gb.y), o1[4 * g4 + 3] * inv * bf_hi(gb.y))};
    }
}
__device__ __forceinline__ void p_attnB(Frame& F, const bf16* Q, const bf16* K, const bf16* V, const bf16* G, const unsigned long long* maskw, bf16* Z) {
    for (int L = F.vcu; L < 2048; L += F.G) {
        const int i = L >> 8, v = L & 255, bh = v >> 3, s = v & 7;
        const int blkq = 16 * (i >> 1) + ((i & 1) ? 15 - s : s);
        attnB_unit(F, bh >> 2, bh & 3, blkq, Q, K, V, G, maskw, Z);
    }
}

__device__ __forceinline__ cargs_t fresh_args() { cargs_t p = (cargs_t)__builtin_amdgcn_kernarg_segment_ptr(); asm volatile("" : "+s"(p)); return p; }
__global__ void __launch_bounds__(NWAVES * 64, 2) trunk_fwd(Args args_unused) {
    extern __shared__ __attribute__((aligned(16))) unsigned char lds[];
    Frame F;
    F.lds = (LAS unsigned char*)lds;
    F.MISC = (volatile LAS unsigned*)(F.lds + MISC_OFF);
    F.tid = threadIdx.x; F.lane = F.tid & 63; F.wave = __builtin_amdgcn_readfirstlane(F.tid >> 6);
    F.G = gridDim.x; F.bx = blockIdx.x; { const int bx = blockIdx.x; F.vcu = (F.G % 8 == 0) ? (bx % 8) * (F.G / 8) + bx / 8 : bx; }
    F.ctl = (gu32*)(fresh_args()->ws + WS_CTL);
    if (F.tid < 64) ((LAS unsigned*)(F.lds + MISC_OFF))[F.tid] = 0u;
    __syncthreads();
#if MK_ONE_LAUNCH
    XcdBarrier bar = xcd_barrier_post((unsigned*)(F.ctl + CW_BAR), F.MISC + 8);
#define SEAM() do { XcdBarrier b_ = bar; asm volatile("" : "+s"(b_.bar), "+s"(b_.x)); xcd_barrier(b_); } while (0)
#define RUN 1
#else
    int seam = 0; const int seg = fresh_args()->seg;
#define SEAM() (++seam)
#define RUN (seam == seg)
#endif
#define WSP(off) (A_->ws + (off))
#define FRESH_F() Frame Fp = F; { int t_ = threadIdx.x; asm volatile("" : "+v"(t_)); Fp.tid = t_; Fp.lane = t_ & 63; Fp.wave = __builtin_amdgcn_readfirstlane(t_ >> 6); asm volatile("" : "+s"(Fp.vcu), "+s"(Fp.G), "+s"(Fp.bx)); }
    if (DUP(0)) { { cargs_t A_ = fresh_args(); FRESH_F(); p_prologue(Fp, A_); } SEAM(); }
    if (P_ON(0) && RUN) { cargs_t A_ = fresh_args(); FRESH_F(); p_prologue(Fp, A_); }
    SEAM();
    for (int lp = 0; lp < 2; ++lp) {
        {
            const int layer = 2 * lp;
            for (int rep_ = 0; rep_ < 1 + DUP(1); ++rep_) { if (rep_) SEAM();
            if (P_ON(1) && RUN) { cargs_t A_ = fresh_args(); FRESH_F(); const float* hin = (layer == 0) ? A_->in[0] : A_->out;
                p_norm_mod(Fp, hin, A_->in[3] + (size_t)layer * 1024, (const float*)WSP(WS_MOD) + (size_t)layer * 8 * 3072, (bf16*)WSP(WS_U)); } }
            SEAM();
            for (int ch = 0; ch < NCHUNK; ++ch) {
                for (int rep_ = 0; rep_ < 1 + DUP(2); ++rep_) { if (rep_) SEAM();
                if (P_ON(2) && RUN) { cargs_t A_ = fresh_args();
                    pg8::Gemm g{(bf16*)WSP(WS_U) + (size_t)ch * MC * 1024, (bf16*)WSP(WS_WA) + (size_t)lp * A_N * 1024, MC, A_N, 1024};
                    pg8::StaticOrder S; { int g_ = F.G, b_ = F.bx; asm volatile("" : "+s"(g_), "+s"(b_)); S.init(MC, A_N, g_, b_); }
                    pg8::EpiA E{A_->ws, ch * MC};
                    pg8::gemm_phase<pg8::EpiA, pg8::StaticOrder, true, true>(F.lds, g, S, E);
                } }
                SEAM();
                if (DUP(3)) { { cargs_t A_ = fresh_args(); FRESH_F(); p_attnA(Fp, (bf16*)WSP(WS_ACT), (float*)WSP(WS_LSE), (bf16*)WSP(WS_END_A)); } SEAM(); }
                if (P_ON(3) && RUN) { cargs_t A_ = fresh_args(); FRESH_F(); p_attnA(Fp, (bf16*)WSP(WS_ACT), (float*)WSP(WS_LSE), nullptr); }
                SEAM();
                if (DUP(4)) { { cargs_t A_ = fresh_args(); FRESH_F(); p_mergeA(Fp, (const bf16*)WSP(WS_ACT), (const float*)WSP(WS_LSE), (bf16*)WSP(WS_U) + (size_t)ch * MC * 1024); } SEAM(); }
                if (P_ON(4) && RUN) { cargs_t A_ = fresh_args(); FRESH_F(); p_mergeA(Fp, (const bf16*)WSP(WS_ACT), (const float*)WSP(WS_LSE), (bf16*)WSP(WS_U) + (size_t)ch * MC * 1024); }
                SEAM();
            }
            for (int rep_ = 0; rep_ < 1 + ((DUP(5) && layer == 0) ? 1 : 0); ++rep_) { if (rep_) SEAM();
            if (P_ON(5) && RUN) { cargs_t A_ = fresh_args(); const float* hin = (layer == 0) ? A_->in[0] : A_->out;
                pg8::Gemm g{(bf16*)WSP(WS_U), (bf16*)WSP(WS_WO) + (size_t)layer * 1024 * 1024, MTOK, 1024, 1024};
                pg8::StaticOrder S; { int g_ = F.G, b_ = F.bx; asm volatile("" : "+s"(g_), "+s"(b_)); S.init(MTOK, 1024, g_, b_); }
                pg8::EpiOut E{hin, A_->out, (const float*)WSP(WS_MOD) + (size_t)layer * 8 * 3072 + 2048};
                pg8::gemm_phase<pg8::EpiOut, pg8::StaticOrder, true, true>(F.lds, g, S, E);
            } }
            SEAM();
        }
        {
            const int layer = 2 * lp + 1;
            if (P_ON(6) && RUN) { cargs_t A_ = fresh_args(); FRESH_F();
                p_norm_mod(Fp, A_->out, A_->in[3] + (size_t)layer * 1024, (const float*)WSP(WS_MOD) + (size_t)layer * 8 * 3072, (bf16*)WSP(WS_U)); }
            SEAM();
            for (int rep_ = 0; rep_ < 1 + DUP(7); ++rep_) { if (rep_) SEAM();
            if (P_ON(7) && RUN) { cargs_t A_ = fresh_args();
                pg8::Gemm g{(bf16*)WSP(WS_U), (bf16*)WSP(WS_WB) + (size_t)lp * B_NP * 1024, MTOK, B_NP, 1024};
                pg8::StaticOrder S; { int g_ = F.G, b_ = F.bx; asm volatile("" : "+s"(g_), "+s"(b_)); S.init(MTOK, B_NP, g_, b_); }
                pg8::EpiB E{A_->ws};
                pg8::gemm_phase<pg8::EpiB, pg8::StaticOrder, true, true>(F.lds, g, S, E);
            } }
            SEAM();
            if (DUP(8)) { { cargs_t A_ = fresh_args(); FRESH_F(); p_index(Fp, (const bf16*)WSP(WS_BQI), (const bf16*)WSP(WS_BKI), (const float*)WSP(WS_BWI), (unsigned long long*)WSP(WS_BMASK)); } SEAM(); }
            if (P_ON(8) && RUN) { cargs_t A_ = fresh_args(); FRESH_F(); p_index(Fp, (const bf16*)WSP(WS_BQI), (const bf16*)WSP(WS_BKI), (const float*)WSP(WS_BWI), (unsigned long long*)WSP(WS_BMASK)); }
            SEAM();
            if (DUP(9)) { { cargs_t A_ = fresh_args(); FRESH_F(); p_attnB(Fp, (const bf16*)WSP(WS_BQ), (const bf16*)WSP(WS_BK), (const bf16*)WSP(WS_BV), (const bf16*)WSP(WS_BG), (const unsigned long long*)WSP(WS_BMASK), (bf16*)WSP(WS_U)); } SEAM(); }
            if (P_ON(9) && RUN) { cargs_t A_ = fresh_args(); FRESH_F(); p_attnB(Fp, (const bf16*)WSP(WS_BQ), (const bf16*)WSP(WS_BK), (const bf16*)WSP(WS_BV), (const bf16*)WSP(WS_BG), (const unsigned long long*)WSP(WS_BMASK), (bf16*)WSP(WS_U)); }
            SEAM();
            if (P_ON(10) && RUN) { cargs_t A_ = fresh_args();
                pg8::Gemm g{(bf16*)WSP(WS_U), (bf16*)WSP(WS_WO) + (size_t)layer * 1024 * 1024, MTOK, 1024, 1024};
                pg8::StaticOrder S; { int g_ = F.G, b_ = F.bx; asm volatile("" : "+s"(g_), "+s"(b_)); S.init(MTOK, 1024, g_, b_); }
                pg8::EpiOut E{A_->out, A_->out, (const float*)WSP(WS_MOD) + (size_t)layer * 8 * 3072 + 2048};
                pg8::gemm_phase<pg8::EpiOut, pg8::StaticOrder, true, true>(F.lds, g, S, E);
            }
            SEAM();
        }
    }
#ifdef EXTRA_SEAMS
    for (int e_ = 0; e_ < EXTRA_SEAMS; ++e_) SEAM();
#endif
    if (P_ON(11) && RUN) { cargs_t A_ = fresh_args(); FRESH_F(); p_final_norm(Fp, A_->out, A_->in[10], A_->out); }
}

extern "C" void kernel_launch(void* const* d_in, const int* in_sizes, int n_in, void* d_out, int out_size, void* d_ws, size_t ws_size, hipStream_t stream) {
    static int grid = 0;
    if (grid == 0) {
        if (n_in != 11 || in_sizes[0] != MTOK * DM || out_size != MTOK * DM || ws_size < WS_NEED) {
            fprintf(stderr, "kernel_launch: unexpected shapes / workspace (n_in %d, in0 %d, out %d, ws %zu, need %zu); nothing launched\n", n_in, n_in > 0 ? in_sizes[0] : -1, out_size, ws_size, (size_t)WS_NEED); grid = -1; return; }
        int dev = 0, cus = 0, per_cu = 0;
        if (hipGetDevice(&dev) != hipSuccess || hipDeviceGetAttribute(&cus, hipDeviceAttributeMultiprocessorCount, dev) != hipSuccess) { fprintf(stderr, "kernel_launch: device query failed\n"); grid = -1; return; }
        if (hipFuncSetAttribute((const void*)trunk_fwd, hipFuncAttributeMaxDynamicSharedMemorySize, LDS_BYTES) != hipSuccess) { fprintf(stderr, "kernel_launch: hipFuncSetAttribute failed\n"); grid = -1; return; }
        if (hipOccupancyMaxActiveBlocksPerMultiprocessor(&per_cu, (const void*)trunk_fwd, NWAVES * 64, LDS_BYTES) != hipSuccess || per_cu < 1)
            fprintf(stderr, "kernel_launch: note: occupancy query reports %d workgroups per CU\n", per_cu);
        (void)hipGetLastError();
        grid = cus;
    }
    if (grid < 0) return;
    if (hipMemsetAsync((char*)d_ws + WS_CTL, 0, CTL_ZERO_BYTES, stream) != hipSuccess) { fprintf(stderr, "kernel_launch: memset failed\n"); return; }
    Args a{};
    for (int i = 0; i < 11; ++i) a.in[i] = (const float*)d_in[i];
    a.pos = (const int*)d_in[2]; a.out = (float*)d_out; a.ws = (unsigned char*)d_ws; a.seg = 0; a.pad = 0;
#if MK_ONE_LAUNCH
    hipLaunchKernelGGL(trunk_fwd, dim3(grid), dim3(NWAVES * 64), LDS_BYTES, stream, a);
#else
    for (int s = 0; s <= N_SEAMS; ++s) { a.seg = s; hipLaunchKernelGGL(trunk_fwd, dim3(grid), dim3(NWAVES * 64), LDS_BYTES, stream, a); }
#endif
    const hipError_t le = hipPeekAtLastError();
    if (le != hipSuccess) fprintf(stderr, "kernel_launch: launch failed: %s\n", hipGetErrorName(le));
}
```
